# Optimizing an MI355X kernel written in HIP

```python
import math
import jax, jax.numpy as jnp
from jax import lax
import numpy as np

D_MODEL = 1024
BATCH = 8
SEQ = 2048
DEPTH = 2

MEM_LEN = 256
BLOCK = 128
HEAD_DIM = 64
EPS = 1e-6
A_HEADS = 8
A_WIDTH = A_HEADS * HEAD_DIM
B_GROUPS = 4
B_GROUP_DIM = 128
B_WIDTH = B_GROUPS * B_GROUP_DIM
CHUNK = 128
EVEN_IN = 3 * A_WIDTH + A_HEADS + 2 * B_WIDTH
EVEN_SPLITS = [A_WIDTH, 2 * A_WIDTH, 3 * A_WIDTH, 3 * A_WIDTH + A_HEADS, 3 * A_WIDTH + A_HEADS + B_WIDTH]
C_WIDTH = 512
CONV_W = 3
D_HEADS = 4
D_WIDTH = D_HEADS * 2 * HEAD_DIM
ODD_IN = 3 * C_WIDTH + 3 * D_WIDTH
ODD_SPLITS = [C_WIDTH, 2 * C_WIDTH, 3 * C_WIDTH, 3 * C_WIDTH + D_WIDTH, 3 * C_WIDTH + 2 * D_WIDTH]
N_BUCKETS = 32
MAX_DIST = 128
X_HEADS = 4
X_HEAD_DIM = 128
X_WIDTH = X_HEADS * X_HEAD_DIM
FF_DENSE = 2816
N_EXPERTS = 8
TOP_K = 2
FF_EXPERT = 3584
N_EVEN = (DEPTH + 1) // 2
N_ODD = DEPTH // 2

kernel_name = "hybrid_fox_gmlp_shortconv_diffattn_moe"


def rmsnorm(x, g):
    xf = x.astype(jnp.float32)
    y = xf * lax.rsqrt(jnp.mean(xf * xf, axis=-1, keepdims=True) + EPS)
    return (y * g.astype(jnp.float32)).astype(x.dtype)


def t5_bucket(dist):
    n = jnp.maximum(dist, 0)
    max_exact = N_BUCKETS // 2
    nf = jnp.maximum(n, 1).astype(jnp.float32)
    large = max_exact + (jnp.log(nf / max_exact) / math.log(MAX_DIST / max_exact)
                         * (N_BUCKETS - max_exact)).astype(jnp.int32)
    large = jnp.minimum(large, N_BUCKETS - 1)
    return jnp.where(n < max_exact, n, large)


def fox_attention(q, k, v, log_f):
    seq = q.shape[2]
    c = jnp.cumsum(log_f, axis=-1)
    scale = HEAD_DIM ** -0.5
    outs = []
    for blk in range(seq // BLOCK):
        qs, qe = blk * BLOCK, (blk + 1) * BLOCK
        logits = jnp.einsum("bhqd,bhkd->bhqk", q[:, :, qs:qe], k[:, :, :qe]).astype(jnp.float32) * scale
        logits = logits + (c[:, :, qs:qe, None] - c[:, :, None, :qe])
        causal = (qs + jnp.arange(BLOCK))[:, None] >= jnp.arange(qe)[None, :]
        logits = jnp.where(causal, logits, -jnp.inf)
        p = jax.nn.softmax(logits, axis=-1).astype(v.dtype)
        outs.append(jnp.einsum("bhqk,bhkd->bhqd", p, v[:, :, :qe]))
    return jnp.concatenate(outs, axis=2)


def spatial_gating(u, v, sgu_norm, w_s, b_s):
    bsz, seq, _ = u.shape
    u = jax.nn.gelu(u).reshape(bsz, seq, B_GROUPS, B_GROUP_DIM)
    v = rmsnorm(jax.nn.gelu(v).reshape(bsz, seq, B_GROUPS, B_GROUP_DIM), sgu_norm)
    v = v.reshape(bsz, seq // CHUNK, CHUNK, B_GROUPS, B_GROUP_DIM)
    tri = jnp.tril(jnp.ones((CHUNK, CHUNK), dtype=bool))
    w = jnp.where(tri[None], w_s, jnp.zeros_like(w_s))
    mixed = jnp.einsum("gts,bcsgd->bctgd", w, v) + b_s.T[None, None, :, :, None]
    return (u * mixed.reshape(bsz, seq, B_GROUPS, B_GROUP_DIM)).reshape(bsz, seq, B_WIDTH)


def short_conv(b_gate, c_gate, x_in, conv_w):
    xc = c_gate * x_in
    y = lax.conv_general_dilated(xc, conv_w[:, None, :], window_strides=(1,),
                                 padding=[(CONV_W - 1, 0)],
                                 dimension_numbers=("NWC", "WIO", "NWC"),
                                 feature_group_count=C_WIDTH)
    return b_gate * y


def diff_attention(q, k, v, rel_bias, lam, lam_init, subln):
    seq = q.shape[3]
    scale = HEAD_DIM ** -0.5
    outs = []
    for blk in range(seq // BLOCK):
        qs, qe = blk * BLOCK, (blk + 1) * BLOCK
        dist = (qs + jnp.arange(BLOCK))[:, None] - jnp.arange(qe)[None, :]
        bias = rel_bias[t5_bucket(dist)].transpose(2, 0, 1).astype(jnp.float32)
        logits = jnp.einsum("bhiqd,bhikd->bhiqk", q[:, :, :, qs:qe], k[:, :, :, :qe]).astype(jnp.float32) * scale
        logits = jnp.where(dist >= 0, logits + bias[None, :, None], -jnp.inf)
        p = jax.nn.softmax(logits, axis=-1)
        p = p[:, :, 0] - lam * p[:, :, 1]
        outs.append(jnp.einsum("bhqk,bhkd->bhqd", p.astype(v.dtype), v[:, :, :qe]))
    o = jnp.concatenate(outs, axis=2)
    return rmsnorm(o, subln) * (1.0 - lam_init)


def even_mixer(h, w_in, b_f, sgu_norm, w_s, b_s, w_out):
    bsz, seq, _ = h.shape
    qa, ka, va, fa, ub, vb = jnp.split(h @ w_in, EVEN_SPLITS, axis=-1)
    heads = lambda t: t.reshape(bsz, seq, A_HEADS, HEAD_DIM).transpose(0, 2, 1, 3)
    log_f = jax.nn.log_sigmoid(fa.astype(jnp.float32) + b_f.astype(jnp.float32)).transpose(0, 2, 1)
    a = fox_attention(heads(qa), heads(ka), heads(va), log_f)
    a = a.transpose(0, 2, 1, 3).reshape(bsz, seq, A_WIDTH)
    g = spatial_gating(ub, vb, sgu_norm, w_s, b_s)
    return jnp.concatenate([a, g], axis=-1) @ w_out


def odd_mixer(h, w_in, conv_w, lam_q1, lam_k1, lam_q2, lam_k2, subln, w_out, rel_bias, lam_init):
    bsz, seq, _ = h.shape
    bg, cg, xi, qd, kd, vd = jnp.split(h @ w_in, ODD_SPLITS, axis=-1)
    c_out = short_conv(bg, cg, xi, conv_w)
    q = qd.reshape(bsz, seq, D_HEADS, 2, HEAD_DIM).transpose(0, 2, 3, 1, 4)
    k = kd.reshape(bsz, seq, D_HEADS, 2, HEAD_DIM).transpose(0, 2, 3, 1, 4)
    v = vd.reshape(bsz, seq, D_HEADS, 2 * HEAD_DIM).transpose(0, 2, 1, 3)
    lam = (jnp.exp(jnp.sum(lam_q1.astype(jnp.float32) * lam_k1.astype(jnp.float32)))
           - jnp.exp(jnp.sum(lam_q2.astype(jnp.float32) * lam_k2.astype(jnp.float32))) + lam_init)
    d_out = diff_attention(q, k, v, rel_bias, lam, lam_init, subln)
    d_out = d_out.transpose(0, 2, 1, 3).reshape(bsz, seq, D_WIDTH)
    return jnp.concatenate([c_out, d_out], axis=-1) @ w_out


def memory_cross_attention(h, mem_n, wq, wkv, wo):
    bsz, seq, _ = h.shape
    m = mem_n.shape[1]
    q = (h @ wq).reshape(bsz, seq, X_HEADS, X_HEAD_DIM)
    k, v = jnp.split(mem_n @ wkv, 2, axis=-1)
    k = k.reshape(bsz, m, X_HEADS, X_HEAD_DIM)
    v = v.reshape(bsz, m, X_HEADS, X_HEAD_DIM)
    logits = jnp.einsum("bshd,bmhd->bhsm", q, k).astype(jnp.float32) * (X_HEAD_DIM ** -0.5)
    p = jax.nn.softmax(logits, axis=-1).astype(v.dtype)
    o = jnp.einsum("bhsm,bmhd->bshd", p, v).reshape(bsz, seq, X_WIDTH)
    return o @ wo


def swiglu(h, w13, w2):
    gate, up = jnp.split(h @ w13, 2, axis=-1)
    return (jax.nn.silu(gate) * up) @ w2


def moe_swiglu(h, w_router, w13, w2):
    logits = (h @ w_router).astype(jnp.float32)
    top_v, top_i = lax.top_k(logits, TOP_K)
    wts = jax.nn.softmax(top_v, axis=-1)
    gate = jnp.sum(jax.nn.one_hot(top_i, N_EXPERTS, dtype=jnp.float32) * wts[..., None], axis=-2)
    y = jnp.zeros_like(h)
    for e in range(N_EXPERTS):
        y = y + gate[..., e:e + 1].astype(h.dtype) * swiglu(h, w13[e], w2[e])
    return y


def setup_inputs(seed: int = 0) -> dict:
    key = jax.random.key(seed)
    ks = iter(jax.random.split(key, 64))

    def nrm(shape, scale):
        return scale * jax.random.normal(next(ks), shape, jnp.float32)

    def gain(shape):
        return 1.0 + 0.05 * jax.random.normal(next(ks), shape, jnp.float32)

    d = D_MODEL
    return {
        "x": nrm((BATCH, SEQ, d), 1.0),
        "mem": nrm((BATCH, MEM_LEN, d), 1.0),
        "rel_bias": nrm((N_BUCKETS, D_HEADS), 0.5),
        "mem_norm": gain((d,)),
        "final_norm": gain((d,)),
        "ev_norm": gain((N_EVEN, d)),
        "ev_w_in": nrm((N_EVEN, d, EVEN_IN), d ** -0.5),
        "ev_b_f": 2.0 + nrm((N_EVEN, A_HEADS), 0.1),
        "ev_sgu_norm": gain((N_EVEN, B_GROUPS, B_GROUP_DIM)),
        "ev_w_s": nrm((N_EVEN, B_GROUPS, CHUNK, CHUNK), CHUNK ** -0.5),
        "ev_b_s": 1.0 + nrm((N_EVEN, B_GROUPS, CHUNK), 0.1),
        "ev_w_out": nrm((N_EVEN, A_WIDTH + B_WIDTH, d), (A_WIDTH + B_WIDTH) ** -0.5),
        "ffn_w13": nrm((N_EVEN, d, 2 * FF_DENSE), d ** -0.5),
        "ffn_w2": nrm((N_EVEN, FF_DENSE, d), FF_DENSE ** -0.5),
        "od_norm": gain((N_ODD, d)),
        "od_w_in": nrm((N_ODD, d, ODD_IN), d ** -0.5),
        "od_conv_w": nrm((N_ODD, CONV_W, C_WIDTH), CONV_W ** -0.5),
        "od_lam_q1": nrm((N_ODD, HEAD_DIM), 0.1),
        "od_lam_k1": nrm((N_ODD, HEAD_DIM), 0.1),
        "od_lam_q2": nrm((N_ODD, HEAD_DIM), 0.1),
        "od_lam_k2": nrm((N_ODD, HEAD_DIM), 0.1),
        "od_subln": gain((N_ODD, 2 * HEAD_DIM)),
        "od_w_out": nrm((N_ODD, C_WIDTH + D_WIDTH, d), (C_WIDTH + D_WIDTH) ** -0.5),
        "moe_router": nrm((N_ODD, d, N_EXPERTS), d ** -0.5),
        "moe_w13": nrm((N_ODD, N_EXPERTS, d, 2 * FF_EXPERT), d ** -0.5),
        "moe_w2": nrm((N_ODD, N_EXPERTS, FF_EXPERT, d), FF_EXPERT ** -0.5),
        "x_norm": gain((DEPTH, d)),
        "x_wq": nrm((DEPTH, d, X_WIDTH), d ** -0.5),
        "x_wkv": nrm((DEPTH, d, 2 * X_WIDTH), d ** -0.5),
        "x_wo": nrm((DEPTH, X_WIDTH, d), X_WIDTH ** -0.5),
        "ffn_norm": gain((DEPTH, d)),
    }


def reference(x, mem, rel_bias, mem_norm, final_norm,
              ev_norm, ev_w_in, ev_b_f, ev_sgu_norm, ev_w_s, ev_b_s, ev_w_out,
              ffn_w13, ffn_w2,
              od_norm, od_w_in, od_conv_w, od_lam_q1, od_lam_k1, od_lam_q2, od_lam_k2, od_subln, od_w_out,
              moe_router, moe_w13, moe_w2,
              x_norm, x_wq, x_wkv, x_wo, ffn_norm):
    mem_n = rmsnorm(mem, mem_norm)
    for layer in range(DEPTH):
        j = layer // 2
        if layer % 2 == 0:
            h = rmsnorm(x, ev_norm[j])
            x = x + even_mixer(h, ev_w_in[j], ev_b_f[j], ev_sgu_norm[j], ev_w_s[j], ev_b_s[j], ev_w_out[j])
        else:
            lam_init = 0.8 - 0.6 * math.exp(-0.3 * layer)
            h = rmsnorm(x, od_norm[j])
            x = x + odd_mixer(h, od_w_in[j], od_conv_w[j], od_lam_q1[j], od_lam_k1[j], od_lam_q2[j],
                              od_lam_k2[j], od_subln[j], od_w_out[j], rel_bias, lam_init)
        h = rmsnorm(x, x_norm[layer])
        x = x + memory_cross_attention(h, mem_n, x_wq[layer], x_wkv[layer], x_wo[layer])
        h = rmsnorm(x, ffn_norm[layer])
        if layer % 2 == 0:
            x = x + swiglu(h, ffn_w13[j], ffn_w2[j])
        else:
            x = x + moe_swiglu(h, moe_router[j], moe_w13[j], moe_w2[j])
    return rmsnorm(x, final_norm)
```

```cpp
#include <hip/hip_runtime.h>
#include <cstdio>
#include <cstdint>
namespace pg8 {
#define PG8_LAS __attribute__((address_space(3)))
typedef unsigned short bf16_t;
typedef short bf16x8 __attribute__((ext_vector_type(8)));
typedef float f32x4 __attribute__((ext_vector_type(4)));
typedef unsigned u32x4 __attribute__((ext_vector_type(4)));
constexpr int BM = 256, BK = 64, HALF = 128, HTB = HALF * BK * 2  , STAGE_BYTES = 8 * HTB, NXCD = 8, WGM = 8;

__host__ __device__ __forceinline__ int lds_byte(int r, int c) { const int st = (r >> 4) * 2 + (c >> 5), rr = r & 15, cc = c & 31, ob = rr * 64 + cc * 2; return st * 1024 + (ob ^ (((ob >> 9) & 1) << 5)); }
__host__ __device__ __forceinline__ void stage_rc(int b, int& R, int& C) { const int st = b / 1024, sb = b % 1024, swz = sb ^ (((sb >> 9) & 1) << 5); R = (st >> 1) * 16 + swz / 64; C = (st & 1) * 32 + (swz % 64) / 2; }
__host__ __device__ __forceinline__ int perm32(int rho) { const int n = rho >> 4, i = rho & 15; return 8 * (i >> 2) + 4 * n + (i & 3); }

struct Unit { int pm, pn; };
struct Gemm { const bf16_t* A; const bf16_t* Bt; int M, N, K; };

struct StaticOrder {
    int nM, nN, nwg, G, c;
    __host__ __device__ void init(int M, int N, int G_, int c_) { nM = M / BM; nN = N / BM; nwg = nM * nN; G = G_; c = c_; }
    __host__ __device__ bool next(int i, Unit& u) const {
        const long L = (long)i * G + c; if (L >= nwg) return false;
        int wgid = (int)L; { const int q = nwg / NXCD, r = nwg % NXCD, xcd = wgid % NXCD, off = wgid / NXCD; wgid = (xcd < r ? xcd * (q + 1) : r * (q + 1) + (xcd - r) * q) + off; }
        const int nig = WGM * nN, gid = wgid / nig, fm = gid * WGM, gsz = (nM - fm) < WGM ? (nM - fm) : WGM;
        u.pm = fm + ((wgid % nig) % gsz); u.pn = (wgid % nig) / gsz; return true;
    }
    __device__ __forceinline__ void a_ready(const Unit&) const {}
    __device__ __forceinline__ void done(const Unit&) const {}
};


__device__ __forceinline__ unsigned cvt_pk_bf16(float lo, float hi) { unsigned r; asm volatile("v_cvt_pk_bf16_f32 %0, %1, %2" : "=v"(r) : "v"(lo), "v"(hi)); return r; }
typedef float f32x2 __attribute__((ext_vector_type(2)));

__device__ __forceinline__ float gelu_tanh(float x) {
    const float z = x * (0.7978845608f + 0.0356774081f * x * x);
    return x * __builtin_amdgcn_rcpf(1.0f + __builtin_amdgcn_exp2f(-2.8853900818f * z));
}
__device__ __forceinline__ float silu_f(float x) { return x * __builtin_amdgcn_rcpf(1.0f + __builtin_amdgcn_exp2f(-1.4426950409f * x)); }
__device__ __forceinline__ u32x4 pack8(const f32x4 v0, const f32x4 v1) { u32x4 w; w.x = cvt_pk_bf16(v0[0], v0[1]); w.y = cvt_pk_bf16(v0[2], v0[3]); w.z = cvt_pk_bf16(v1[0], v1[1]); w.w = cvt_pk_bf16(v1[2], v1[3]); return w; }
__device__ __forceinline__ float rs_row(const float* ssq16, int row) {
    const f32x4* p = (const f32x4*)(ssq16 + (size_t)row * 16);
    const f32x4 a = p[0], b = p[1], c = p[2], d = p[3];
    const float s = (((a[0] + a[1]) + (a[2] + a[3])) + ((b[0] + b[1]) + (b[2] + b[3]))) + (((c[0] + c[1]) + (c[2] + c[3])) + ((d[0] + d[1]) + (d[2] + d[3])));
    return __builtin_amdgcn_rsqf(s * (1.0f / 1024.0f) + 1e-6f);
}
template <int ODD> struct EpiIn {
    static constexpr bool PERM = true, AFTER_DRAIN = false;
    bf16_t* O; const float* ssq16;
    __device__ __forceinline__ void operator()(const f32x4 (&acc)[2][2][4][2], const Unit& u, int wr, int wc, int fr, int fq) const {
        const int row0 = u.pm * BM + wr * 64 + fr, cw = wc * 32 + 8 * fq;
        int kind, colbase;
        if (!ODD) { kind = (u.pn >= 6) ? 1 : 0; colbase = u.pn * 256; }
        else { if (u.pn < 2) { kind = 0; colbase = u.pn * 256; } else if (u.pn < 6) { kind = 2; colbase = 512 + (u.pn - 2) * 128; } else { kind = 0; colbase = 1024 + (u.pn - 6) * 256; } }
#pragma unroll
        for (int ai = 0; ai < 2; ++ai)
#pragma unroll
            for (int m = 0; m < 4; ++m) {
                const int row = row0 + ai * HALF + m * 16; const float rs = rs_row(ssq16, row); bf16_t* rowp = O + (size_t)row * 2560 + colbase + cw;
                if (kind == 2) { const f32x4 v0 = (acc[ai][0][m][0] * rs) * (acc[ai][1][m][0] * rs), v1 = (acc[ai][0][m][1] * rs) * (acc[ai][1][m][1] * rs); *(u32x4*)rowp = pack8(v0, v1); }
                else {
#pragma unroll
                    for (int bj = 0; bj < 2; ++bj) { f32x4 v0 = acc[ai][bj][m][0] * rs, v1 = acc[ai][bj][m][1] * rs;
                        if (kind == 1) {
#pragma unroll
                            for (int j = 0; j < 4; ++j) { v0[j] = gelu_tanh(v0[j]); v1[j] = gelu_tanh(v1[j]); } }
                        *(u32x4*)(rowp + bj * HALF) = pack8(v0, v1); } }
            }
    }
};
struct EpiPlain {
    static constexpr bool PERM = true, AFTER_DRAIN = false;
    bf16_t* O; int ldc; const float* ssq16;
    __device__ __forceinline__ void operator()(const f32x4 (&acc)[2][2][4][2], const Unit& u, int wr, int wc, int fr, int fq) const {
        const int row0 = u.pm * BM + wr * 64 + fr, cw = u.pn * BM + wc * 32 + 8 * fq;
#pragma unroll
        for (int ai = 0; ai < 2; ++ai)
#pragma unroll
            for (int m = 0; m < 4; ++m) {
                const int row = row0 + ai * HALF + m * 16; const float rs = ssq16 ? rs_row(ssq16, row) : 1.0f; bf16_t* rowp = O + (size_t)row * ldc + cw;
#pragma unroll
                for (int bj = 0; bj < 2; ++bj) *(u32x4*)(rowp + bj * HALF) = pack8(acc[ai][bj][m][0] * rs, acc[ai][bj][m][1] * rs);
            }
    }
};
template <int NPN> struct EpiSwiglu {
    static constexpr bool PERM = true, AFTER_DRAIN = false;
    bf16_t* O; int ldc; const float* ssq16;
    __device__ __forceinline__ void operator()(const f32x4 (&acc)[2][2][4][2], const Unit& u, int wr, int wc, int fr, int fq) const {
        const int row0 = u.pm * BM + wr * 64 + fr, cw = (u.pn % NPN) * HALF + wc * 32 + 8 * fq;
#pragma unroll
        for (int ai = 0; ai < 2; ++ai)
#pragma unroll
            for (int m = 0; m < 4; ++m) {
                const int row = row0 + ai * HALF + m * 16; const float rs = ssq16 ? rs_row(ssq16, row) : 1.0f;
                f32x4 v0, v1;
#pragma unroll
                for (int j = 0; j < 4; ++j) { v0[j] = silu_f(acc[ai][0][m][0][j] * rs) * (acc[ai][1][m][0][j] * rs); v1[j] = silu_f(acc[ai][0][m][1][j] * rs) * (acc[ai][1][m][1][j] * rs); }
                *(u32x4*)(O + (size_t)row * ldc + cw) = pack8(v0, v1);
            }
    }
};
struct EpiResid {
    static constexpr bool PERM = true, AFTER_DRAIN = false;
    const float* base; float* out; bf16_t* xb; float* ssq16;
    __device__ __forceinline__ void operator()(const f32x4 (&acc)[2][2][4][2], const Unit& u, int wr, int wc, int fr, int fq) const {
        const int row0 = u.pm * BM + wr * 64 + fr, cw = u.pn * BM + wc * 32 + 8 * fq;
#pragma unroll
        for (int ai = 0; ai < 2; ++ai)
#pragma unroll
            for (int m = 0; m < 4; ++m) {
                const int row = row0 + ai * HALF + m * 16; const size_t off = (size_t)row * 1024 + cw; float s = 0.f;
#pragma unroll
                for (int bj = 0; bj < 2; ++bj) {
                    const f32x4 b0 = *(const f32x4*)(base + off + bj * HALF), b1 = *(const f32x4*)(base + off + bj * HALF + 4);
                    const f32x4 v0 = acc[ai][bj][m][0] + b0, v1 = acc[ai][bj][m][1] + b1;
                    *(f32x4*)(out + off + bj * HALF) = v0; *(f32x4*)(out + off + bj * HALF + 4) = v1;
                    *(u32x4*)(xb + off + bj * HALF) = pack8(v0, v1);
                    s += ((v0[0] * v0[0] + v0[1] * v0[1]) + (v0[2] * v0[2] + v0[3] * v0[3])) + ((v1[0] * v1[0] + v1[1] * v1[1]) + (v1[2] * v1[2] + v1[3] * v1[3]));
                }
                s += __shfl_xor(s, 16); s += __shfl_xor(s, 32);
                if (fq == 0) ssq16[(size_t)row * 16 + u.pn * 4 + wc] = s;
            }
    }
};
struct EpiY {
    static constexpr bool PERM = true, AFTER_DRAIN = false;
    bf16_t* Y; const float* gate;
    __device__ __forceinline__ void operator()(const f32x4 (&acc)[2][2][4][2], const Unit& u, int wr, int wc, int fr, int fq) const {
        const int row0 = u.pm * BM + wr * 64 + fr, cw = (u.pn & 3) * BM + wc * 32 + 8 * fq;
#pragma unroll
        for (int ai = 0; ai < 2; ++ai)
#pragma unroll
            for (int m = 0; m < 4; ++m) {
                const int row = row0 + ai * HALF + m * 16; const float g = gate[row]; bf16_t* rowp = Y + (size_t)row * 1024 + cw;
#pragma unroll
                for (int bj = 0; bj < 2; ++bj) *(u32x4*)(rowp + bj * HALF) = pack8(acc[ai][bj][m][0] * g, acc[ai][bj][m][1] * g);
            }
    }
};
struct MoeOrder {
    StaticOrder so; int NPN; int tb[8];
    __device__ __forceinline__ void init(const unsigned* cnt, int NPN_, int G, int c) {
        int t = 0;
#pragma unroll
        for (int e = 0; e < 8; ++e) { tb[e] = t; t += (int)((cnt[e] + 255u) >> 8); }
        NPN = NPN_; so.nM = t; so.nN = NPN_; so.nwg = t * NPN_; so.G = G; so.c = c;
    }
    __device__ __forceinline__ bool next(int i, Unit& u) const {
        if (!so.next(i, u)) return false;
        int e = 0;
#pragma unroll
        for (int j = 1; j < 8; ++j) e += (u.pm >= tb[j]) ? 1 : 0;
        u.pn += e * NPN; return true;
    }
    __device__ __forceinline__ void a_ready(const Unit&) const {}
    __device__ __forceinline__ void done(const Unit&) const {}
};

template <class Epi, class Sched, bool ALIGN_EPI = false, bool SP2 = false>
__device__ __forceinline__ void gemm_phase(PG8_LAS unsigned char* lds, const Gemm g, const Sched& S, const Epi& E) {
    const int tid = threadIdx.x, wid = __builtin_amdgcn_readfirstlane(tid >> 6), lane = tid & 63, wr = wid >> 2, wc = wid & 3, fr = lane & 15, fq = lane >> 4;
    const int K = g.K, nt = K / BK;
    unsigned voffA[2], voffB[2];
#pragma unroll
    for (int i = 0; i < 2; ++i) { int R, C; stage_rc(tid * 16 + i * 8192, R, C); const int Rb = Epi::PERM ? ((R & ~31) + perm32(R & 31)) : R;
        voffA[i] = (unsigned)(R * K + C) * 2u; voffB[i] = (unsigned)(Rb * K + C) * 2u; }
    const size_t kstep = (size_t)(BK * 2);
    const size_t hstep = (size_t)HALF * K * 2;
    const size_t tstep = 2 * hstep;
    const unsigned ldsw = (unsigned)wid * 1024u;
    const int aoff = lds_byte(wr * 64 + fr, fq * 8), boff = lds_byte(wc * 32 + fr, fq * 8);
#define PG8_SA(b, h) (((b) * 2 + (h)) * HTB)
#define PG8_SB(b, h) ((4 + (b) * 2 + (h)) * HTB)
#define PG8_STAGE(bufoff, gbase, voff) do { _Pragma("unroll") for (int _i = 0; _i < 2; ++_i) \
        __builtin_amdgcn_global_load_lds((const unsigned*)((const char*)(gbase) + (voff)[_i]), (PG8_LAS unsigned*)(lds + (bufoff) + ldsw + _i * 8192), 16, 0, 0); } while (0)
#define PG8_LDA(dst, b, h) do { _Pragma("unroll") for (int m = 0; m < 4; ++m) _Pragma("unroll") for (int k = 0; k < 2; ++k) dst[m][k] = *(const PG8_LAS bf16x8*)(lds + PG8_SA(b, h) + aoff + m * 2048 + k * 1024); } while (0)
#define PG8_LDB(dst, b, h) do { _Pragma("unroll") for (int n = 0; n < 2; ++n) _Pragma("unroll") for (int k = 0; k < 2; ++k) dst[n][k] = *(const PG8_LAS bf16x8*)(lds + PG8_SB(b, h) + boff + n * 2048 + k * 1024); } while (0)
#define PG8_MMA(ai, bj, At, Bt) do { __builtin_amdgcn_s_setprio(1); _Pragma("unroll") for (int m = 0; m < 4; ++m) _Pragma("unroll") for (int n = 0; n < 2; ++n) _Pragma("unroll") for (int k = 0; k < 2; ++k) \
        acc[ai][bj][m][n] = __builtin_amdgcn_mfma_f32_16x16x32_bf16(Bt[n][k], At[m][k], acc[ai][bj][m][n], 0, 0, 0); __builtin_amdgcn_s_setprio(0); } while (0)
#define PG8_WAIT_V(n) asm volatile("s_waitcnt vmcnt(" #n ")" ::: "memory")
#define PG8_WAIT_L(n) asm volatile("s_waitcnt lgkmcnt(" #n ")" ::: "memory")
#define PG8_BAR __builtin_amdgcn_s_barrier()
#define PG8_SCHED __builtin_amdgcn_sched_barrier(0)
    Unit cur, nxt; int ui = 0;
    if (!S.next(0, cur)) return;
    f32x4 acc[2][2][4][2];
#pragma unroll
    for (int a = 0; a < 2; ++a)
#pragma unroll
        for (int b = 0; b < 2; ++b)
#pragma unroll
            for (int m = 0; m < 4; ++m)
#pragma unroll
                for (int n = 0; n < 2; ++n) acc[a][b][m][n] = (f32x4){0.f, 0.f, 0.f, 0.f};
    bf16x8 At[4][2], B0[2][2], B1[2][2];
    const char* cA = (const char*)g.A + (size_t)cur.pm * tstep; const char* cB = (const char*)g.Bt + (size_t)cur.pn * tstep;
    S.a_ready(cur);
    if constexpr (SP2) {
        PG8_STAGE(PG8_SB(0, 0), cB, voffB); PG8_STAGE(PG8_SB(0, 1), cB + hstep, voffB); PG8_STAGE(PG8_SA(0, 0), cA, voffA); PG8_STAGE(PG8_SA(0, 1), cA + hstep, voffA);
        if (wr == 1) PG8_BAR;
        PG8_WAIT_V(2); PG8_BAR;
        PG8_STAGE(PG8_SB(1, 0), cB + kstep, voffB); PG8_STAGE(PG8_SA(1, 0), cA + kstep, voffA); PG8_STAGE(PG8_SB(1, 1), cB + hstep + kstep, voffB);
        PG8_WAIT_V(6); PG8_BAR;
    } else {
        PG8_STAGE(PG8_SB(0, 0), cB, voffB); PG8_STAGE(PG8_SA(0, 0), cA, voffA); PG8_STAGE(PG8_SB(0, 1), cB + hstep, voffB); PG8_STAGE(PG8_SA(0, 1), cA + hstep, voffA);
        if (wr == 1) PG8_BAR;
        PG8_WAIT_V(4); PG8_BAR;
        PG8_STAGE(PG8_SB(1, 0), cB + kstep, voffB); PG8_STAGE(PG8_SA(1, 0), cA + kstep, voffA); PG8_STAGE(PG8_SB(1, 1), cB + hstep + kstep, voffB);
        PG8_WAIT_V(6); PG8_BAR;
    }
    for (;;) {
        const bool has_next = S.next(ui + 1, nxt);
        const char* nA = has_next ? (const char*)g.A + (size_t)nxt.pm * tstep : cA; const char* nB = has_next ? (const char*)g.Bt + (size_t)nxt.pn * tstep : cB;
        for (int t = 0; t < nt; t += 2) {
            const bool last = (t == nt - 2);
            const char* a1 = cA + (size_t)(t + 1) * kstep;
            const char* a2 = last ? nA : cA + (size_t)(t + 2) * kstep; const char* b2 = last ? nB : cB + (size_t)(t + 2) * kstep;
            const char* a3 = a2 + kstep; const char* b3 = b2 + kstep;
            if (last && has_next) S.a_ready(nxt);
            if constexpr (SP2) {
            PG8_LDB(B0, 0, 0); PG8_LDB(B1, 0, 1); PG8_SCHED; PG8_LDA(At, 0, 0); PG8_STAGE(PG8_SA(1, 1), a1 + hstep, voffA);
            PG8_WAIT_V(8); PG8_WAIT_L(0); PG8_BAR; PG8_MMA(0, 0, At, B0); PG8_MMA(0, 1, At, B1); PG8_BAR; PG8_SCHED;
            PG8_LDA(At, 0, 1); PG8_STAGE(PG8_SB(0, 0), b2, voffB); PG8_STAGE(PG8_SB(0, 1), b2 + hstep, voffB); PG8_STAGE(PG8_SA(0, 0), a2, voffA);
            PG8_WAIT_V(8); PG8_WAIT_L(0); PG8_BAR; PG8_MMA(1, 0, At, B0); PG8_MMA(1, 1, At, B1); PG8_BAR; PG8_SCHED;
            PG8_LDB(B0, 1, 0); PG8_LDB(B1, 1, 1); PG8_SCHED; PG8_LDA(At, 1, 0); PG8_STAGE(PG8_SA(0, 1), a2 + hstep, voffA);
            PG8_WAIT_V(8); PG8_WAIT_L(0); PG8_BAR; PG8_MMA(0, 0, At, B0); PG8_MMA(0, 1, At, B1); PG8_BAR; PG8_SCHED;
            PG8_LDA(At, 1, 1); PG8_STAGE(PG8_SB(1, 0), b3, voffB); PG8_STAGE(PG8_SB(1, 1), b3 + hstep, voffB); PG8_STAGE(PG8_SA(1, 0), a3, voffA);
            PG8_WAIT_V(8); PG8_WAIT_L(0); PG8_BAR; PG8_MMA(1, 0, At, B0); PG8_MMA(1, 1, At, B1); PG8_BAR; PG8_SCHED;
            } else {
            PG8_LDB(B0, 0, 0); PG8_SCHED; PG8_LDA(At, 0, 0); PG8_STAGE(PG8_SA(1, 1), a1 + hstep, voffA);
            PG8_WAIT_L(8); PG8_BAR; PG8_WAIT_L(0); PG8_MMA(0, 0, At, B0); PG8_BAR; PG8_SCHED;
            PG8_LDB(B1, 0, 1); PG8_STAGE(PG8_SB(0, 0), b2, voffB);
            PG8_BAR; PG8_WAIT_L(0); PG8_MMA(0, 1, At, B1); PG8_BAR;
            PG8_LDA(At, 0, 1); PG8_STAGE(PG8_SA(0, 0), a2, voffA);
            PG8_BAR; PG8_WAIT_L(0); PG8_MMA(1, 0, At, B0); PG8_BAR; PG8_SCHED;
            PG8_STAGE(PG8_SB(0, 1), b2 + hstep, voffB);
            PG8_WAIT_V(6); PG8_BAR; PG8_MMA(1, 1, At, B1); PG8_BAR;
            PG8_LDB(B0, 1, 0); PG8_SCHED; PG8_LDA(At, 1, 0); PG8_STAGE(PG8_SA(0, 1), a2 + hstep, voffA);
            PG8_WAIT_L(8); PG8_BAR; PG8_WAIT_L(0); PG8_MMA(0, 0, At, B0); PG8_BAR; PG8_SCHED;
            PG8_LDB(B1, 1, 1); PG8_STAGE(PG8_SB(1, 0), b3, voffB);
            PG8_BAR; PG8_WAIT_L(0); PG8_MMA(0, 1, At, B1); PG8_BAR;
            PG8_LDA(At, 1, 1); PG8_STAGE(PG8_SA(1, 0), a3, voffA);
            PG8_BAR; PG8_WAIT_L(0); PG8_MMA(1, 0, At, B0); PG8_BAR; PG8_SCHED;
            PG8_STAGE(PG8_SB(1, 1), b3 + hstep, voffB);
            PG8_WAIT_V(6); PG8_BAR; PG8_MMA(1, 1, At, B1); PG8_BAR;
            }
        }
        if constexpr (ALIGN_EPI) { if (wr == 0) PG8_BAR; }
        if constexpr (!Epi::AFTER_DRAIN) { E(acc, cur, wr, wc, fr, fq); S.done(cur); }
        if (!has_next) break;
#pragma unroll
        for (int a = 0; a < 2; ++a)
#pragma unroll
            for (int b = 0; b < 2; ++b)
#pragma unroll
                for (int m = 0; m < 4; ++m)
#pragma unroll
                    for (int n = 0; n < 2; ++n) acc[a][b][m][n] = (f32x4){0.f, 0.f, 0.f, 0.f};
        cur = nxt; cA = nA; cB = nB; ++ui;
        if constexpr (ALIGN_EPI) { if (wr == 1) PG8_BAR; }
    }
    PG8_WAIT_V(0);
    if constexpr (!ALIGN_EPI) { if (wr == 0) PG8_BAR; }
    PG8_BAR;
    if constexpr (Epi::AFTER_DRAIN) { E.fused(acc, cur, wr, wc, fr, fq, lds, wid, lane); S.done(cur); }
#undef PG8_SA
#undef PG8_SB
#undef PG8_STAGE
#undef PG8_LDA
#undef PG8_LDB
#undef PG8_MMA
#undef PG8_WAIT_V
#undef PG8_WAIT_L
#undef PG8_BAR
#undef PG8_SCHED
}
}

namespace att {
typedef unsigned short bf16;
using bf16x8 = __attribute__((ext_vector_type(8))) short;
using s16x4  = __attribute__((ext_vector_type(4))) short;
using f32x16 = __attribute__((ext_vector_type(16))) float;
using f32x4  = __attribute__((ext_vector_type(4))) float;
using u32x4  = __attribute__((ext_vector_type(4))) unsigned;
#define ASBAR() __builtin_amdgcn_sched_barrier(0)
#define LDS3 __attribute__((address_space(3)))
constexpr float THR2 = 11.5f;
__device__ __forceinline__ int crow(int r, int hi) { return (r & 3) + 8 * (r >> 2) + 4 * hi; }
__device__ __forceinline__ unsigned cvtpk(float lo, float hi) { unsigned r; asm volatile("v_cvt_pk_bf16_f32 %0, %1, %2" : "=v"(r) : "v"(lo), "v"(hi)); return r; }
__device__ __forceinline__ unsigned short f2bf(float f) { unsigned u = __builtin_bit_cast(unsigned, f); return (unsigned short)((u + 0x7fffu + ((u >> 16) & 1u)) >> 16); }
template <int DQK> __device__ __forceinline__ int kswz(int row, int colB) { return row * (DQK * 2) + (colB ^ ((row & 7) << 4)); }
template <int DQK, int DV> struct Geo {
    static constexpr int SHM_K = 64 * DQK * 2, SHM_V = 64 * DV * 2, NCB = DV / 32;
    static constexpr int WS_OFF = 2 * SHM_V + 2 * SHM_K, TAB_OFF = WS_OFF + 2048, BYTES = TAB_OFF + 8192;
};
__device__ __forceinline__ void partialSM(f32x16& p0, f32x16& p1, float& m_reg, float& alpha) {
    float pmax = p0[0];
#pragma unroll
    for (int r = 1; r < 16; ++r) pmax = fmaxf(pmax, p0[r]);
#pragma unroll
    for (int r = 0; r < 16; ++r) pmax = fmaxf(pmax, p1[r]);
    { auto rr = __builtin_amdgcn_permlane32_swap(__float_as_uint(pmax), __float_as_uint(pmax), false, false); pmax = fmaxf(__uint_as_float(rr[0]), __uint_as_float(rr[1])); }
    float mn;
    if (__builtin_expect(__all(pmax - m_reg <= THR2), 1)) { mn = m_reg; alpha = 1.f; }
    else { mn = fmaxf(m_reg, pmax); alpha = __builtin_amdgcn_exp2f(m_reg - mn); m_reg = mn; }
#pragma unroll
    for (int r = 0; r < 16; ++r) { p0[r] -= mn; p1[r] -= mn; }
#pragma unroll
    for (int r = 0; r < 16; ++r) p0[r] = __builtin_amdgcn_exp2f(p0[r]);
}
__device__ __forceinline__ void finishSM(f32x16& p0, f32x16& p1, float alpha, float& l_reg, bf16x8& pa0, bf16x8& pa1, bf16x8& pa2, bf16x8& pa3) {
#pragma unroll
    for (int r = 0; r < 16; ++r) p1[r] = __builtin_amdgcn_exp2f(p1[r]);
    float ps = 0;
#pragma unroll
    for (int r = 0; r < 16; ++r) ps += p0[r];
#pragma unroll
    for (int r = 0; r < 16; ++r) ps += p1[r];
    { auto rr = __builtin_amdgcn_permlane32_swap(__float_as_uint(ps), __float_as_uint(ps), false, false); ps = __uint_as_float(rr[0]) + __uint_as_float(rr[1]); }
    l_reg = l_reg * alpha + ps;
#define ATT_PK4(P, BASE, OUT) do { unsigned a0 = cvtpk(P[BASE + 0], P[BASE + 1]), a1 = cvtpk(P[BASE + 2], P[BASE + 3]);   \
    unsigned b0 = cvtpk(P[BASE + 4], P[BASE + 5]), b1 = cvtpk(P[BASE + 6], P[BASE + 7]);                              \
    auto r0 = __builtin_amdgcn_permlane32_swap(a0, b0, false, false); auto r1 = __builtin_amdgcn_permlane32_swap(a1, b1, false, false); \
    u32x4 w = {r0[0], r1[0], r0[1], r1[1]}; OUT = *reinterpret_cast<bf16x8*>(&w); } while (0)
    ATT_PK4(p0, 0, pa0); ATT_PK4(p0, 8, pa1); ATT_PK4(p1, 0, pa2); ATT_PK4(p1, 8, pa3);
#undef ATT_PK4
}
template <int DQK> __device__ __forceinline__ void qkt(f32x16& p0, f32x16& p1, const LDS3 char* Ks, const bf16x8* qr, int r32, int hi) {
    p0 = f32x16{}; p1 = f32x16{};
#pragma unroll
    for (int d0 = 0; d0 < DQK / 16; ++d0) { const int cb = (d0 * 16 + hi * 8) * 2;
        const bf16x8 b0 = *(const LDS3 bf16x8*)(Ks + kswz<DQK>(r32, cb));
        const bf16x8 b1 = *(const LDS3 bf16x8*)(Ks + kswz<DQK>(32 + r32, cb));
        p0 = __builtin_amdgcn_mfma_f32_32x32x16_bf16(b0, qr[d0], p0, 0, 0, 0);
        p1 = __builtin_amdgcn_mfma_f32_32x32x16_bf16(b1, qr[d0], p1, 0, 0, 0); }
}
template <int NCB> __device__ __forceinline__ int v_st(int k, int c) { const int kk = (k & ~0xC) | ((k & 4) << 1) | ((k & 8) >> 1); return ((kk >> 3) * NCB + (c >> 5)) * 512 + ((kk & 7) * 32 + (c & 31)) * 2; }
__device__ __forceinline__ int v_rd_base(int lane) { return ((lane & 3) << 3) | (((lane >> 2) & 3) << 6) | (((lane >> 4) & 1) << 5) | (((lane >> 5) & 1) << 8); }
template <int NCB> constexpr int v_rd_off(int d0, int ks, int half) { return d0 * 512 + ks * (2 * NCB * 512) + half * (NCB * 512); }
template <int OFF> __device__ __forceinline__ s16x4 tr_read(int vb) { s16x4 r; asm volatile("ds_read_b64_tr_b16 %0, %1 offset:%2" : "=&v"(r) : "v"(vb), "i"(OFF) : "memory"); return r; }
template <int NCB, int D0, bool SPLIT> __device__ __forceinline__ void pv_one(f32x16& od, int vb, bf16x8 pa0, bf16x8 pa1, bf16x8 pa2, bf16x8 pa3) {
#define ATT_PK(L, H) (bf16x8){L[0], L[1], L[2], L[3], H[0], H[1], H[2], H[3]}
    if constexpr (!SPLIT) {
        const s16x4 l0 = tr_read<v_rd_off<NCB>(D0, 0, 0)>(vb), h0 = tr_read<v_rd_off<NCB>(D0, 0, 1)>(vb), l1 = tr_read<v_rd_off<NCB>(D0, 1, 0)>(vb), h1 = tr_read<v_rd_off<NCB>(D0, 1, 1)>(vb);
        const s16x4 l2 = tr_read<v_rd_off<NCB>(D0, 2, 0)>(vb), h2 = tr_read<v_rd_off<NCB>(D0, 2, 1)>(vb), l3 = tr_read<v_rd_off<NCB>(D0, 3, 0)>(vb), h3 = tr_read<v_rd_off<NCB>(D0, 3, 1)>(vb);
        asm volatile("s_waitcnt lgkmcnt(0)" ::: "memory"); ASBAR();
        od = __builtin_amdgcn_mfma_f32_32x32x16_bf16(pa0, ATT_PK(l0, h0), od, 0, 0, 0);
        od = __builtin_amdgcn_mfma_f32_32x32x16_bf16(pa1, ATT_PK(l1, h1), od, 0, 0, 0);
        od = __builtin_amdgcn_mfma_f32_32x32x16_bf16(pa2, ATT_PK(l2, h2), od, 0, 0, 0);
        od = __builtin_amdgcn_mfma_f32_32x32x16_bf16(pa3, ATT_PK(l3, h3), od, 0, 0, 0);
    } else {
        { const s16x4 l0 = tr_read<v_rd_off<NCB>(D0, 0, 0)>(vb), h0 = tr_read<v_rd_off<NCB>(D0, 0, 1)>(vb), l1 = tr_read<v_rd_off<NCB>(D0, 1, 0)>(vb), h1 = tr_read<v_rd_off<NCB>(D0, 1, 1)>(vb);
          asm volatile("s_waitcnt lgkmcnt(0)" ::: "memory"); ASBAR();
          od = __builtin_amdgcn_mfma_f32_32x32x16_bf16(pa0, ATT_PK(l0, h0), od, 0, 0, 0);
          od = __builtin_amdgcn_mfma_f32_32x32x16_bf16(pa1, ATT_PK(l1, h1), od, 0, 0, 0); ASBAR(); }
        { const s16x4 l2 = tr_read<v_rd_off<NCB>(D0, 2, 0)>(vb), h2 = tr_read<v_rd_off<NCB>(D0, 2, 1)>(vb), l3 = tr_read<v_rd_off<NCB>(D0, 3, 0)>(vb), h3 = tr_read<v_rd_off<NCB>(D0, 3, 1)>(vb);
          asm volatile("s_waitcnt lgkmcnt(0)" ::: "memory"); ASBAR();
          od = __builtin_amdgcn_mfma_f32_32x32x16_bf16(pa2, ATT_PK(l2, h2), od, 0, 0, 0);
          od = __builtin_amdgcn_mfma_f32_32x32x16_bf16(pa3, ATT_PK(l3, h3), od, 0, 0, 0); ASBAR(); }
    }
#undef ATT_PK
}
template <int NCB, bool SPLIT> __device__ __forceinline__ void pv_all(f32x16* o, int vb, bf16x8 pa0, bf16x8 pa1, bf16x8 pa2, bf16x8 pa3) {
    pv_one<NCB, 0, SPLIT>(o[0], vb, pa0, pa1, pa2, pa3); pv_one<NCB, 1, SPLIT>(o[1], vb, pa0, pa1, pa2, pa3);
    if constexpr (NCB == 4) { pv_one<NCB, 2, SPLIT>(o[2], vb, pa0, pa1, pa2, pa3); pv_one<NCB, 3, SPLIT>(o[3], vb, pa0, pa1, pa2, pa3); }
}
template <int MODE> __device__ __forceinline__ void apply_bias(f32x16& p0, f32x16& p1, int kt, const LDS3 float* tab, float cq, int qabs, int q0w, int hi) {
    const int k0 = kt * 64;
    if constexpr (MODE == 1) {
#pragma unroll
        for (int j = 0; j < 4; ++j) { const f32x4 ck = *(const LDS3 f32x4*)(tab + k0 + 8 * j + 4 * hi); const f32x4 ck1 = *(const LDS3 f32x4*)(tab + k0 + 32 + 8 * j + 4 * hi);
#pragma unroll
            for (int i = 0; i < 4; ++i) { p0[4 * j + i] += cq - ck[i]; p1[4 * j + i] += cq - ck1[i]; } }
        if (k0 + 63 > q0w) {
#pragma unroll
            for (int r = 0; r < 16; ++r) { const int kv = k0 + crow(r, hi); if (kv > qabs) p0[r] = -INFINITY; if (kv + 32 > qabs) p1[r] = -INFINITY; } }
    } else if constexpr (MODE == 2) {
        const int dmin = q0w - (k0 + 63);
        if (dmin >= 113) { const float b31 = tab[127];
#pragma unroll
            for (int r = 0; r < 16; ++r) { p0[r] += b31; p1[r] += b31; } }
        else {
            const int dq = qabs - k0 - 4 * hi;
#pragma unroll
            for (int g4 = 0; g4 < 4; ++g4) {
#pragma unroll
                for (int i = 0; i < 4; ++i) { const int r = 4 * g4 + i, d = dq - 8 * g4 - i, d1 = d - 32;
                    const int dc = d < 0 ? 0 : (d > 127 ? 127 : d), dc1 = d1 < 0 ? 0 : (d1 > 127 ? 127 : d1);
                    const float t0 = tab[dc], t1 = tab[dc1];
                    p0[r] = d < 0 ? -INFINITY : p0[r] + t0; p1[r] = d1 < 0 ? -INFINITY : p1[r] + t1; }
                asm volatile("" ::: "memory");
            } }
    }
}
template <int DQK, int DV, int MODE, int LDQ, int LDK, int LDO>
__device__ __forceinline__ void attn_unit(const bf16* __restrict__ Qb, const bf16* __restrict__ Kh, const bf16* __restrict__ Vh, bf16* __restrict__ Ob, int NT, int q0, LDS3 char* lds) {
    using G = Geo<DQK, DV>;
    constexpr int SHM_K = G::SHM_K, SHM_V = G::SHM_V, NCB = G::NCB, NKC = DQK / 64, NVC = DV / 64, KCPR = DQK / 8, VCPR = DV / 8;
    const int tid = threadIdx.x, wid = __builtin_amdgcn_readfirstlane(tid >> 6), lane = tid & 63, r32 = lane & 31, hi = lane >> 5;
    LDS3 char* V_lds = lds; LDS3 char* K_lds = lds + 2 * SHM_V;
    LDS3 float* ws = (LDS3 float*)(lds + G::WS_OFF) + wid * 64; LDS3 float* li_l = ws; LDS3 float* al_l = ws + 32;
    const LDS3 float* tab = (const LDS3 float*)(lds + G::TAB_OFF);
    const int q0w = q0 + wid * 32, qabs = q0w + r32;
    float cq = 0.f; if constexpr (MODE == 1) cq = tab[qabs];
    float m_reg = -1e30f, l_reg = 0; f32x16 o[NCB]; bf16x8 qr[DQK / 16];
#pragma unroll
    for (int d = 0; d < NCB; ++d) o[d] = f32x16{};
    const bf16* Qw = Qb + (long)(wid * 32 + r32) * LDQ + hi * 8;
#pragma unroll
    for (int d0 = 0; d0 < DQK / 16; ++d0) qr[d0] = *reinterpret_cast<const bf16x8*>(Qw + d0 * 16);
    int kgo[NKC], klo[NKC], vgo[NVC], vlo[NVC];
#pragma unroll
    for (int j = 0; j < NKC; ++j) { const int ci = tid + 512 * j, row = ci / KCPR, col = (ci % KCPR) * 8; kgo[j] = row * LDK + col; klo[j] = kswz<DQK>(row, col * 2); }
#pragma unroll
    for (int j = 0; j < NVC; ++j) { const int ci = tid + 512 * j, row = ci / VCPR, col = (ci % VCPR) * 8; vgo[j] = row * LDK + col; vlo[j] = v_st<NCB>(row, col); }
    const int vb0 = (int)(unsigned)(uintptr_t)V_lds + v_rd_base(lane);
    constexpr int SD = (MODE == 2) ? 1 : 2;
    struct { bf16x8 vs[NVC], ks[NKC]; } sr_[SD];
#define ATT_SLOAD(i, k0) do { _Pragma("unroll") for (int j_ = 0; j_ < NVC; ++j_) sr_[i].vs[j_] = *reinterpret_cast<const bf16x8*>(&Vh[(long)(k0) * LDK + vgo[j_]]); \
    _Pragma("unroll") for (int j_ = 0; j_ < NKC; ++j_) sr_[i].ks[j_] = *reinterpret_cast<const bf16x8*>(&Kh[(long)(k0) * LDK + kgo[j_]]); } while (0)
#define ATT_SWRITE(b, i) do { _Pragma("unroll") for (int j_ = 0; j_ < NVC; ++j_) *(LDS3 bf16x8*)(V_lds + (b) * SHM_V + vlo[j_]) = sr_[i].vs[j_]; \
    _Pragma("unroll") for (int j_ = 0; j_ < NKC; ++j_) *(LDS3 bf16x8*)(K_lds + (b) * SHM_K + klo[j_]) = sr_[i].ks[j_]; } while (0)
#define ATT_SWAIT() asm volatile("s_waitcnt vmcnt(%0)" :: "n"(SD == 2 ? NKC + NVC : 0) : "memory")
#define ATT_RESC(a) do { if (__any((a) < 1.f)) { if (hi == 0) al_l[r32] = (a); asm volatile("s_waitcnt lgkmcnt(0)" ::: "memory"); \
    _Pragma("unroll") for (int d = 0; d < NCB; ++d) _Pragma("unroll") for (int r = 0; r < 16; ++r) o[d][r] *= al_l[crow(r, hi)]; } } while (0)
    f32x16 pA0, pA1, pB0, pB1; float alA, alB; bf16x8 pa0, pa1, pa2, pa3;
    constexpr int SE = 0, SO = SD - 1;
    ATT_SLOAD(SE, 0); asm volatile("s_waitcnt vmcnt(0)" ::: "memory"); ATT_SWRITE(0, SE); __syncthreads();
    qkt<DQK>(pA0, pA1, K_lds, qr, r32, hi); apply_bias<MODE>(pA0, pA1, 0, tab, cq, qabs, q0w, hi); partialSM(pA0, pA1, m_reg, alA);
    ATT_SLOAD(SO, 64); if (SD == 2 && 2 < NT) ATT_SLOAD(SE, 128);
    ATT_SWAIT(); ATT_SWRITE(1, SO); __syncthreads();
    for (int j = 1; j + 1 < NT; j += 2) {
        ASBAR(); qkt<DQK>(pB0, pB1, K_lds + SHM_K, qr, r32, hi);
        finishSM(pA0, pA1, alA, l_reg, pa0, pa1, pa2, pa3); ASBAR();
        ATT_SLOAD(SO, (j + SD) * 64); ASBAR();
        pv_all<NCB, MODE == 2>(o, vb0, pa0, pa1, pa2, pa3); apply_bias<MODE>(pB0, pB1, j, tab, cq, qabs, q0w, hi); partialSM(pB0, pB1, m_reg, alB);
        __syncthreads(); ATT_SWAIT(); ATT_SWRITE(0, SE);
        ATT_RESC(alB); __syncthreads();
        ASBAR(); qkt<DQK>(pA0, pA1, K_lds, qr, r32, hi);
        finishSM(pB0, pB1, alB, l_reg, pa0, pa1, pa2, pa3); ASBAR();
        if (SD == 1 || j + 3 < NT) ATT_SLOAD(SE, (j + 1 + SD) * 64); ASBAR();
        pv_all<NCB, MODE == 2>(o, vb0 + SHM_V, pa0, pa1, pa2, pa3); apply_bias<MODE>(pA0, pA1, j + 1, tab, cq, qabs, q0w, hi); partialSM(pA0, pA1, m_reg, alA);
        __syncthreads(); ATT_SWAIT(); ATT_SWRITE(1, SO);
        ATT_RESC(alA); __syncthreads();
    }
    ASBAR(); qkt<DQK>(pB0, pB1, K_lds + SHM_K, qr, r32, hi);
    finishSM(pA0, pA1, alA, l_reg, pa0, pa1, pa2, pa3); ASBAR();
    pv_all<NCB, MODE == 2>(o, vb0, pa0, pa1, pa2, pa3); apply_bias<MODE>(pB0, pB1, NT - 1, tab, cq, qabs, q0w, hi); partialSM(pB0, pB1, m_reg, alB);
    __syncthreads(); ATT_RESC(alB);
    finishSM(pB0, pB1, alB, l_reg, pa0, pa1, pa2, pa3); ASBAR();
    pv_all<NCB, MODE == 2>(o, vb0 + SHM_V, pa0, pa1, pa2, pa3);
    if (hi == 0) li_l[r32] = l_reg; asm volatile("s_waitcnt lgkmcnt(0)" ::: "memory");
    float rli[16];
#pragma unroll
    for (int r = 0; r < 16; ++r) rli[r] = __builtin_amdgcn_rcpf(li_l[crow(r, hi)]);
    bf16* Ow = Ob + (long)(wid * 32) * LDO;
#pragma unroll
    for (int r = 0; r < 16; ++r) { const int orow = crow(r, hi);
#pragma unroll
        for (int d0 = 0; d0 < NCB; ++d0) Ow[(long)orow * LDO + d0 * 32 + r32] = f2bf(o[d0][r] * rli[r]); }
    __syncthreads();
#undef ATT_SLOAD
#undef ATT_SWRITE
#undef ATT_SWAIT
#undef ATT_RESC
}
#undef ASBAR
#undef LDS3
}

#define GAS __attribute__((address_space(1)))
#define LAS __attribute__((address_space(3)))
typedef unsigned short bf16;
typedef unsigned v4u __attribute__((ext_vector_type(4)));
typedef float f32x4 __attribute__((ext_vector_type(4)));
typedef short bf16x8 __attribute__((ext_vector_type(8)));
typedef GAS unsigned gu32;
typedef GAS unsigned long long gu64;
#define RLX_AGENT __ATOMIC_RELAXED, __HIP_MEMORY_SCOPE_AGENT
#define LDS_WAIT() asm volatile("s_waitcnt lgkmcnt(0)" ::: "memory")
#define VM_WAIT() asm volatile("s_waitcnt vmcnt(0)" ::: "memory")
__device__ __forceinline__ unsigned long long rt() { return __builtin_amdgcn_s_memrealtime(); }
__device__ __forceinline__ unsigned f2bf(float f) { unsigned u = __builtin_bit_cast(unsigned, f); return (u + 0x7fffu + ((u >> 16) & 1u)) >> 16; }
__device__ __forceinline__ unsigned pk2(float lo, float hi) { return f2bf(lo) | (f2bf(hi) << 16); }

#define XB_TMO      128
#define XB_XCNT(j)  (256  + 64 * (j))
#define XB_XSUB(j)  (1280 + 64 * (j))
#define XB_XGEN(j)  (2304 + 64 * (j))
#define XB_TOP      3328
#define XB_TOPGEN   3392
#define XCD_BAR_WORDS 3456
#define XB_SPIN_CAP (1u << 18)

__device__ __forceinline__ unsigned xb_ld(unsigned* p)              { return __hip_atomic_load(p, __ATOMIC_RELAXED, __HIP_MEMORY_SCOPE_AGENT); }
__device__ __forceinline__ unsigned xb_add(unsigned* p, unsigned v) { return __hip_atomic_fetch_add(p, v, __ATOMIC_RELAXED, __HIP_MEMORY_SCOPE_AGENT); }
__device__ __forceinline__ unsigned xb_xcc_id() { return (unsigned)__builtin_amdgcn_s_getreg((3 << 11) | 20) & 0xFu; }
#define XB_SPIN(cond, bar) do { unsigned _sp = 0; while (cond) { __builtin_amdgcn_s_sleep(1); \
    if ((++_sp & 255u) == 0u) { if (xb_ld(&(bar)[XB_TMO])) break; if (_sp > XB_SPIN_CAP) { atomicAdd(&(bar)[XB_TMO], 1u); break; } } } } while (0)

struct XcdBarrier {
    unsigned* bar; unsigned x;
    volatile LAS unsigned* st;
};

__device__ __forceinline__ XcdBarrier xcd_barrier_post(unsigned* bar, volatile LAS unsigned* st) {
    XcdBarrier b; b.bar = bar; b.x = xb_xcc_id(); b.st = st;
    if (threadIdx.x == 0) (void)xb_add(&bar[XB_XCNT(b.x)], 1u);
    return b;
}
__device__ __forceinline__ void xcd_barrier_complete(unsigned* bar, unsigned x, unsigned& nloc, unsigned& nx) {
    const unsigned G = gridDim.x * gridDim.y * gridDim.z;
    unsigned sum, cnt, mine, sp = 0u;
    for (;;) {
        sum = 0u; cnt = 0u; mine = 0u;
#pragma unroll
        for (unsigned j = 0; j < 16; ++j) { const unsigned c = xb_ld(&bar[XB_XCNT(j)]); sum += c; cnt += (c > 0u) ? 1u : 0u; mine = (j == x) ? c : mine; }
        if (sum == G) break;
        __builtin_amdgcn_s_sleep(1);
        if ((++sp & 255u) == 0u) { if (xb_ld(&bar[XB_TMO])) break; if (sp > XB_SPIN_CAP) { atomicAdd(&bar[XB_TMO], 1u); break; } }
    }
    nloc = mine > 0u ? mine : 1u; nx = cnt > 0u ? cnt : 1u;
}

__device__ __forceinline__ void xcd_barrier(const XcdBarrier& b) {
    asm volatile("s_waitcnt vmcnt(0)" ::: "memory");
    __syncthreads();
    if (threadIdx.x == 0) {
        unsigned* bar = b.bar;
        __builtin_amdgcn_s_waitcnt(0);
        unsigned nloc = b.st[0], nx = b.st[1];
        if (nloc == 0u) { xcd_barrier_complete(bar, b.x, nloc, nx); b.st[0] = nloc; b.st[1] = nx; }
        const unsigned old = xb_add(&bar[XB_XSUB(b.x)], 1u);
        const unsigned gen = old / nloc;
        if (old + 1u == (gen + 1u) * nloc) {
            __builtin_amdgcn_fence(__ATOMIC_RELEASE, "agent");
            asm volatile("s_waitcnt vmcnt(0)" ::: "memory");
            const unsigned og = xb_add(&bar[XB_TOP], 1u);
            const unsigned tg = og / nx;
            if (og + 1u == (tg + 1u) * nx) xb_add(&bar[XB_TOPGEN], 1u);
            else XB_SPIN(xb_ld(&bar[XB_TOPGEN]) == tg, bar);
            __builtin_amdgcn_fence(__ATOMIC_ACQUIRE, "agent");
            xb_add(&bar[XB_XGEN(b.x)], 1u);
            asm volatile("s_waitcnt vmcnt(0)" ::: "memory");
        } else {
            XB_SPIN(xb_ld(&bar[XB_XGEN(b.x)]) == gen, bar);
            __builtin_amdgcn_fence(__ATOMIC_ACQUIRE, "agent");
            asm volatile("s_waitcnt vmcnt(0)" ::: "memory");
        }
    }
    __syncthreads();
}

constexpr int NWAVES = 8;
#ifndef MK_PER_PHASE
#define MK_PER_PHASE 0
#endif
constexpr int BATCH = 8, SEQ = 2048, D = 1024, M = BATCH * SEQ, MEMLEN = 256, MMEM = BATCH * MEMLEN;
constexpr int EV_SRC_N = 2568, PW = 2560  , OD_SRC_N = 3072;
constexpr int FF = 2816, FE = 3584, NE = 8, XW = 512;
constexpr int PAIR_ROWS = 2 * M + NE * 256;
constexpr float EPS = 1e-6f;
constexpr float LOG2E = 1.4426950408889634f;
constexpr float C2_64 = 0.125f * LOG2E, C2_128 = 0.08838834764831845f * LOG2E;
constexpr float LAM_INIT = 0.35550906759096926f;
constexpr size_t MiB = 1u << 20;
constexpr size_t WS_CTL = 0, CTL_ZERO_BYTES = 1 * MiB;
constexpr size_t WS_W_EVIN = 1 * MiB;
constexpr size_t WS_W_MKV = WS_W_EVIN + 5 * MiB;
constexpr size_t WS_W_EVOUT = WS_W_MKV + 4 * MiB;
constexpr size_t WS_W_XQ = WS_W_EVOUT + 2 * MiB;
constexpr size_t WS_W_XO = WS_W_XQ + 2 * MiB;
constexpr size_t WS_W_F13 = WS_W_XO + 2 * MiB;
constexpr size_t WS_W_F2 = WS_W_F13 + 11 * MiB;
constexpr size_t WS_W_ODIN = WS_W_F2 + 6 * MiB;
constexpr size_t WS_W_ODOUT = WS_W_ODIN + 6 * MiB;
constexpr size_t WS_W_M13 = WS_W_ODOUT + 2 * MiB;
constexpr size_t WS_W_M2 = WS_W_M13 + 112 * MiB;
constexpr size_t WS_XB = WS_W_M2 + 56 * MiB;
constexpr size_t WS_SSQ = WS_XB + 32 * MiB;
constexpr size_t WS_FLOG = WS_SSQ + 1 * MiB;
constexpr size_t WS_C2 = WS_FLOG + 1 * MiB;
constexpr size_t WS_TOK = WS_C2 + 1 * MiB;
constexpr size_t WS_GATE = WS_TOK + 1 * MiB;
constexpr size_t WS_P = WS_GATE + 1 * MiB;
constexpr size_t WS_AG = WS_P + 80 * MiB;
constexpr size_t WS_OD = WS_AG + 32 * MiB;
constexpr size_t WS_MEMN = WS_OD + 32 * MiB;
constexpr size_t WS_KVM = WS_MEMN + 4 * MiB;
constexpr size_t WS_QX = WS_KVM + 8 * MiB;
constexpr size_t WS_OX = WS_QX + 16 * MiB;
constexpr size_t WS_ACT = WS_OX + 16 * MiB;
constexpr size_t WS_Y = WS_ACT + 238 * MiB;
constexpr size_t WS_HG = WS_P;
constexpr size_t WS_END = WS_Y + 68 * MiB;
static_assert((size_t)PAIR_ROWS * 1024 * 2 <= 68 * MiB && (size_t)PAIR_ROWS * 3584 * 2 <= 238 * MiB && (size_t)M * PW * 2 <= 80 * MiB, "d_ws map");
constexpr int CW_CNT = 64;
constexpr int CW_BAR = 4096;
constexpr int RING_OFF = 0, RING_BYTES = 131072;
constexpr int LDSCTL_OFF = RING_BYTES, MISC_OFF = LDSCTL_OFF + 320;
constexpr int LDS_BYTES = 147456;

struct Frame {
    LAS unsigned char* lds;
    volatile LAS unsigned* MISC;
    gu32* ctl;
    int tid, lane, wave;
    int vcu, G;
    const float* in[31];
    float* out; unsigned char* ws;
};
__device__ __forceinline__ float wave_sum(float v) {
#pragma unroll
    for (int o = 1; o < 64; o <<= 1) v += __shfl_xor(v, o);
    return v;
}
__device__ __forceinline__ float bf2f(unsigned short b) { return __builtin_bit_cast(float, (unsigned)b << 16); }
__device__ __forceinline__ float bflo(unsigned w) { return __builtin_bit_cast(float, w << 16); }
__device__ __forceinline__ float bfhi(unsigned w) { return __builtin_bit_cast(float, w & 0xffff0000u); }

__device__ __forceinline__ void xpose_item(const float* W, int ldw, int scol0, int k0, bf16* WT, int K, int drow0, const float* gain, float scale, LAS float* scr, int lane) {
#pragma unroll 8
    for (int i = 0; i < 32; ++i) { const int kk = 2 * i + (lane >> 5); const float g = gain ? gain[k0 + kk] * scale : scale; scr[kk * 33 + (lane & 31)] = W[(size_t)(k0 + kk) * ldw + scol0 + (lane & 31)] * g; }
    LDS_WAIT(); asm volatile("" ::: "memory");
    const int c = lane & 7;
#pragma unroll
    for (int j = 0; j < 4; ++j) { const int n = (lane >> 3) + 8 * j; const LAS float* s = scr + (8 * c) * 33 + n;
        v4u o; o.x = pk2(s[0 * 33], s[1 * 33]); o.y = pk2(s[2 * 33], s[3 * 33]); o.z = pk2(s[4 * 33], s[5 * 33]); o.w = pk2(s[6 * 33], s[7 * 33]);
        *(GAS v4u*)(WT + (size_t)(drow0 + n) * K + k0 + 8 * c) = o; }
    LDS_WAIT(); asm volatile("" ::: "memory");
}
enum { MAP_ID = 0, MAP_EVIN = 1, MAP_ODIN = 2, MAP_SWIGLU = 3 };
template <int MAP> __device__ __forceinline__ int map_col(int db, int F, float& scale) {
    scale = 1.0f;
    if constexpr (MAP == MAP_ID) return 32 * db;
    else if constexpr (MAP == MAP_EVIN) { if (db < 16) scale = C2_64; return db < 48 ? 32 * db : 1544 + 32 * (db - 48); }
    else if constexpr (MAP == MAP_ODIN) {
        if (db < 16) return 32 * db;
        if (db < 48) { const int t = (db - 16) >> 3, w = (db - 16) & 7; return w < 4 ? 512 + t * 128 + w * 32 : 1024 + t * 128 + (w - 4) * 32; }
        if (db < 64) scale = C2_64;
        return 1536 + 32 * (db - 48);
    } else { const int t = db >> 3, w = db & 7; return w < 4 ? t * 128 + w * 32 : F + t * 128 + (w - 4) * 32; }
}
template <int MAP> __device__ __forceinline__ void xpose_job(Frame& F, const float* W, int ldw, int K, int Ndst, int Fh, bf16* WT, const float* gain, float scale0, LAS float* scr) {
    const int gw = F.vcu * NWAVES + F.wave, NGW = F.G * NWAVES, nblk = Ndst / 32, nitems = (K / 64) * nblk;
    for (int it = gw; it < nitems; it += NGW) { const int kb = it / nblk, db = it % nblk; float sc; const int scol = map_col<MAP>(db, Fh, sc);
        xpose_item(W, ldw, scol, 64 * kb, WT, K, 32 * db, gain, sc * scale0, scr, F.lane); }
}
__device__ __forceinline__ void p0_prologue(Frame& F) {
    unsigned char* ws = F.ws;
    const int gw = F.vcu * NWAVES + F.wave, NGW = F.G * NWAVES, lane = F.lane;
    {
        LAS float* wfg = (LAS float*)(F.lds);
        const float* Win = F.in[6]; const float* gn = F.in[5];
        for (int u = F.tid; u < 8 * 1024; u += NWAVES * 64) { const int k = u >> 3, j = u & 7; wfg[j * 1024 + k] = Win[(size_t)k * EV_SRC_N + 1536 + j] * gn[k]; }
        __syncthreads();
        const float* x = F.in[0]; const float* bfp = F.in[7];
        bf16* XB = (bf16*)(ws + WS_XB); float* SSQ = (float*)(ws + WS_SSQ); float* FLOG = (float*)(ws + WS_FLOG);
        for (int m = gw; m < M; m += NGW) {
            const GAS f32x4* xr = (const GAS f32x4*)(x + (size_t)m * D) + lane;
            f32x4 v[4]; float s = 0.f;
#pragma unroll
            for (int j = 0; j < 4; ++j) { v[j] = xr[64 * j]; s += (v[j].x * v[j].x + v[j].y * v[j].y) + (v[j].z * v[j].z + v[j].w * v[j].w); }
            const float ssq = wave_sum(s), rs = __builtin_amdgcn_rsqf(ssq * (1.0f / D) + EPS);
            GAS unsigned long long* o8 = (GAS unsigned long long*)(XB + (size_t)m * D) + lane;
#pragma unroll
            for (int j = 0; j < 4; ++j) o8[64 * j] = (unsigned long long)pk2(v[j].x, v[j].y) | ((unsigned long long)pk2(v[j].z, v[j].w) << 32);
            float f[8];
#pragma unroll
            for (int c = 0; c < 8; ++c) { float a = 0.f;
#pragma unroll
                for (int j = 0; j < 4; ++j) { const f32x4 w = *(const LAS f32x4*)(wfg + c * 1024 + 4 * lane + 256 * j); a += (v[j].x * w.x + v[j].y * w.y) + (v[j].z * w.z + v[j].w * w.w); }
                f[c] = wave_sum(a); }
            float fl = f[0];
#pragma unroll
            for (int c = 1; c < 8; ++c) fl = (lane == c) ? f[c] : fl;
            if (lane < 8) { const float z = fl * rs + bfp[lane]; FLOG[(size_t)m * 8 + lane] = fminf(z, 0.f) - log1pf(expf(-fabsf(z))); }
            if (lane < 16) SSQ[(size_t)m * 16 + lane] = (lane == 0) ? ssq : 0.f;
        }
        const float* mem = F.in[1]; const float* mg = F.in[3]; bf16* MEMN = (bf16*)(ws + WS_MEMN);
        for (int m = gw; m < MMEM; m += NGW) {
            const GAS f32x4* xr = (const GAS f32x4*)(mem + (size_t)m * D) + lane; const GAS f32x4* gr = (const GAS f32x4*)mg + lane;
            f32x4 v[4]; float s = 0.f;
#pragma unroll
            for (int j = 0; j < 4; ++j) { v[j] = xr[64 * j]; s += (v[j].x * v[j].x + v[j].y * v[j].y) + (v[j].z * v[j].z + v[j].w * v[j].w); }
            const float rs = __builtin_amdgcn_rsqf(wave_sum(s) * (1.0f / D) + EPS);
            GAS unsigned long long* o8 = (GAS unsigned long long*)(MEMN + (size_t)m * D) + lane;
#pragma unroll
            for (int j = 0; j < 4; ++j) { const f32x4 g = gr[64 * j]; o8[64 * j] = (unsigned long long)pk2(v[j].x * rs * g.x, v[j].y * rs * g.y) | ((unsigned long long)pk2(v[j].z * rs * g.z, v[j].w * rs * g.w) << 32); }
        }
        __syncthreads();
    }
    LAS float* scr = (LAS float*)(F.lds + RING_OFF + F.wave * 16384);
    xpose_job<MAP_EVIN>(F, F.in[6], EV_SRC_N, D, 2560, 0, (bf16*)(ws + WS_W_EVIN), F.in[5], 1.f, scr);
    for (int l = 0; l < 2; ++l) xpose_job<MAP_ID>(F, F.in[28] + (size_t)l * D * 1024, 1024, D, 1024, 0, (bf16*)(ws + WS_W_MKV) + (size_t)l * 1024 * D, nullptr, 1.f, scr);
    xpose_job<MAP_ID>(F, F.in[11], D, D, D, 0, (bf16*)(ws + WS_W_EVOUT), nullptr, 1.f, scr);
    for (int l = 0; l < 2; ++l) xpose_job<MAP_ID>(F, F.in[27] + (size_t)l * D * XW, XW, D, XW, 0, (bf16*)(ws + WS_W_XQ) + (size_t)l * XW * D, F.in[26] + l * D, C2_128, scr);
    for (int l = 0; l < 2; ++l) xpose_job<MAP_ID>(F, F.in[29] + (size_t)l * XW * D, D, XW, D, 0, (bf16*)(ws + WS_W_XO) + (size_t)l * D * XW, nullptr, 1.f, scr);
    xpose_job<MAP_SWIGLU>(F, F.in[12], 2 * FF, D, 2 * FF, FF, (bf16*)(ws + WS_W_F13), F.in[30], 1.f, scr);
    xpose_job<MAP_ID>(F, F.in[13], D, FF, D, 0, (bf16*)(ws + WS_W_F2), nullptr, 1.f, scr);
    xpose_job<MAP_ODIN>(F, F.in[15], OD_SRC_N, D, 3072, 0, (bf16*)(ws + WS_W_ODIN), F.in[14], 1.f, scr);
    xpose_job<MAP_ID>(F, F.in[22], D, D, D, 0, (bf16*)(ws + WS_W_ODOUT), nullptr, 1.f, scr);
    for (int e = 0; e < NE; ++e) xpose_job<MAP_SWIGLU>(F, F.in[24] + (size_t)e * D * 2 * FE, 2 * FE, D, 2 * FE, FE, (bf16*)(ws + WS_W_M13) + (size_t)e * 2 * FE * D, nullptr, 1.f, scr);
    for (int e = 0; e < NE; ++e) xpose_job<MAP_ID>(F, F.in[25] + (size_t)e * FE * D, D, FE, D, 0, (bf16*)(ws + WS_W_M2) + (size_t)e * D * FE, nullptr, 1.f, scr);
}
__device__ __forceinline__ void cumsum_seq(Frame& F, int sq) {
    const float* FLOG = (const float*)(F.ws + WS_FLOG); float* C2 = (float*)(F.ws + WS_C2);
    const int b = sq >> 3, h = sq & 7, lane = F.lane;
    const float* src = FLOG + ((size_t)b * SEQ + 32 * lane) * 8 + h;
    float v[32]; float run = 0.f;
#pragma unroll
    for (int i = 0; i < 32; ++i) { run += src[i * 8]; v[i] = run; }
    float tot = run;
#pragma unroll
    for (int o = 1; o < 64; o <<= 1) { const float t = __shfl_up(tot, o); if (lane >= o) tot += t; }
    const float base = tot - run;
    float* dst = C2 + (size_t)sq * SEQ + 32 * lane;
#pragma unroll
    for (int i = 0; i < 32; ++i) dst[i] = (base + v[i]) * LOG2E;
}
__device__ __forceinline__ void sgu_unit(Frame& F, int b, int c, int g) {
    typedef att::bf16x8 bf16x8; typedef att::f32x16 f32x16;
    constexpr int LP = 136;
    LAS unsigned short* Wl = (LAS unsigned short*)(F.lds); LAS unsigned short* Vt = Wl + 128 * LP;
    const int tid = F.tid, lane = F.lane, wid = F.wave, r32 = lane & 31, hi = lane >> 5;
    const bf16* P = (const bf16*)(F.ws + WS_P); bf16* AG = (bf16*)(F.ws + WS_AG);
    const size_t row0 = (size_t)b * SEQ + (size_t)c * 128;
    {
        const int t = tid >> 2, s0 = (tid & 3) * 32; const float* wp = F.in[9] + ((size_t)g * 128 + t) * 128 + s0;
#pragma unroll
        for (int i = 0; i < 8; ++i) { f32x4 w = ((const f32x4*)wp)[i]; const int s = s0 + 4 * i;
            w.x = (s + 0 <= t) ? w.x : 0.f; w.y = (s + 1 <= t) ? w.y : 0.f; w.z = (s + 2 <= t) ? w.z : 0.f; w.w = (s + 3 <= t) ? w.w : 0.f;
            *(LAS unsigned long long*)(Wl + t * LP + s) = (unsigned long long)pk2(w.x, w.y) | ((unsigned long long)pk2(w.z, w.w) << 32); }
    }
    {
        const int s = tid >> 2, d0 = (tid & 3) * 32; const bf16* vp = P + (row0 + s) * PW + 2048 + g * 128 + d0; const float* gn = F.in[8] + g * 128 + d0;
        float v[32]; float ss = 0.f;
#pragma unroll
        for (int i = 0; i < 4; ++i) { const v4u w = ((const v4u*)vp)[i];
            v[8 * i + 0] = bflo(w.x); v[8 * i + 1] = bfhi(w.x); v[8 * i + 2] = bflo(w.y); v[8 * i + 3] = bfhi(w.y); v[8 * i + 4] = bflo(w.z); v[8 * i + 5] = bfhi(w.z); v[8 * i + 6] = bflo(w.w); v[8 * i + 7] = bfhi(w.w); }
#pragma unroll
        for (int i = 0; i < 32; ++i) ss += v[i] * v[i];
        ss += __shfl_xor(ss, 1); ss += __shfl_xor(ss, 2);
        const float rs = __builtin_amdgcn_rsqf(ss * (1.0f / 128.0f) + EPS);
#pragma unroll
        for (int i = 0; i < 32; ++i) Vt[(d0 + i) * LP + s] = (unsigned short)f2bf(v[i] * rs * gn[i]);
    }
    __syncthreads();
    const int wt = wid >> 1, wd = wid & 1;
    f32x16 acc0 = f32x16{}, acc1 = f32x16{};
    for (int ks = 0; ks < 2 * (wt + 1); ++ks) {
        const bf16x8 a = *(const LAS bf16x8*)(Wl + (32 * wt + r32) * LP + 16 * ks + 8 * hi);
        const bf16x8 b0 = *(const LAS bf16x8*)(Vt + (64 * wd + r32) * LP + 16 * ks + 8 * hi), b1 = *(const LAS bf16x8*)(Vt + (64 * wd + 32 + r32) * LP + 16 * ks + 8 * hi);
        acc0 = __builtin_amdgcn_mfma_f32_32x32x16_bf16(a, b0, acc0, 0, 0, 0); acc1 = __builtin_amdgcn_mfma_f32_32x32x16_bf16(a, b1, acc1, 0, 0, 0);
    }
    const float* bsp = F.in[10] + g * 128;
#pragma unroll
    for (int r = 0; r < 16; ++r) { const int t = 32 * wt + att::crow(r, hi); const float bs = bsp[t];
        const bf16* up = P + (row0 + t) * PW + 1536 + g * 128 + 64 * wd + r32; bf16* op = AG + (row0 + t) * D + 512 + g * 128 + 64 * wd + r32;
        op[0] = (bf16)f2bf(bf2f(up[0]) * (acc0[r] + bs)); op[32] = (bf16)f2bf(bf2f(up[32]) * (acc1[r] + bs)); }
    __syncthreads();
}
__device__ __forceinline__ void odd_glue_phase(Frame& F) {
    const int gw = F.vcu * NWAVES + F.wave, NGW = F.G * NWAVES, lane = F.lane;
    const bf16* P = (const bf16*)(F.ws + WS_P); const bf16* OD0 = (const bf16*)(F.ws + WS_OD); const bf16* OD1 = OD0 + (size_t)M * 512; bf16* CD = (bf16*)(F.ws + WS_AG);
    const float lam = expf(wave_sum(F.in[17][lane] * F.in[18][lane])) - expf(wave_sum(F.in[19][lane] * F.in[20][lane])) + LAM_INIT;
    const float* cw = F.in[16]; const float* sub = F.in[21];
    float w0[8], w1[8], w2[8], sg[8];
#pragma unroll
    for (int i = 0; i < 8; ++i) { w0[i] = cw[8 * lane + i]; w1[i] = cw[512 + 8 * lane + i]; w2[i] = cw[1024 + 8 * lane + i]; sg[i] = sub[(8 * lane + i) & 127] * (1.0f - LAM_INIT); }
    for (int m = gw; m < M; m += NGW) {
        const int t = m & (SEQ - 1);
        const bf16* pr = P + (size_t)m * PW + 8 * lane;
        const v4u bg = *(const v4u*)pr, x2 = *(const v4u*)(pr + 512);
        v4u x1 = (v4u){0u, 0u, 0u, 0u}, x0 = (v4u){0u, 0u, 0u, 0u};
        if (t >= 1) x1 = *(const v4u*)(pr + 512 - PW);
        if (t >= 2) x0 = *(const v4u*)(pr + 512 - 2 * PW);
        const unsigned bgw[4] = {bg.x, bg.y, bg.z, bg.w}, a2[4] = {x2.x, x2.y, x2.z, x2.w}, a1[4] = {x1.x, x1.y, x1.z, x1.w}, a0[4] = {x0.x, x0.y, x0.z, x0.w};
        unsigned oc[4];
#pragma unroll
        for (int i = 0; i < 4; ++i) {
            const float lo = bflo(bgw[i]) * (w0[2 * i] * bflo(a0[i]) + w1[2 * i] * bflo(a1[i]) + w2[2 * i] * bflo(a2[i]));
            const float hi = bfhi(bgw[i]) * (w0[2 * i + 1] * bfhi(a0[i]) + w1[2 * i + 1] * bfhi(a1[i]) + w2[2 * i + 1] * bfhi(a2[i]));
            oc[i] = pk2(lo, hi); }
        *(v4u*)(CD + (size_t)m * D + 8 * lane) = (v4u){oc[0], oc[1], oc[2], oc[3]};
        const v4u o0 = *(const v4u*)(OD0 + (size_t)m * 512 + 8 * lane), o1 = *(const v4u*)(OD1 + (size_t)m * 512 + 8 * lane);
        const unsigned p0[4] = {o0.x, o0.y, o0.z, o0.w}, p1[4] = {o1.x, o1.y, o1.z, o1.w};
        float dv[8]; float ss = 0.f;
#pragma unroll
        for (int i = 0; i < 4; ++i) { dv[2 * i] = bflo(p0[i]) - lam * bflo(p1[i]); dv[2 * i + 1] = bfhi(p0[i]) - lam * bfhi(p1[i]); ss += dv[2 * i] * dv[2 * i] + dv[2 * i + 1] * dv[2 * i + 1]; }
        ss += __shfl_xor(ss, 1); ss += __shfl_xor(ss, 2); ss += __shfl_xor(ss, 4); ss += __shfl_xor(ss, 8);
        const float rs = __builtin_amdgcn_rsqf(ss * (1.0f / 128.0f) + EPS);
        *(v4u*)(CD + (size_t)m * D + 512 + 8 * lane) = (v4u){pk2(dv[0] * rs * sg[0], dv[1] * rs * sg[1]), pk2(dv[2] * rs * sg[2], dv[3] * rs * sg[3]), pk2(dv[4] * rs * sg[4], dv[5] * rs * sg[5]), pk2(dv[6] * rs * sg[6], dv[7] * rs * sg[7])};
    }
}
__device__ __forceinline__ void router_phase(Frame& F) {
    const int gw = F.vcu * NWAVES + F.wave, NGW = F.G * NWAVES, lane = F.lane;
    LAS float* wrl = (LAS float*)(F.lds);
    { const float* Wr = F.in[23]; const float* gn = F.in[30] + D;
      for (int u = F.tid; u < 8 * 1024; u += NWAVES * 64) { const int k = u >> 3, e = u & 7; wrl[e * 1024 + k] = Wr[u] * gn[k]; } }
    __syncthreads();
    const float* X = F.out; unsigned* cnt = (unsigned*)(F.ctl + CW_CNT);
    int* TOKI = (int*)(F.ws + WS_TOK); float* TOKW = (float*)(F.ws + WS_TOK + 256 * 1024);
    for (int m = gw; m < M; m += NGW) {
        const GAS f32x4* xr = (const GAS f32x4*)(X + (size_t)m * D) + lane;
        f32x4 v[4]; float s = 0.f;
#pragma unroll
        for (int j = 0; j < 4; ++j) { v[j] = xr[64 * j]; s += (v[j].x * v[j].x + v[j].y * v[j].y) + (v[j].z * v[j].z + v[j].w * v[j].w); }
        const float rs = __builtin_amdgcn_rsqf(wave_sum(s) * (1.0f / D) + EPS);
        float lg[8];
#pragma unroll
        for (int e = 0; e < 8; ++e) { float a = 0.f;
#pragma unroll
            for (int j = 0; j < 4; ++j) { const f32x4 w = *(const LAS f32x4*)(wrl + e * 1024 + 4 * lane + 256 * j); a += (v[j].x * w.x + v[j].y * w.y) + (v[j].z * w.z + v[j].w * w.w); }
            lg[e] = wave_sum(a) * rs; }
        int i1 = 0; float v1 = lg[0];
#pragma unroll
        for (int e = 1; e < 8; ++e) if (lg[e] > v1) { v1 = lg[e]; i1 = e; }
        int i2 = -1; float v2 = -INFINITY;
#pragma unroll
        for (int e = 0; e < 8; ++e) if (e != i1 && lg[e] > v2) { v2 = lg[e]; i2 = e; }
        const float w1 = 1.0f / (1.0f + expf(v2 - v1)), w2 = 1.0f - w1;
        if (lane == 0) {
            const unsigned p1 = __hip_atomic_fetch_add(cnt + i1, 1u, RLX_AGENT), p2 = __hip_atomic_fetch_add(cnt + i2, 1u, RLX_AGENT);
            *(int4*)(TOKI + (size_t)m * 4) = make_int4(i1, i2, (int)p1, (int)p2);
            *(float4*)(TOKW + (size_t)m * 4) = make_float4(w1, w2, rs, 0.f);
        }
    }
}
__device__ __forceinline__ int moe_base(const unsigned* cnt, int e) {
    int b = 0;
#pragma unroll
    for (int j = 0; j < 8; ++j) b += (j < e) ? (int)((cnt[j] + 255u) >> 8) : 0;
    return b * 256;
}
__device__ __forceinline__ void gather_phase(Frame& F) {
    const int gw = F.vcu * NWAVES + F.wave, NGW = F.G * NWAVES, lane = F.lane;
    const float* X = F.out; const unsigned* cnt = (const unsigned*)(F.ctl + CW_CNT); const float* gn = F.in[30] + D;
    const int* TOKI = (const int*)(F.ws + WS_TOK); const float* TOKW = (const float*)(F.ws + WS_TOK + 256 * 1024); int* TOKP = (int*)(F.ws + WS_TOK + 512 * 1024);
    bf16* HG = (bf16*)(F.ws + WS_HG); float* GATE = (float*)(F.ws + WS_GATE);
    unsigned c8[8];
#pragma unroll
    for (int e = 0; e < 8; ++e) c8[e] = cnt[e];
    for (int m = gw; m < M; m += NGW) {
        const int4 ti = *(const int4*)(TOKI + (size_t)m * 4); const float4 tw = *(const float4*)(TOKW + (size_t)m * 4);
        const int p1 = moe_base(c8, ti.x) + ti.z, p2 = moe_base(c8, ti.y) + ti.w;
        const GAS f32x4* xr = (const GAS f32x4*)(X + (size_t)m * D) + lane; const GAS f32x4* gr = (const GAS f32x4*)gn + lane;
        GAS unsigned long long* o1 = (GAS unsigned long long*)(HG + (size_t)p1 * D) + lane; GAS unsigned long long* o2 = (GAS unsigned long long*)(HG + (size_t)p2 * D) + lane;
#pragma unroll
        for (int j = 0; j < 4; ++j) { const f32x4 v = xr[64 * j], g = gr[64 * j];
            const unsigned long long w = (unsigned long long)pk2(v.x * tw.z * g.x, v.y * tw.z * g.y) | ((unsigned long long)pk2(v.z * tw.z * g.z, v.w * tw.z * g.w) << 32);
            o1[64 * j] = w; o2[64 * j] = w; }
        if (lane == 0) { GATE[p1] = tw.x; GATE[p2] = tw.y; *(int2*)(TOKP + (size_t)m * 2) = make_int2(p1, p2); }
    }
}
__device__ __forceinline__ void final_phase(Frame& F) {
    const int gw = F.vcu * NWAVES + F.wave, NGW = F.G * NWAVES, lane = F.lane;
    float* X = F.out; const int* TOKP = (const int*)(F.ws + WS_TOK + 512 * 1024); const bf16* Y = (const bf16*)(F.ws + WS_Y); const float* gn = F.in[4];
    for (int m = gw; m < M; m += NGW) {
        const int2 pp = *(const int2*)(TOKP + (size_t)m * 2);
        GAS f32x4* xr = (GAS f32x4*)(X + (size_t)m * D) + lane; const GAS f32x4* gr = (const GAS f32x4*)gn + lane;
        const GAS unsigned long long* y1 = (const GAS unsigned long long*)(Y + (size_t)pp.x * D) + lane; const GAS unsigned long long* y2 = (const GAS unsigned long long*)(Y + (size_t)pp.y * D) + lane;
        f32x4 v[4]; float s = 0.f;
#pragma unroll
        for (int j = 0; j < 4; ++j) { v[j] = xr[64 * j]; const unsigned long long a = y1[64 * j], b = y2[64 * j];
            v[j].x += bflo((unsigned)a) + bflo((unsigned)b); v[j].y += bfhi((unsigned)a) + bfhi((unsigned)b);
            v[j].z += bflo((unsigned)(a >> 32)) + bflo((unsigned)(b >> 32)); v[j].w += bfhi((unsigned)(a >> 32)) + bfhi((unsigned)(b >> 32));
            s += (v[j].x * v[j].x + v[j].y * v[j].y) + (v[j].z * v[j].z + v[j].w * v[j].w); }
        const float rs = __builtin_amdgcn_rsqf(wave_sum(s) * (1.0f / D) + EPS);
#pragma unroll
        for (int j = 0; j < 4; ++j) { const f32x4 g = gr[64 * j]; xr[64 * j] = (f32x4){v[j].x * rs * g.x, v[j].y * rs * g.y, v[j].z * rs * g.z, v[j].w * rs * g.w}; }
    }
}

__device__ __forceinline__ void fox_sgu_phase(Frame& F) {
    using G = att::Geo<64, 64>;
    LAS char* lds = (LAS char*)F.lds;
    const bf16* P = (const bf16*)(F.ws + WS_P); bf16* AG = (bf16*)(F.ws + WS_AG); const float* C2 = (const float*)(F.ws + WS_C2);
    for (int pr = F.vcu; pr < 256; pr += F.G) {
        const int bh = pr >> 2, s = pr & 3, b = bh >> 3, h = bh & 7;
        LAS f32x4* tab = (LAS f32x4*)(lds + G::TAB_OFF);
        for (int u = F.tid; u < SEQ / 4; u += NWAVES * 64) tab[u] = ((const f32x4*)(C2 + (size_t)bh * SEQ))[u];
        __syncthreads();
        for (int k = 0; k < 2; ++k) { const int qb = (k == 0) ? 7 - s : s; const size_t row0 = (size_t)b * SEQ + (size_t)qb * 256, kv0 = (size_t)b * SEQ * PW;
            att::attn_unit<64, 64, 1, PW, PW, D>(P + row0 * PW + h * 64, P + kv0 + 512 + h * 64, P + kv0 + 1024 + h * 64, AG + row0 * D + h * 64, 4 * (qb + 1), qb * 256, lds); }
    }
    for (int u = F.vcu; u < 512; u += F.G) sgu_unit(F, u >> 6, (u >> 2) & 15, u & 3);
}
__device__ __forceinline__ void diff_phase(Frame& F) {
    using G = att::Geo<64, 128>;
    LAS char* lds = (LAS char*)F.lds;
    const bf16* P = (const bf16*)(F.ws + WS_P); bf16* OD = (bf16*)(F.ws + WS_OD); const float* RB = F.in[2];
    for (int pr = F.vcu; pr < 256; pr += F.G) {
        const int bhi = pr >> 2, s = pr & 3, b = bhi >> 3, h = (bhi >> 1) & 3, i = bhi & 1;
        LAS float* tab = (LAS float*)(lds + G::TAB_OFF);
        if (F.tid < 128) { const int d = F.tid; int bk = d;
            if (d >= 16) { bk = 16 + (int)(logf((float)d * (1.0f / 16.0f)) / logf(8.0f) * 16.0f); bk = bk > 31 ? 31 : bk; }
            tab[d] = RB[bk * 4 + h] * LOG2E; }
        __syncthreads();
        for (int k = 0; k < 2; ++k) { const int qb = (k == 0) ? 7 - s : s; const size_t row0 = (size_t)b * SEQ + (size_t)qb * 256, kv0 = (size_t)b * SEQ * PW;
            att::attn_unit<64, 128, 2, PW, PW, 512>(P + row0 * PW + 1024 + h * 128 + i * 64, P + kv0 + 1536 + h * 128 + i * 64, P + kv0 + 2048 + h * 128, OD + (size_t)i * M * 512 + row0 * 512 + h * 128, 4 * (qb + 1), qb * 256, lds); }
    }
}
__device__ __forceinline__ void xattn_phase(Frame& F, int layer) {
    LAS char* lds = (LAS char*)F.lds;
    const bf16* QX = (const bf16*)(F.ws + WS_QX); const bf16* KVM = (const bf16*)(F.ws + WS_KVM); bf16* OX = (bf16*)(F.ws + WS_OX);
    for (int u = F.vcu; u < 256; u += F.G) { const int b = u >> 5, h = (u >> 3) & 3, qb = u & 7; const size_t row0 = (size_t)b * SEQ + (size_t)qb * 256;
        const bf16* kp = KVM + (size_t)b * MEMLEN * 2048 + layer * 1024 + h * 128;
        att::attn_unit<128, 128, 0, 512, 2048, 512>(QX + row0 * 512 + h * 128, kp, kp + 512, OX + row0 * 512 + h * 128, 4, 0, lds); }
}

struct Args { const float* in[31]; float* out; unsigned char* ws; int ph_lo, ph_hi; };
constexpr int N_PHASES = 21;
__global__ void __launch_bounds__(NWAVES * 64, 2) hyb_fwd(Args args) {
    extern __shared__ __attribute__((aligned(16))) unsigned char lds[];
    Frame F;
    F.lds = (LAS unsigned char*)lds;
    F.MISC = (volatile LAS unsigned*)(F.lds + MISC_OFF);
    F.tid = threadIdx.x; F.lane = F.tid & 63; F.wave = __builtin_amdgcn_readfirstlane(F.tid >> 6);
    F.G = gridDim.x; { const int bx = blockIdx.x; F.vcu = (F.G % 8 == 0) ? (bx % 8) * (F.G / 8) + bx / 8 : bx; }
#pragma unroll
    for (int i = 0; i < 31; ++i) F.in[i] = args.in[i];
    F.out = args.out; F.ws = args.ws; F.ctl = (gu32*)(args.ws + WS_CTL);
    unsigned char* ws = args.ws;
    for (int u = F.tid; u < (LDS_BYTES - LDSCTL_OFF) / 4; u += NWAVES * 64) ((LAS unsigned*)(F.lds + LDSCTL_OFF))[u] = 0u;
    __syncthreads();
    XcdBarrier bar; bar.bar = (unsigned*)(F.ctl + CW_BAR); bar.x = 0; bar.st = nullptr;
    if (!MK_PER_PHASE) bar = xcd_barrier_post((unsigned*)(F.ctl + CW_BAR), F.MISC + 8);
#define GRID_BAR() do { if (!MK_PER_PHASE) xcd_barrier(bar); } while (0)
    const int lo = args.ph_lo, hi = args.ph_hi;
#ifndef PH_MASK
#define PH_MASK 0x1fffff
#endif
#define IN(k) (((PH_MASK >> (k)) & 1) && lo <= (k) && (k) < hi)
#define SEAM(k) do { if (IN(k) && IN((k) + 1)) GRID_BAR(); } while (0)
    const int bx = (int)blockIdx.x, G = F.G;
    bf16* XB = (bf16*)(ws + WS_XB); float* SSQ = (float*)(ws + WS_SSQ); bf16* P = (bf16*)(ws + WS_P); bf16* AG = (bf16*)(ws + WS_AG);
    bf16* QX = (bf16*)(ws + WS_QX); bf16* OX = (bf16*)(ws + WS_OX); bf16* ACT = (bf16*)(ws + WS_ACT);

    if (IN(0)) p0_prologue(F);
    SEAM(0);
    if (IN(1)) {
        if (F.wave == 0) for (int sq = G - 1 - bx; sq < 64; sq += G) cumsum_seq(F, sq);
        { pg8::Gemm g{XB, (const bf16*)(ws + WS_W_EVIN), M, 2560, D}; pg8::StaticOrder S; S.init(M, 2560, G, bx);
          pg8::EpiIn<0> E{P, SSQ}; pg8::gemm_phase<pg8::EpiIn<0>, pg8::StaticOrder, true, true>(F.lds + RING_OFF, g, S, E); }
        { pg8::Gemm g{(const bf16*)(ws + WS_MEMN), (const bf16*)(ws + WS_W_MKV), MMEM, 2048, D}; pg8::StaticOrder S; S.init(MMEM, 2048, G, (bx + G / 2) % G);
          pg8::EpiPlain E{(bf16*)(ws + WS_KVM), 2048, nullptr}; pg8::gemm_phase<pg8::EpiPlain, pg8::StaticOrder, true, true>(F.lds + RING_OFF, g, S, E); }
    }
    SEAM(1);
    if (IN(2)) fox_sgu_phase(F);
    SEAM(2);
    if (IN(3)) { pg8::Gemm g{AG, (const bf16*)(ws + WS_W_EVOUT), M, D, D}; pg8::StaticOrder S; S.init(M, D, G, bx);
        pg8::EpiResid E{F.in[0], F.out, XB, SSQ}; pg8::gemm_phase<pg8::EpiResid, pg8::StaticOrder, true, true>(F.lds + RING_OFF, g, S, E); }
    SEAM(3);
    if (IN(4)) { pg8::Gemm g{XB, (const bf16*)(ws + WS_W_XQ), M, XW, D}; pg8::StaticOrder S; S.init(M, XW, G, bx);
        pg8::EpiPlain E{QX, XW, SSQ}; pg8::gemm_phase<pg8::EpiPlain, pg8::StaticOrder, true, true>(F.lds + RING_OFF, g, S, E); }
    SEAM(4);
    if (IN(5)) xattn_phase(F, 0);
    SEAM(5);
    if (IN(6)) { pg8::Gemm g{OX, (const bf16*)(ws + WS_W_XO), M, D, XW}; pg8::StaticOrder S; S.init(M, D, G, bx);
        pg8::EpiResid E{F.out, F.out, XB, SSQ}; pg8::gemm_phase<pg8::EpiResid, pg8::StaticOrder, true, true>(F.lds + RING_OFF, g, S, E); }
    SEAM(6);
    if (IN(7)) { pg8::Gemm g{XB, (const bf16*)(ws + WS_W_F13), M, 2 * FF, D}; pg8::StaticOrder S; S.init(M, 2 * FF, G, bx);
        pg8::EpiSwiglu<22> E{ACT, FF, SSQ}; pg8::gemm_phase<pg8::EpiSwiglu<22>, pg8::StaticOrder, true, true>(F.lds + RING_OFF, g, S, E); }
    SEAM(7);
    if (IN(8)) { pg8::Gemm g{ACT, (const bf16*)(ws + WS_W_F2), M, D, FF}; pg8::StaticOrder S; S.init(M, D, G, bx);
        pg8::EpiResid E{F.out, F.out, XB, SSQ}; pg8::gemm_phase<pg8::EpiResid, pg8::StaticOrder, true, true>(F.lds + RING_OFF, g, S, E); }
    SEAM(8);
    if (IN(9)) { pg8::Gemm g{XB, (const bf16*)(ws + WS_W_ODIN), M, 3072, D}; pg8::StaticOrder S; S.init(M, 3072, G, bx);
        pg8::EpiIn<1> E{P, SSQ}; pg8::gemm_phase<pg8::EpiIn<1>, pg8::StaticOrder, true, true>(F.lds + RING_OFF, g, S, E); }
    SEAM(9);
    if (IN(10)) diff_phase(F);
    SEAM(10);
    if (IN(11)) odd_glue_phase(F);
    SEAM(11);
    if (IN(12)) { pg8::Gemm g{AG, (const bf16*)(ws + WS_W_ODOUT), M, D, D}; pg8::StaticOrder S; S.init(M, D, G, bx);
        pg8::EpiResid E{F.out, F.out, XB, SSQ}; pg8::gemm_phase<pg8::EpiResid, pg8::StaticOrder, true, true>(F.lds + RING_OFF, g, S, E); }
    SEAM(12);
    if (IN(13)) { pg8::Gemm g{XB, (const bf16*)(ws + WS_W_XQ) + (size_t)XW * D, M, XW, D}; pg8::StaticOrder S; S.init(M, XW, G, bx);
        pg8::EpiPlain E{QX, XW, SSQ}; pg8::gemm_phase<pg8::EpiPlain, pg8::StaticOrder, true, true>(F.lds + RING_OFF, g, S, E); }
    SEAM(13);
    if (IN(14)) xattn_phase(F, 1);
    SEAM(14);
    if (IN(15)) { pg8::Gemm g{OX, (const bf16*)(ws + WS_W_XO) + (size_t)D * XW, M, D, XW}; pg8::StaticOrder S; S.init(M, D, G, bx);
        pg8::EpiResid E{F.out, F.out, XB, SSQ}; pg8::gemm_phase<pg8::EpiResid, pg8::StaticOrder, true, true>(F.lds + RING_OFF, g, S, E); }
    SEAM(15);
    if (IN(16)) router_phase(F);
    SEAM(16);
    if (IN(17)) gather_phase(F);
    SEAM(17);
    if (IN(18)) { pg8::Gemm g{(const bf16*)(ws + WS_HG), (const bf16*)(ws + WS_W_M13), PAIR_ROWS, NE * 2 * FE, D}; pg8::MoeOrder S; S.init((const unsigned*)(F.ctl + CW_CNT), 28, G, bx);
        pg8::EpiSwiglu<28> E{ACT, FE, nullptr}; pg8::gemm_phase<pg8::EpiSwiglu<28>, pg8::MoeOrder, true, true>(F.lds + RING_OFF, g, S, E); }
    SEAM(18);
    if (IN(19)) { pg8::Gemm g{ACT, (const bf16*)(ws + WS_W_M2), PAIR_ROWS, NE * D, FE}; pg8::MoeOrder S; S.init((const unsigned*)(F.ctl + CW_CNT), 4, G, bx);
        pg8::EpiY E{(bf16*)(ws + WS_Y), (const float*)(ws + WS_GATE)}; pg8::gemm_phase<pg8::EpiY, pg8::MoeOrder, true, true>(F.lds + RING_OFF, g, S, E); }
    SEAM(19);
    if (IN(20)) final_phase(F);
#undef IN
#undef SEAM
#undef GRID_BAR
}

extern "C" void kernel_launch(void* const* d_in, const int* in_sizes, int n_in, void* d_out, int out_size, void* d_ws, size_t ws_size, hipStream_t stream) {
    static int grid = 0;
    if (grid == 0) {
        if (n_in != 31 || in_sizes[0] != M * D || out_size != M * D || ws_size < WS_END) { fprintf(stderr, "kernel_launch: built for 31 inputs, x/out of %d floats, >= %zu bytes of workspace; got n_in %d, in0 %d, out %d, ws %zu; nothing launched\n", M * D, (size_t)WS_END, n_in, n_in > 0 ? in_sizes[0] : -1, out_size, ws_size); grid = -1; return; }
        int dev = 0, cus = 0, per_cu = 0;
        if (hipGetDevice(&dev) != hipSuccess || hipDeviceGetAttribute(&cus, hipDeviceAttributeMultiprocessorCount, dev) != hipSuccess) { fprintf(stderr, "kernel_launch: hipGetDevice / hipDeviceGetAttribute failed\n"); grid = -1; return; }
        if (hipFuncSetAttribute((const void*)hyb_fwd, hipFuncAttributeMaxDynamicSharedMemorySize, LDS_BYTES) != hipSuccess) { fprintf(stderr, "kernel_launch: hipFuncSetAttribute failed\n"); grid = -1; return; }
        if (hipOccupancyMaxActiveBlocksPerMultiprocessor(&per_cu, (const void*)hyb_fwd, NWAVES * 64, LDS_BYTES) != hipSuccess || per_cu < 1)
            fprintf(stderr, "kernel_launch: note: occupancy query reports %d workgroups per CU\n", per_cu);
        (void)hipGetLastError();
        grid = cus;
    }
    if (grid < 0) return;
    if (hipMemsetAsync((char*)d_ws + WS_CTL, 0, CTL_ZERO_BYTES, stream) != hipSuccess) { fprintf(stderr, "kernel_launch: hipMemsetAsync failed\n"); return; }
    Args a{};
    for (int i = 0; i < 31; ++i) a.in[i] = (const float*)d_in[i];
    a.out = (float*)d_out; a.ws = (unsigned char*)d_ws;
#if MK_PER_PHASE
    for (int p = 0; p < N_PHASES; ++p) { a.ph_lo = p; a.ph_hi = p + 1; hipLaunchKernelGGL(hyb_fwd, dim3(grid), dim3(NWAVES * 64), LDS_BYTES, stream, a); }
#else
    a.ph_lo = 0; a.ph_hi = N_PHASES;
    hipLaunchKernelGGL(hyb_fwd, dim3(grid), dim3(NWAVES * 64), LDS_BYTES, stream, a);
#endif
    const hipError_t le = hipPeekAtLastError();
    if (le != hipSuccess) fprintf(stderr, "kernel_launch: launch failed: %s (grid %d)\n", hipGetErrorName(le), grid);
}
```

```cpp
#include <hip/hip_runtime.h>
#include <cstdio>
#include <cstdint>
namespace pg8 {
#define PG8_LAS __attribute__((address_space(3)))
typedef unsigned short bf16_t;
typedef short bf16x8 __attribute__((ext_vector_type(8)));
typedef float f32x4 __attribute__((ext_vector_type(4)));
typedef unsigned u32x4 __attribute__((ext_vector_type(4)));
constexpr int BM = 256, BK = 64, HALF = 128, HTB = HALF * BK * 2  , STAGE_BYTES = 8 * HTB, NXCD = 8, WGM = 8;

__host__ __device__ __forceinline__ int lds_byte(int r, int c) { const int st = (r >> 4) * 2 + (c >> 5), rr = r & 15, cc = c & 31, ob = rr * 64 + cc * 2; return st * 1024 + (ob ^ (((ob >> 9) & 1) << 5)); }
__host__ __device__ __forceinline__ void stage_rc(int b, int& R, int& C) { const int st = b / 1024, sb = b % 1024, swz = sb ^ (((sb >> 9) & 1) << 5); R = (st >> 1) * 16 + swz / 64; C = (st & 1) * 32 + (swz % 64) / 2; }
__host__ __device__ __forceinline__ int perm32(int rho) { const int n = rho >> 4, i = rho & 15; return 8 * (i >> 2) + 4 * n + (i & 3); }

struct Unit { int pm, pn; int kofs = 0, nt = 0; };
struct Gemm { const bf16_t* A; const bf16_t* Bt; int M, N, K; };

struct StaticOrder {
    static constexpr bool VARK = false;
    int nM, nN, nwg, G, c;
    __host__ __device__ void init(int M, int N, int G_, int c_) { nM = M / BM; nN = N / BM; nwg = nM * nN; G = G_; c = c_; }
    __host__ __device__ bool next(int i, Unit& u) const {
        const long L = (long)i * G + c; if (L >= nwg) return false;
        int wgid = (int)L; { const int q = nwg / NXCD, r = nwg % NXCD, xcd = wgid % NXCD, off = wgid / NXCD; wgid = (xcd < r ? xcd * (q + 1) : r * (q + 1) + (xcd - r) * q) + off; }
        const int nig = WGM * nN, gid = wgid / nig, fm = gid * WGM, gsz = (nM - fm) < WGM ? (nM - fm) : WGM;
        u.pm = fm + ((wgid % nig) % gsz); u.pn = (wgid % nig) / gsz; return true;
    }
    __device__ __forceinline__ void a_ready(const Unit&) const {}
    __device__ __forceinline__ void done(const Unit&) const {}
};


__device__ __forceinline__ unsigned cvt_pk_bf16(float lo, float hi) { unsigned r; asm volatile("v_cvt_pk_bf16_f32 %0, %1, %2" : "=v"(r) : "v"(lo), "v"(hi)); return r; }
typedef float f32x2 __attribute__((ext_vector_type(2)));

__device__ __forceinline__ float gelu_tanh(float x) {
    const float z = x * (0.7978845608f + 0.0356774081f * x * x);
    return x * __builtin_amdgcn_rcpf(1.0f + __builtin_amdgcn_exp2f(-2.8853900818f * z));
}
__device__ __forceinline__ float silu_f(float x) { return x * __builtin_amdgcn_rcpf(1.0f + __builtin_amdgcn_exp2f(-1.4426950409f * x)); }
__device__ __forceinline__ u32x4 pack8(const f32x4 v0, const f32x4 v1) { u32x4 w; w.x = cvt_pk_bf16(v0[0], v0[1]); w.y = cvt_pk_bf16(v0[2], v0[3]); w.z = cvt_pk_bf16(v1[0], v1[1]); w.w = cvt_pk_bf16(v1[2], v1[3]); return w; }
__device__ __forceinline__ float rs_row(const float* ssq16, int row) {
    const f32x4* p = (const f32x4*)(ssq16 + (size_t)row * 16);
    const f32x4 a = p[0], b = p[1], c = p[2], d = p[3];
    const float s = (((a[0] + a[1]) + (a[2] + a[3])) + ((b[0] + b[1]) + (b[2] + b[3]))) + (((c[0] + c[1]) + (c[2] + c[3])) + ((d[0] + d[1]) + (d[2] + d[3])));
    return __builtin_amdgcn_rsqf(s * (1.0f / 1024.0f) + 1e-6f);
}
struct RsPre { f32x4 a, b; };
__device__ __forceinline__ void rs_issue(RsPre& r, const float* ssq16, int pm, int tid) { const f32x4* p = (const f32x4*)(ssq16 + (size_t)(pm * BM + (tid >> 1)) * 16 + (tid & 1) * 8); r.a = p[0]; r.b = p[1]; }
__device__ __forceinline__ void rs_finish(const RsPre& r, PG8_LAS float* tab, int tid) {
    float s = ((r.a[0] + r.a[1]) + (r.a[2] + r.a[3])) + ((r.b[0] + r.b[1]) + (r.b[2] + r.b[3]));
    s += __shfl_xor(s, 1);
    if (!(tid & 1)) tab[tid >> 1] = __builtin_amdgcn_rsqf(s * (1.0f / 1024.0f) + 1e-6f);
}
template <int ODD> struct EpiIn {
    static constexpr bool PERM = true, AFTER_DRAIN = false, RS = true;
    bf16_t* O; const float* ssq16;
    __device__ __forceinline__ void operator()(const f32x4 (&acc)[2][2][4][2], const Unit& u, int wr, int wc, int fr, int fq, const PG8_LAS float* rst) const {
        const int row0 = u.pm * BM + wr * 64 + fr, cw = wc * 32 + 8 * fq;
        int kind, colbase;
        if (!ODD) { kind = (u.pn >= 6) ? 1 : 0; colbase = u.pn * 256; }
        else { if (u.pn < 2) { kind = 0; colbase = u.pn * 256; } else if (u.pn < 6) { kind = 2; colbase = 512 + (u.pn - 2) * 128; } else { kind = 0; colbase = 1024 + (u.pn - 6) * 256; } }
#pragma unroll
        for (int ai = 0; ai < 2; ++ai)
#pragma unroll
            for (int m = 0; m < 4; ++m) {
                const int row = row0 + ai * HALF + m * 16; const float rs = rst[ai * HALF + wr * 64 + m * 16 + fr]; bf16_t* rowp = O + (size_t)row * 2560 + colbase + cw;
                if (kind == 2) { const f32x4 v0 = (acc[ai][0][m][0] * rs) * (acc[ai][1][m][0] * rs), v1 = (acc[ai][0][m][1] * rs) * (acc[ai][1][m][1] * rs); *(u32x4*)rowp = pack8(v0, v1); }
                else {
#pragma unroll
                    for (int bj = 0; bj < 2; ++bj) { f32x4 v0 = acc[ai][bj][m][0] * rs, v1 = acc[ai][bj][m][1] * rs;
                        if (kind == 1) {
#pragma unroll
                            for (int j = 0; j < 4; ++j) { v0[j] = gelu_tanh(v0[j]); v1[j] = gelu_tanh(v1[j]); } }
                        *(u32x4*)(rowp + bj * HALF) = pack8(v0, v1); } }
            }
    }
};
template <bool RS_> struct EpiPlain {
    static constexpr bool PERM = true, AFTER_DRAIN = false, RS = RS_;
    bf16_t* O; int ldc; const float* ssq16;
    __device__ __forceinline__ void operator()(const f32x4 (&acc)[2][2][4][2], const Unit& u, int wr, int wc, int fr, int fq, const PG8_LAS float* rst = nullptr) const {
        const int row0 = u.pm * BM + wr * 64 + fr, cw = u.pn * BM + wc * 32 + 8 * fq;
#pragma unroll
        for (int ai = 0; ai < 2; ++ai)
#pragma unroll
            for (int m = 0; m < 4; ++m) {
                const int row = row0 + ai * HALF + m * 16; float rs = 1.0f; if constexpr (RS_) rs = rst[ai * HALF + wr * 64 + m * 16 + fr]; bf16_t* rowp = O + (size_t)row * ldc + cw;
#pragma unroll
                for (int bj = 0; bj < 2; ++bj) *(u32x4*)(rowp + bj * HALF) = pack8(acc[ai][bj][m][0] * rs, acc[ai][bj][m][1] * rs);
            }
    }
};
template <int NPN> struct EpiSwiglu {
    static constexpr bool PERM = true, AFTER_DRAIN = false, RS = true;
    bf16_t* O; int ldc; const float* ssq16;
    __device__ __forceinline__ void operator()(const f32x4 (&acc)[2][2][4][2], const Unit& u, int wr, int wc, int fr, int fq, const PG8_LAS float* rst) const {
        const int row0 = u.pm * BM + wr * 64 + fr, cw = (u.pn % NPN) * HALF + wc * 32 + 8 * fq;
#pragma unroll
        for (int ai = 0; ai < 2; ++ai)
#pragma unroll
            for (int m = 0; m < 4; ++m) {
                const int row = row0 + ai * HALF + m * 16; const float rs = rst[ai * HALF + wr * 64 + m * 16 + fr];
                f32x4 v0, v1;
#pragma unroll
                for (int j = 0; j < 4; ++j) { v0[j] = silu_f(acc[ai][0][m][0][j] * rs) * (acc[ai][1][m][0][j] * rs); v1[j] = silu_f(acc[ai][0][m][1][j] * rs) * (acc[ai][1][m][1][j] * rs); }
                *(u32x4*)(O + (size_t)row * ldc + cw) = pack8(v0, v1);
            }
    }
};
template <int NPN, bool RS_> struct EpiSwigluF8 {
    static constexpr bool PERM = true, AFTER_DRAIN = false, RS = RS_;
    unsigned char* O; int ldc; float sc; const float* ssq16;
    __device__ __forceinline__ void operator()(const f32x4 (&acc)[2][2][4][2], const Unit& u, int wr, int wc, int fr, int fq, const PG8_LAS float* rst = nullptr) const {
        const int row0 = u.pm * BM + wr * 64 + fr, cw = (u.pn % NPN) * HALF + wc * 32 + 8 * fq;
#pragma unroll
        for (int ai = 0; ai < 2; ++ai)
#pragma unroll
            for (int m = 0; m < 4; ++m) {
                const int row = row0 + ai * HALF + m * 16; float s_ = sc; if constexpr (RS_) s_ *= rst[ai * HALF + wr * 64 + m * 16 + fr];
                float v[8];
                const float c1_ = -1.4426950409f * s_, is2_ = __builtin_amdgcn_rcpf(s_ * s_);
#pragma unroll
                for (int j = 0; j < 4; ++j) { const float g0 = acc[ai][0][m][0][j], g1 = acc[ai][0][m][1][j];
                    v[j] = (g0 * acc[ai][1][m][0][j]) * __builtin_amdgcn_rcpf(__builtin_fmaf(__builtin_amdgcn_exp2f(g0 * c1_), is2_, is2_));
                    v[4 + j] = (g1 * acc[ai][1][m][1][j]) * __builtin_amdgcn_rcpf(__builtin_fmaf(__builtin_amdgcn_exp2f(g1 * c1_), is2_, is2_)); }
                int w0 = __builtin_amdgcn_cvt_pk_fp8_f32(v[0], v[1], 0, false); w0 = __builtin_amdgcn_cvt_pk_fp8_f32(v[2], v[3], w0, true);
                int w1 = __builtin_amdgcn_cvt_pk_fp8_f32(v[4], v[5], 0, false); w1 = __builtin_amdgcn_cvt_pk_fp8_f32(v[6], v[7], w1, true);
                typedef int i32x2_t __attribute__((ext_vector_type(2)));
                *(i32x2_t*)(O + (size_t)row * ldc + cw) = (i32x2_t){w0, w1};
            }
    }
};
template <bool X8> struct EpiResid {
    static constexpr bool PERM = true, AFTER_DRAIN = false, RS = false;
    bf16_t* xb; float* ssq16; unsigned char* x8; float sc;
    __device__ __forceinline__ void operator()(const f32x4 (&acc)[2][2][4][2], const Unit& u, int wr, int wc, int fr, int fq) const {
        const int row0 = u.pm * BM + wr * 64 + fr, cw = u.pn * BM + wc * 32 + 8 * fq;
#pragma unroll
        for (int ai = 0; ai < 2; ++ai)
#pragma unroll
            for (int m = 0; m < 4; ++m) {
                const int row = row0 + ai * HALF + m * 16; const size_t off = (size_t)row * 1024 + cw; float s = 0.f;
#pragma unroll
                for (int bj = 0; bj < 2; ++bj) {
                    const u32x4 xo = *(const u32x4*)(xb + off + bj * HALF);
                    const f32x4 b0 = {__builtin_bit_cast(float, xo.x << 16), __builtin_bit_cast(float, xo.x & 0xffff0000u), __builtin_bit_cast(float, xo.y << 16), __builtin_bit_cast(float, xo.y & 0xffff0000u)};
                    const f32x4 b1 = {__builtin_bit_cast(float, xo.z << 16), __builtin_bit_cast(float, xo.z & 0xffff0000u), __builtin_bit_cast(float, xo.w << 16), __builtin_bit_cast(float, xo.w & 0xffff0000u)};
                    const f32x4 v0 = acc[ai][bj][m][0] * sc + b0, v1 = acc[ai][bj][m][1] * sc + b1;
                    *(u32x4*)(xb + off + bj * HALF) = pack8(v0, v1);
                    if constexpr (X8) { int w0 = __builtin_amdgcn_cvt_pk_fp8_f32(v0[0], v0[1], 0, false); w0 = __builtin_amdgcn_cvt_pk_fp8_f32(v0[2], v0[3], w0, true);
                        int w1 = __builtin_amdgcn_cvt_pk_fp8_f32(v1[0], v1[1], 0, false); w1 = __builtin_amdgcn_cvt_pk_fp8_f32(v1[2], v1[3], w1, true);
                        typedef int i32x2_t __attribute__((ext_vector_type(2))); *(i32x2_t*)(x8 + off + bj * HALF) = (i32x2_t){w0, w1}; }
                    s += ((v0[0] * v0[0] + v0[1] * v0[1]) + (v0[2] * v0[2] + v0[3] * v0[3])) + ((v1[0] * v1[0] + v1[1] * v1[1]) + (v1[2] * v1[2] + v1[3] * v1[3]));
                }
                s += __shfl_xor(s, 16); s += __shfl_xor(s, 32);
                if (fq == 0) ssq16[(size_t)row * 16 + u.pn * 4 + wc] = s;
            }
    }
};
struct EpiY {
    static constexpr bool PERM = true, AFTER_DRAIN = false, RS = false;
    bf16_t* Y; const float* gate; float sc; bf16_t* YP;
    __device__ __forceinline__ void operator()(const f32x4 (&acc)[2][2][4][2], const Unit& u, int wr, int wc, int fr, int fq) const {
        const int row0 = u.pm * BM + wr * 64 + fr, cw = (u.pn & 3) * BM + wc * 32 + 8 * fq;
        bf16_t* base = Y; size_t rofs = 0;
        if (u.pm >= 128) { base = YP + (size_t)(u.kofs >> 9) * (2048 * 1024); rofs = (size_t)128 * BM; }
#pragma unroll
        for (int ai = 0; ai < 2; ++ai)
#pragma unroll
            for (int m = 0; m < 4; ++m) {
                const int row = row0 + ai * HALF + m * 16; const float g = gate[row] * sc; bf16_t* rowp = base + ((size_t)row - rofs) * 1024 + cw;
#pragma unroll
                for (int bj = 0; bj < 2; ++bj) *(u32x4*)(rowp + bj * HALF) = pack8(acc[ai][bj][m][0] * g, acc[ai][bj][m][1] * g);
            }
    }
};
struct MoeOrder {
    static constexpr bool VARK = false;
    StaticOrder so; int NPN; const PG8_LAS int* texp;
    __device__ __forceinline__ void init(int T, const PG8_LAS int* texp_, int NPN_, int G, int c) { NPN = NPN_; texp = texp_; so.nM = T; so.nN = NPN_; so.nwg = T * NPN_; so.G = G; so.c = c; }
    __device__ __forceinline__ bool next(int i, Unit& u) const {
        if (!so.next(i, u)) return false;
        u.pn += __builtin_amdgcn_readfirstlane(texp[u.pm]) * NPN; return true;
    }
    __device__ __forceinline__ void a_ready(const Unit&) const {}
    __device__ __forceinline__ void done(const Unit&) const {}
};
struct MoeSplitOrder {
    static constexpr bool VARK = true;
    StaticOrder so; int T, G, c, ntf; const PG8_LAS int* texp;
    __device__ __forceinline__ void init(int T_, const PG8_LAS int* texp_, int G_, int c_, int ntf_) { T = T_; texp = texp_; G = G_; c = c_; ntf = ntf_; so.nM = 128; so.nN = 4; so.nwg = 512; so.G = G_; so.c = c_; }
    __device__ __forceinline__ bool next(int i, Unit& u) const {
        const int L = i * G + c; int pnl;
        if (L < 512) { so.next(i, u); pnl = u.pn; u.kofs = 0; u.nt = ntf; }
        else { const int Ls = L - 512; if (Ls >= (T - 128) * 28) return false;
            const int su = Ls / 7, sl = Ls - su * 7; u.pm = 128 + (su >> 2); pnl = su & 3; u.kofs = sl * 512; u.nt = 4; }
        u.pn = __builtin_amdgcn_readfirstlane(texp[u.pm]) * 4 + pnl; return true;
    }
    __device__ __forceinline__ void a_ready(const Unit&) const {}
    __device__ __forceinline__ void done(const Unit&) const {}
};
template <class Epi, class Sched, bool ALIGN_EPI = false, bool SP2 = false, bool FP8 = false>
__device__ __forceinline__ void gemm_phase(PG8_LAS unsigned char* lds, const Gemm g, const Sched& S, const Epi& E) {
    const int tid = threadIdx.x, wid = __builtin_amdgcn_readfirstlane(tid >> 6), lane = tid & 63, wr = wid >> 2, wc = wid & 3, fr = lane & 15, fq = lane >> 4;
    const int K = FP8 ? g.K / 2 : g.K  , nt = K / BK;
    typedef int v8i32_t __attribute__((ext_vector_type(8))); typedef short s16x16_t __attribute__((ext_vector_type(16)));
    unsigned voffA[2], voffB[2];
#pragma unroll
    for (int i = 0; i < 2; ++i) { int R, C; stage_rc(tid * 16 + i * 8192, R, C); const int Rb = Epi::PERM ? ((R & ~31) + perm32(R & 31)) : R;
        voffA[i] = (unsigned)(R * K + C) * 2u; voffB[i] = (unsigned)(Rb * K + C) * 2u; }
    const size_t kstep = (size_t)(BK * 2);
    const size_t hstep = (size_t)HALF * K * 2;
    const size_t tstep = 2 * hstep;
    const unsigned ldsw = (unsigned)wid * 1024u;
    const int aoff = lds_byte(wr * 64 + fr, fq * 8), boff = lds_byte(wc * 32 + fr, fq * 8);
#define PG8_SA(b, h) (((b) * 2 + (h)) * HTB)
#define PG8_SB(b, h) ((4 + (b) * 2 + (h)) * HTB)
#define PG8_STAGE(bufoff, gbase, voff) do { _Pragma("unroll") for (int _i = 0; _i < 2; ++_i) \
        __builtin_amdgcn_global_load_lds((const unsigned*)((const char*)(gbase) + (voff)[_i]), (PG8_LAS unsigned*)(lds + (bufoff) + ldsw + _i * 8192), 16, 0, 0); } while (0)
#define PG8_LDA(dst, b, h) do { _Pragma("unroll") for (int m = 0; m < 4; ++m) _Pragma("unroll") for (int k = 0; k < 2; ++k) dst[m][k] = *(const PG8_LAS bf16x8*)(lds + PG8_SA(b, h) + aoff + m * 2048 + k * 1024); } while (0)
#define PG8_LDB(dst, b, h) do { _Pragma("unroll") for (int n = 0; n < 2; ++n) _Pragma("unroll") for (int k = 0; k < 2; ++k) dst[n][k] = *(const PG8_LAS bf16x8*)(lds + PG8_SB(b, h) + boff + n * 2048 + k * 1024); } while (0)
#define PG8_CAT(x, y) __builtin_bit_cast(v8i32_t, __builtin_shufflevector((x), (y), 0, 1, 2, 3, 4, 5, 6, 7, 8, 9, 10, 11, 12, 13, 14, 15))
#define PG8_MMA(ai, bj, At, Bt) do { __builtin_amdgcn_s_setprio(1); _Pragma("unroll") for (int m = 0; m < 4; ++m) _Pragma("unroll") for (int n = 0; n < 2; ++n) { \
        if constexpr (FP8) { const v8i32_t b8_ = PG8_CAT(Bt[n][0], Bt[n][1]), a8_ = PG8_CAT(At[m][0], At[m][1]); asm volatile("v_mfma_f32_16x16x128_f8f6f4 %0, %1, %2, %0" : "+v"(acc[ai][bj][m][n]) : "v"(b8_), "v"(a8_)); } \
        else { _Pragma("unroll") for (int k = 0; k < 2; ++k) acc[ai][bj][m][n] = __builtin_amdgcn_mfma_f32_16x16x32_bf16(Bt[n][k], At[m][k], acc[ai][bj][m][n], 0, 0, 0); } } \
        __builtin_amdgcn_s_setprio(0); } while (0)
#define PG8_WAIT_V(n) asm volatile("s_waitcnt vmcnt(" #n ")" ::: "memory")
#define PG8_WAIT_L(n) asm volatile("s_waitcnt lgkmcnt(" #n ")" ::: "memory")
#define PG8_BAR __builtin_amdgcn_s_barrier()
#define PG8_SCHED __builtin_amdgcn_sched_barrier(0)
    Unit cur, nxt; int ui = 0;
    if (!S.next(0, cur)) return;
    f32x4 acc[2][2][4][2];
#pragma unroll
    for (int a = 0; a < 2; ++a)
#pragma unroll
        for (int b = 0; b < 2; ++b)
#pragma unroll
            for (int m = 0; m < 4; ++m)
#pragma unroll
                for (int n = 0; n < 2; ++n) acc[a][b][m][n] = (f32x4){0.f, 0.f, 0.f, 0.f};
    bf16x8 At[4][2], B0[2][2], B1[2][2];
    const char* cA = (const char*)g.A + (size_t)cur.pm * tstep + (Sched::VARK ? cur.kofs : 0); const char* cB = (const char*)g.Bt + (size_t)cur.pn * tstep + (Sched::VARK ? cur.kofs : 0);
    S.a_ready(cur);
    PG8_LAS float* const rstab = (PG8_LAS float*)(lds + STAGE_BYTES);
    if constexpr (Epi::RS) { RsPre r0_; rs_issue(r0_, E.ssq16, cur.pm, tid); rs_finish(r0_, rstab, tid); }
    if constexpr (SP2) {
        PG8_STAGE(PG8_SB(0, 0), cB, voffB); PG8_STAGE(PG8_SB(0, 1), cB + hstep, voffB); PG8_STAGE(PG8_SA(0, 0), cA, voffA); PG8_STAGE(PG8_SA(0, 1), cA + hstep, voffA);
        if (wr == 1) PG8_BAR;
        PG8_WAIT_V(2); PG8_BAR;
        PG8_STAGE(PG8_SB(1, 0), cB + kstep, voffB); PG8_STAGE(PG8_SA(1, 0), cA + kstep, voffA); PG8_STAGE(PG8_SB(1, 1), cB + hstep + kstep, voffB);
        PG8_WAIT_V(6); PG8_BAR;
    } else {
        PG8_STAGE(PG8_SB(0, 0), cB, voffB); PG8_STAGE(PG8_SA(0, 0), cA, voffA); PG8_STAGE(PG8_SB(0, 1), cB + hstep, voffB); PG8_STAGE(PG8_SA(0, 1), cA + hstep, voffA);
        if (wr == 1) PG8_BAR;
        PG8_WAIT_V(4); PG8_BAR;
        PG8_STAGE(PG8_SB(1, 0), cB + kstep, voffB); PG8_STAGE(PG8_SA(1, 0), cA + kstep, voffA); PG8_STAGE(PG8_SB(1, 1), cB + hstep + kstep, voffB);
        PG8_WAIT_V(6); PG8_BAR;
    }
    for (;;) {
        const bool has_next = S.next(ui + 1, nxt);
        const char* nA = has_next ? (const char*)g.A + (size_t)nxt.pm * tstep + (Sched::VARK ? nxt.kofs : 0) : cA; const char* nB = has_next ? (const char*)g.Bt + (size_t)nxt.pn * tstep + (Sched::VARK ? nxt.kofs : 0) : cB;
        const int ntu = Sched::VARK ? cur.nt : nt;
#pragma nounroll
        for (int t = 0; t < ntu; t += 2) {
            const bool last = (t == ntu - 2);
            const char* a1 = cA + (size_t)(t + 1) * kstep;
            const char* a2 = last ? nA : cA + (size_t)(t + 2) * kstep; const char* b2 = last ? nB : cB + (size_t)(t + 2) * kstep;
            const char* a3 = a2 + kstep; const char* b3 = b2 + kstep;
            if (last && has_next) S.a_ready(nxt);
            if constexpr (SP2) {
            PG8_LDB(B0, 0, 0); PG8_LDB(B1, 0, 1); PG8_SCHED; PG8_LDA(At, 0, 0); PG8_STAGE(PG8_SA(1, 1), a1 + hstep, voffA);
            PG8_WAIT_V(8); PG8_WAIT_L(0); PG8_BAR; PG8_MMA(0, 0, At, B0); PG8_MMA(0, 1, At, B1); PG8_BAR; PG8_SCHED;
            PG8_LDA(At, 0, 1); PG8_STAGE(PG8_SB(0, 0), b2, voffB); PG8_STAGE(PG8_SB(0, 1), b2 + hstep, voffB); PG8_STAGE(PG8_SA(0, 0), a2, voffA);
            PG8_WAIT_V(8); PG8_WAIT_L(0); PG8_BAR; PG8_MMA(1, 0, At, B0); PG8_MMA(1, 1, At, B1); PG8_BAR; PG8_SCHED;
            PG8_LDB(B0, 1, 0); PG8_LDB(B1, 1, 1); PG8_SCHED; PG8_LDA(At, 1, 0); PG8_STAGE(PG8_SA(0, 1), a2 + hstep, voffA);
            PG8_WAIT_V(8); PG8_WAIT_L(0); PG8_BAR; PG8_MMA(0, 0, At, B0); PG8_MMA(0, 1, At, B1); PG8_BAR; PG8_SCHED;
            PG8_LDA(At, 1, 1); PG8_STAGE(PG8_SB(1, 0), b3, voffB); PG8_STAGE(PG8_SB(1, 1), b3 + hstep, voffB); PG8_STAGE(PG8_SA(1, 0), a3, voffA);
            PG8_WAIT_V(8); PG8_WAIT_L(0); PG8_BAR; PG8_MMA(1, 0, At, B0); PG8_MMA(1, 1, At, B1); PG8_BAR; PG8_SCHED;
            } else {
            PG8_LDB(B0, 0, 0); PG8_SCHED; PG8_LDA(At, 0, 0); PG8_STAGE(PG8_SA(1, 1), a1 + hstep, voffA);
            PG8_WAIT_L(8); PG8_BAR; PG8_WAIT_L(0); PG8_MMA(0, 0, At, B0); PG8_BAR; PG8_SCHED;
            PG8_LDB(B1, 0, 1); PG8_STAGE(PG8_SB(0, 0), b2, voffB);
            PG8_BAR; PG8_WAIT_L(0); PG8_MMA(0, 1, At, B1); PG8_BAR;
            PG8_LDA(At, 0, 1); PG8_STAGE(PG8_SA(0, 0), a2, voffA);
            PG8_BAR; PG8_WAIT_L(0); PG8_MMA(1, 0, At, B0); PG8_BAR; PG8_SCHED;
            PG8_STAGE(PG8_SB(0, 1), b2 + hstep, voffB);
            PG8_WAIT_V(6); PG8_BAR; PG8_MMA(1, 1, At, B1); PG8_BAR;
            PG8_LDB(B0, 1, 0); PG8_SCHED; PG8_LDA(At, 1, 0); PG8_STAGE(PG8_SA(0, 1), a2 + hstep, voffA);
            PG8_WAIT_L(8); PG8_BAR; PG8_WAIT_L(0); PG8_MMA(0, 0, At, B0); PG8_BAR; PG8_SCHED;
            PG8_LDB(B1, 1, 1); PG8_STAGE(PG8_SB(1, 0), b3, voffB);
            PG8_BAR; PG8_WAIT_L(0); PG8_MMA(0, 1, At, B1); PG8_BAR;
            PG8_LDA(At, 1, 1); PG8_STAGE(PG8_SA(1, 0), a3, voffA);
            PG8_BAR; PG8_WAIT_L(0); PG8_MMA(1, 0, At, B0); PG8_BAR; PG8_SCHED;
            PG8_STAGE(PG8_SB(1, 1), b3 + hstep, voffB);
            PG8_WAIT_V(6); PG8_BAR; PG8_MMA(1, 1, At, B1); PG8_BAR;
            }
        }
        if constexpr (FP8) asm volatile("s_nop 15\n\ts_nop 15" ::: "memory");
        if constexpr (ALIGN_EPI) { if (wr == 0) PG8_BAR; }
        if constexpr (!Epi::AFTER_DRAIN) {
            if constexpr (Epi::RS) { RsPre rn_; if (has_next) rs_issue(rn_, E.ssq16, nxt.pm, tid);
                E(acc, cur, wr, wc, fr, fq, rstab + (ui & 1) * 256);
                if (has_next) rs_finish(rn_, rstab + ((ui + 1) & 1) * 256, tid); }
            else E(acc, cur, wr, wc, fr, fq);
            S.done(cur); }
        if (!has_next) break;
#pragma unroll
        for (int a = 0; a < 2; ++a)
#pragma unroll
            for (int b = 0; b < 2; ++b)
#pragma unroll
                for (int m = 0; m < 4; ++m)
#pragma unroll
                    for (int n = 0; n < 2; ++n) acc[a][b][m][n] = (f32x4){0.f, 0.f, 0.f, 0.f};
        cur = nxt; cA = nA; cB = nB; ++ui;
        if constexpr (ALIGN_EPI) { if (wr == 1) PG8_BAR; }
    }
    PG8_WAIT_V(0);
    if constexpr (!ALIGN_EPI) { if (wr == 0) PG8_BAR; }
    PG8_BAR;
    if constexpr (Epi::AFTER_DRAIN) { E.fused(acc, cur, wr, wc, fr, fq, lds, wid, lane); S.done(cur); }
#undef PG8_SA
#undef PG8_SB
#undef PG8_STAGE
#undef PG8_LDA
#undef PG8_LDB
#undef PG8_MMA
#undef PG8_CAT
#undef PG8_WAIT_V
#undef PG8_WAIT_L
#undef PG8_BAR
#undef PG8_SCHED
}
}

namespace att {
typedef unsigned short bf16;
using bf16x8 = __attribute__((ext_vector_type(8))) short;
using s16x4  = __attribute__((ext_vector_type(4))) short;
using f32x16 = __attribute__((ext_vector_type(16))) float;
using f32x4  = __attribute__((ext_vector_type(4))) float;
using u32x4  = __attribute__((ext_vector_type(4))) unsigned;
#define ASBAR() __builtin_amdgcn_sched_barrier(0)
#define LDS3 __attribute__((address_space(3)))
constexpr float THR2 = 40.0f;
__device__ __forceinline__ int crow(int r, int hi) { return (r & 3) + 8 * (r >> 2) + 4 * hi; }
__device__ __forceinline__ unsigned cvtpk(float lo, float hi) { unsigned r; asm volatile("v_cvt_pk_bf16_f32 %0, %1, %2" : "=v"(r) : "v"(lo), "v"(hi)); return r; }
__device__ __forceinline__ unsigned short f2bf(float f) { unsigned u = __builtin_bit_cast(unsigned, f); return (unsigned short)((u + 0x7fffu + ((u >> 16) & 1u)) >> 16); }
template <int DQK> __device__ __forceinline__ int kswz(int row, int colB) { return row * (DQK * 2) + (colB ^ ((row & 7) << 4)); }
template <int DQK, int DV> struct Geo {
    static constexpr int SHM_K = 64 * DQK * 2, SHM_V = 64 * DV * 2, NCB = DV / 32;
    static constexpr int WS_OFF = 2 * SHM_V + 2 * SHM_K, TAB_OFF = WS_OFF + 2048, BYTES = TAB_OFF + 8192;
};
__device__ __forceinline__ void partialSM_abs(f32x16& p0, f32x16& p1, float& m_reg, float& alpha, float cadd) {
    float pmax = p0[0];
#pragma unroll
    for (int r = 1; r < 16; ++r) pmax = fmaxf(pmax, p0[r]);
#pragma unroll
    for (int r = 0; r < 16; ++r) pmax = fmaxf(pmax, p1[r]);
    { auto rr = __builtin_amdgcn_permlane32_swap(__float_as_uint(pmax), __float_as_uint(pmax), false, false); pmax = fmaxf(__uint_as_float(rr[0]), __uint_as_float(rr[1])); }
    pmax += cadd;
    float mn;
    if (__builtin_expect(__all(pmax - m_reg <= THR2), 1)) { mn = m_reg; alpha = 1.f; }
    else { mn = fmaxf(m_reg, pmax); alpha = __builtin_amdgcn_exp2f(m_reg - mn); m_reg = mn; }
    const float sh = cadd - mn;
#pragma unroll
    for (int r = 0; r < 16; ++r) { p0[r] += sh; p1[r] += sh; }
#pragma unroll
    for (int r = 0; r < 16; ++r) p0[r] = __builtin_amdgcn_exp2f(p0[r]);
}
template <bool FIRST> __device__ __forceinline__ void partialSM_rel(f32x16& p0, f32x16& p1, float& m_reg, float& alpha, f32x16& cini, float cq) {
    float pmax = p0[0];
#pragma unroll
    for (int r = 1; r < 16; ++r) pmax = fmaxf(pmax, p0[r]);
#pragma unroll
    for (int r = 0; r < 16; ++r) pmax = fmaxf(pmax, p1[r]);
    { auto rr = __builtin_amdgcn_permlane32_swap(__float_as_uint(pmax), __float_as_uint(pmax), false, false); pmax = fmaxf(__uint_as_float(rr[0]), __uint_as_float(rr[1])); }
    alpha = 1.f;
    if (FIRST || !__builtin_expect(__all(pmax <= THR2), 1)) {
        const float dl = FIRST ? pmax : fmaxf(pmax, 0.f);
        if (!FIRST) alpha = __builtin_amdgcn_exp2f(-dl);
        m_reg += dl;
#pragma unroll
        for (int r = 0; r < 16; ++r) { p0[r] -= dl; p1[r] -= dl; cini[r] = cq - m_reg; }
    }
#pragma unroll
    for (int r = 0; r < 16; ++r) p0[r] = __builtin_amdgcn_exp2f(p0[r]);
}
__device__ __forceinline__ void finishSM(f32x16& p0, f32x16& p1, float alpha, float& l_reg, bf16x8& pa0, bf16x8& pa1, bf16x8& pa2, bf16x8& pa3) {
#pragma unroll
    for (int r = 0; r < 16; ++r) p1[r] = __builtin_amdgcn_exp2f(p1[r]);
    float ps = 0;
#pragma unroll
    for (int r = 0; r < 16; ++r) ps += p0[r];
#pragma unroll
    for (int r = 0; r < 16; ++r) ps += p1[r];
    { auto rr = __builtin_amdgcn_permlane32_swap(__float_as_uint(ps), __float_as_uint(ps), false, false); ps = __uint_as_float(rr[0]) + __uint_as_float(rr[1]); }
    l_reg = l_reg * alpha + ps;
#define ATT_PK4(P, BASE, OUT) do { unsigned a0 = cvtpk(P[BASE + 0], P[BASE + 1]), a1 = cvtpk(P[BASE + 2], P[BASE + 3]);   \
    unsigned b0 = cvtpk(P[BASE + 4], P[BASE + 5]), b1 = cvtpk(P[BASE + 6], P[BASE + 7]);                              \
    auto r0 = __builtin_amdgcn_permlane32_swap(a0, b0, false, false); auto r1 = __builtin_amdgcn_permlane32_swap(a1, b1, false, false); \
    u32x4 w = {r0[0], r1[0], r0[1], r1[1]}; OUT = *reinterpret_cast<bf16x8*>(&w); } while (0)
    ATT_PK4(p0, 0, pa0); ATT_PK4(p0, 8, pa1); ATT_PK4(p1, 0, pa2); ATT_PK4(p1, 8, pa3);
#undef ATT_PK4
}
template <int DQK, bool REL> __device__ __forceinline__ void qkt(f32x16& p0, f32x16& p1, const LDS3 char* Ks, const bf16x8* qr, int r32, int hi, const f32x16& cini, unsigned e0 = 0u, unsigned e1 = 0u) {
    const f32x16 z = f32x16{};
#pragma unroll
    for (int d0 = 0; d0 < DQK / 16; ++d0) { const int cb = (d0 * 16 + hi * 8) * 2;
        const bf16x8 b0 = *(const LDS3 bf16x8*)(Ks + kswz<DQK>(r32, cb));
        const bf16x8 b1 = *(const LDS3 bf16x8*)(Ks + kswz<DQK>(32 + r32, cb));
        p0 = __builtin_amdgcn_mfma_f32_32x32x16_bf16(b0, qr[d0], d0 == 0 ? (REL ? cini : z) : p0, 0, 0, 0);
        p1 = __builtin_amdgcn_mfma_f32_32x32x16_bf16(b1, qr[d0], d0 == 0 ? (REL ? cini : z) : p1, 0, 0, 0); }
    if constexpr (REL) {
        const u32x4 a0 = {hi ? 0u : e0, 0u, 0u, 0u}, a1 = {hi ? 0u : e1, 0u, 0u, 0u}, on = {hi ? 0u : 0x3F803F80u, 0u, 0u, 0u};
        p0 = __builtin_amdgcn_mfma_f32_32x32x16_bf16(__builtin_bit_cast(bf16x8, a0), __builtin_bit_cast(bf16x8, on), p0, 0, 0, 0);
        p1 = __builtin_amdgcn_mfma_f32_32x32x16_bf16(__builtin_bit_cast(bf16x8, a1), __builtin_bit_cast(bf16x8, on), p1, 0, 0, 0);
    }
}
template <int NCB> __device__ __forceinline__ int v_st(int k, int c) { const int kk = (k & ~0xC) | ((k & 4) << 1) | ((k & 8) >> 1); return ((kk >> 3) * NCB + (c >> 5)) * 512 + ((kk & 7) * 32 + (c & 31)) * 2; }
__device__ __forceinline__ int v_rd_base(int lane) { return ((lane & 3) << 3) | (((lane >> 2) & 3) << 6) | (((lane >> 4) & 1) << 5) | (((lane >> 5) & 1) << 8); }
template <int NCB> constexpr int v_rd_off(int d0, int ks, int half) { return d0 * 512 + ks * (2 * NCB * 512) + half * (NCB * 512); }
template <int OFF> __device__ __forceinline__ s16x4 tr_read(int vb) { s16x4 r; asm volatile("ds_read_b64_tr_b16 %0, %1 offset:%2" : "=&v"(r) : "v"(vb), "i"(OFF) : "memory"); return r; }
template <int NCB, int D0, bool SPLIT> __device__ __forceinline__ void pv_one(f32x16& od, int vb, bf16x8 pa0, bf16x8 pa1, bf16x8 pa2, bf16x8 pa3) {
#define ATT_PK(L, H) (bf16x8){L[0], L[1], L[2], L[3], H[0], H[1], H[2], H[3]}
    if constexpr (!SPLIT) {
        const s16x4 l0 = tr_read<v_rd_off<NCB>(D0, 0, 0)>(vb), h0 = tr_read<v_rd_off<NCB>(D0, 0, 1)>(vb), l1 = tr_read<v_rd_off<NCB>(D0, 1, 0)>(vb), h1 = tr_read<v_rd_off<NCB>(D0, 1, 1)>(vb);
        const s16x4 l2 = tr_read<v_rd_off<NCB>(D0, 2, 0)>(vb), h2 = tr_read<v_rd_off<NCB>(D0, 2, 1)>(vb), l3 = tr_read<v_rd_off<NCB>(D0, 3, 0)>(vb), h3 = tr_read<v_rd_off<NCB>(D0, 3, 1)>(vb);
        asm volatile("s_waitcnt lgkmcnt(0)" ::: "memory"); ASBAR();
        od = __builtin_amdgcn_mfma_f32_32x32x16_bf16(pa0, ATT_PK(l0, h0), od, 0, 0, 0);
        od = __builtin_amdgcn_mfma_f32_32x32x16_bf16(pa1, ATT_PK(l1, h1), od, 0, 0, 0);
        od = __builtin_amdgcn_mfma_f32_32x32x16_bf16(pa2, ATT_PK(l2, h2), od, 0, 0, 0);
        od = __builtin_amdgcn_mfma_f32_32x32x16_bf16(pa3, ATT_PK(l3, h3), od, 0, 0, 0);
    } else {
        { const s16x4 l0 = tr_read<v_rd_off<NCB>(D0, 0, 0)>(vb), h0 = tr_read<v_rd_off<NCB>(D0, 0, 1)>(vb), l1 = tr_read<v_rd_off<NCB>(D0, 1, 0)>(vb), h1 = tr_read<v_rd_off<NCB>(D0, 1, 1)>(vb);
          asm volatile("s_waitcnt lgkmcnt(0)" ::: "memory"); ASBAR();
          od = __builtin_amdgcn_mfma_f32_32x32x16_bf16(pa0, ATT_PK(l0, h0), od, 0, 0, 0);
          od = __builtin_amdgcn_mfma_f32_32x32x16_bf16(pa1, ATT_PK(l1, h1), od, 0, 0, 0); ASBAR(); }
        { const s16x4 l2 = tr_read<v_rd_off<NCB>(D0, 2, 0)>(vb), h2 = tr_read<v_rd_off<NCB>(D0, 2, 1)>(vb), l3 = tr_read<v_rd_off<NCB>(D0, 3, 0)>(vb), h3 = tr_read<v_rd_off<NCB>(D0, 3, 1)>(vb);
          asm volatile("s_waitcnt lgkmcnt(0)" ::: "memory"); ASBAR();
          od = __builtin_amdgcn_mfma_f32_32x32x16_bf16(pa2, ATT_PK(l2, h2), od, 0, 0, 0);
          od = __builtin_amdgcn_mfma_f32_32x32x16_bf16(pa3, ATT_PK(l3, h3), od, 0, 0, 0); ASBAR(); }
    }
#undef ATT_PK
}
template <int NCB, bool SPLIT> __device__ __forceinline__ void pv_all(f32x16* o, int vb, bf16x8 pa0, bf16x8 pa1, bf16x8 pa2, bf16x8 pa3) {
    pv_one<NCB, 0, SPLIT>(o[0], vb, pa0, pa1, pa2, pa3); pv_one<NCB, 1, SPLIT>(o[1], vb, pa0, pa1, pa2, pa3);
    if constexpr (NCB == 4) { pv_one<NCB, 2, SPLIT>(o[2], vb, pa0, pa1, pa2, pa3); pv_one<NCB, 3, SPLIT>(o[3], vb, pa0, pa1, pa2, pa3); }
}
template <int MODE> __device__ __forceinline__ bool t5_far(int kt, int q0w) { return MODE == 2 && q0w - (kt * 64 + 63) >= 113; }
template <int MODE> __device__ __forceinline__ void apply_bias(f32x16& p0, f32x16& p1, int kt, const LDS3 float* tab, int qabs, int q0w, int hi) {
    const int k0 = kt * 64;
    if constexpr (MODE == 1) {
        if (k0 + 63 > q0w) {
#pragma unroll
            for (int r = 0; r < 16; ++r) { const int kv = k0 + crow(r, hi); if (kv > qabs) p0[r] = -INFINITY; if (kv + 32 > qabs) p1[r] = -INFINITY; } }
    } else if constexpr (MODE == 2) {
        if (!t5_far<MODE>(kt, q0w)) {
            const int dq = qabs - k0 - 4 * hi;
#pragma unroll
            for (int g4 = 0; g4 < 4; ++g4) {
#pragma unroll
                for (int i = 0; i < 4; ++i) { const int r = 4 * g4 + i, d = dq - 8 * g4 - i, d1 = d - 32;
                    const int dc = d < 0 ? 0 : (d > 127 ? 127 : d), dc1 = d1 < 0 ? 0 : (d1 > 127 ? 127 : d1);
                    const float t0 = tab[dc], t1 = tab[dc1];
                    p0[r] = d < 0 ? -INFINITY : p0[r] + t0; p1[r] = d1 < 0 ? -INFINITY : p1[r] + t1; }
                asm volatile("" ::: "memory");
            } }
    }
}
template <int DQK, int DV, int MODE, int LDQ, int LDK, int LDO>
__device__ __forceinline__ void attn_unit(const bf16* __restrict__ Qb, const bf16* __restrict__ Kh, const bf16* __restrict__ Vh, bf16* __restrict__ Ob, int NT, int q0, LDS3 char* lds) {
    using G = Geo<DQK, DV>;
    constexpr int SHM_K = G::SHM_K, SHM_V = G::SHM_V, NCB = G::NCB, NKC = DQK / 64, NVC = DV / 64, KCPR = DQK / 8, VCPR = DV / 8;
    const int tid = threadIdx.x, wid = __builtin_amdgcn_readfirstlane(tid >> 6), lane = tid & 63, r32 = lane & 31, hi = lane >> 5;
    LDS3 char* V_lds = lds; LDS3 char* K_lds = lds + 2 * SHM_V;
    LDS3 float* ws = (LDS3 float*)(lds + G::WS_OFF) + wid * 64; LDS3 float* li_l = ws; LDS3 float* al_l = ws + 32;
    const LDS3 float* tab = (const LDS3 float*)(lds + G::TAB_OFF); const LDS3 unsigned* etab = (const LDS3 unsigned*)(lds + G::TAB_OFF);
    const int q0w = q0 + wid * 32, qabs = q0w + r32;
    float cq = 0.f; float b31 = 0.f;
    if constexpr (MODE == 1) { const unsigned e = etab[qabs]; cq = -(__builtin_bit_cast(float, e << 16) + __builtin_bit_cast(float, e & 0xffff0000u)); }
    if constexpr (MODE == 2) b31 = tab[127];
    float m_reg = (MODE == 1) ? 0.f : -1e30f, l_reg = 0; f32x16 cini;
#pragma unroll
    for (int r = 0; r < 16; ++r) cini[r] = cq; f32x16 o[NCB]; bf16x8 qr[DQK / 16];
#pragma unroll
    for (int d = 0; d < NCB; ++d) o[d] = f32x16{};
    const bf16* Qw = Qb + (long)(wid * 32 + r32) * LDQ + hi * 8;
#pragma unroll
    for (int d0 = 0; d0 < DQK / 16; ++d0) qr[d0] = *reinterpret_cast<const bf16x8*>(Qw + d0 * 16);
    int kgo[NKC], klo[NKC], vgo[NVC], vlo[NVC];
#pragma unroll
    for (int j = 0; j < NKC; ++j) { const int ci = tid + 512 * j, row = ci / KCPR, col = (ci % KCPR) * 8; kgo[j] = row * LDK + col; klo[j] = kswz<DQK>(row, col * 2); }
#pragma unroll
    for (int j = 0; j < NVC; ++j) { const int ci = tid + 512 * j, row = ci / VCPR, col = (ci % VCPR) * 8; vgo[j] = row * LDK + col; vlo[j] = v_st<NCB>(row, col); }
    const int vb0 = (int)(unsigned)(uintptr_t)V_lds + v_rd_base(lane);
    constexpr int SD = (MODE == 0) ? 2 : 1;
    struct { bf16x8 vs[NVC], ks[NKC]; } sr_[SD];
#define ATT_SLOAD(i, k0) do { _Pragma("unroll") for (int j_ = 0; j_ < NVC; ++j_) sr_[i].vs[j_] = *reinterpret_cast<const bf16x8*>(&Vh[(long)(k0) * LDK + vgo[j_]]); \
    _Pragma("unroll") for (int j_ = 0; j_ < NKC; ++j_) sr_[i].ks[j_] = *reinterpret_cast<const bf16x8*>(&Kh[(long)(k0) * LDK + kgo[j_]]); } while (0)
#define ATT_SWRITE(b, i) do { _Pragma("unroll") for (int j_ = 0; j_ < NVC; ++j_) *(LDS3 bf16x8*)(V_lds + (b) * SHM_V + vlo[j_]) = sr_[i].vs[j_]; \
    _Pragma("unroll") for (int j_ = 0; j_ < NKC; ++j_) *(LDS3 bf16x8*)(K_lds + (b) * SHM_K + klo[j_]) = sr_[i].ks[j_]; } while (0)
#define ATT_SWAIT() asm volatile("s_waitcnt vmcnt(%0)" :: "n"(SD == 2 ? NKC + NVC : 0) : "memory")
#define ATT_RESC(a) do { if (__any((a) < 1.f)) { if (hi == 0) al_l[r32] = (a); asm volatile("s_waitcnt lgkmcnt(0)" ::: "memory"); \
    _Pragma("unroll") for (int d = 0; d < NCB; ++d) _Pragma("unroll") for (int r = 0; r < 16; ++r) o[d][r] *= al_l[crow(r, hi)]; } } while (0)
#define ATT_BAR() asm volatile("s_waitcnt lgkmcnt(0)\n\ts_barrier" ::: "memory")
    f32x16 pA0, pA1, pB0, pB1; float alA, alB; bf16x8 pa0, pa1, pa2, pa3;
#define ATT_QKT(P0, P1, KB, kt) do { if constexpr (MODE == 1) qkt<DQK, true>(P0, P1, KB, qr, r32, hi, cini, etab[(kt) * 64 + r32], etab[(kt) * 64 + 32 + r32]); else qkt<DQK, false>(P0, P1, KB, qr, r32, hi, cini); } while (0)
#define ATT_PSM(FIRST_, P0, P1, AL, kt) do { if constexpr (MODE == 1) partialSM_rel<FIRST_>(P0, P1, m_reg, AL, cini, cq); else partialSM_abs(P0, P1, m_reg, AL, t5_far<MODE>((kt), q0w) ? b31 : 0.f); } while (0)
    constexpr int SE = 0, SO = SD - 1;
    ATT_SLOAD(SE, 0); asm volatile("s_waitcnt vmcnt(0)" ::: "memory"); ATT_SWRITE(0, SE); ATT_BAR();
    ATT_QKT(pA0, pA1, K_lds, 0); apply_bias<MODE>(pA0, pA1, 0, tab, qabs, q0w, hi); ATT_PSM(true, pA0, pA1, alA, 0);
    ATT_SLOAD(SO, 64); if (SD == 2 && 2 < NT) ATT_SLOAD(SE, 128);
    ATT_SWAIT(); ATT_SWRITE(1, SO); ATT_BAR();
    for (int j = 1; j + 1 < NT; j += 2) {
        ASBAR(); ATT_QKT(pB0, pB1, K_lds + SHM_K, j);
        finishSM(pA0, pA1, alA, l_reg, pa0, pa1, pa2, pa3); ASBAR();
        ATT_SLOAD(SO, (j + SD) * 64); ASBAR();
        pv_all<NCB, MODE == 2>(o, vb0, pa0, pa1, pa2, pa3); apply_bias<MODE>(pB0, pB1, j, tab, qabs, q0w, hi); ATT_PSM(false, pB0, pB1, alB, j);
        ATT_BAR(); ATT_SWAIT(); ATT_SWRITE(0, SE);
        ATT_RESC(alB); ATT_BAR();
        ASBAR(); ATT_QKT(pA0, pA1, K_lds, j + 1);
        finishSM(pB0, pB1, alB, l_reg, pa0, pa1, pa2, pa3); ASBAR();
        if (SD == 1 || j + 3 < NT) ATT_SLOAD(SE, (j + 1 + SD) * 64); ASBAR();
        pv_all<NCB, MODE == 2>(o, vb0 + SHM_V, pa0, pa1, pa2, pa3); apply_bias<MODE>(pA0, pA1, j + 1, tab, qabs, q0w, hi); ATT_PSM(false, pA0, pA1, alA, j + 1);
        ATT_BAR(); ATT_SWAIT(); ATT_SWRITE(1, SO);
        ATT_RESC(alA); ATT_BAR();
    }
    ASBAR(); ATT_QKT(pB0, pB1, K_lds + SHM_K, NT - 1);
    finishSM(pA0, pA1, alA, l_reg, pa0, pa1, pa2, pa3); ASBAR();
    pv_all<NCB, MODE == 2>(o, vb0, pa0, pa1, pa2, pa3); apply_bias<MODE>(pB0, pB1, NT - 1, tab, qabs, q0w, hi); ATT_PSM(false, pB0, pB1, alB, NT - 1);
    ATT_BAR(); ATT_RESC(alB);
    finishSM(pB0, pB1, alB, l_reg, pa0, pa1, pa2, pa3); ASBAR();
    pv_all<NCB, MODE == 2>(o, vb0 + SHM_V, pa0, pa1, pa2, pa3);
    if (hi == 0) li_l[r32] = l_reg; asm volatile("s_waitcnt lgkmcnt(0)" ::: "memory");
    float rli[16];
#pragma unroll
    for (int r = 0; r < 16; ++r) rli[r] = __builtin_amdgcn_rcpf(li_l[crow(r, hi)]);
    bf16* Ow = Ob + (long)(wid * 32) * LDO;
#pragma unroll
    for (int r = 0; r < 16; ++r) { const int orow = crow(r, hi);
#pragma unroll
        for (int d0 = 0; d0 < NCB; ++d0) Ow[(long)orow * LDO + d0 * 32 + r32] = f2bf(o[d0][r] * rli[r]); }
    __syncthreads();
#undef ATT_SLOAD
#undef ATT_SWRITE
#undef ATT_SWAIT
#undef ATT_RESC
#undef ATT_QKT
#undef ATT_BAR
#undef ATT_PSM
}
#undef ASBAR
#undef LDS3
}
#ifndef FOX_THR
#define FOX_THR 100
#endif
namespace fx {
using att::bf16; using att::bf16x8; using att::s16x4; using att::f32x16; using att::u32x4; using att::crow;
typedef unsigned u32x2 __attribute__((ext_vector_type(2)));
typedef __attribute__((address_space(3))) const char* lds_cptr;
typedef short v4i16_t __attribute__((ext_vector_type(4)));
#define FXL __attribute__((address_space(3)))
#define SBAR() __builtin_amdgcn_sched_barrier(0)
constexpr int NW = 8, QBLK = 32, QB = QBLK * NW, KVBLK = 64;
constexpr int NSLOT = 3, SLOTB = 8192;
constexpr int LDS_K = 0, LDS_V = NSLOT * SLOTB, LDS_WS = 2 * NSLOT * SLOTB, LDS_OST = LDS_WS + NW * 64 * 4, LDS_TAB = LDS_OST + NW * 4096, LDS_BYTES = LDS_TAB + 8192;
constexpr unsigned ONES = 0x3F803F80u;
__device__ __forceinline__ void cmask(f32x16& p0, f32x16& p1, int jb, int qrel, int hi) {
  const float NEG = -INFINITY; int kb = 64 * jb + 4 * hi;
  #pragma unroll
  for (int r = 0; r < 16; ++r) { int kv = kb + (r & 3) + 8 * (r >> 2); if (kv > qrel) p0[r] = NEG; if (kv + 32 > qrel) p1[r] = NEG; }
}
__device__ __forceinline__ void glds16(const void* sbase, unsigned voff, unsigned lds_dst) { unsigned keep;
  asm volatile("s_mov_b32 %0, m0\n\ts_mov_b32 m0, %2\n\ts_nop 0\n\tglobal_load_lds_dwordx4 %1, %3\n\ts_mov_b32 m0, %0" : "=&s"(keep) : "v"(voff), "s"(lds_dst), "s"(sbase) : "memory"); }
__device__ __forceinline__ float max3f(float a, float b, float c) { float r; asm("v_max3_f32 %0, %1, %2, %3" : "=v"(r) : "v"(a), "v"(b), "v"(c)); return r; }
__device__ __forceinline__ float max2f(float a, float b) { float r; asm("v_max_f32_e32 %0, %1, %2" : "=v"(r) : "v"(a), "v"(b)); return r; }
__device__ __forceinline__ float fsub_s(float a, float b) { float r; asm("v_sub_f32_e32 %0, %1, %2" : "=v"(r) : "v"(a), "v"(b)); return r; }
typedef float f32x2_t __attribute__((ext_vector_type(2))); typedef __bf16 bf16x2_t __attribute__((ext_vector_type(2)));
__device__ __forceinline__ unsigned cvtpk_s(float lo, float hi) { f32x2_t v = {lo, hi}; bf16x2_t b = __builtin_convertvector(v, bf16x2_t); return __builtin_bit_cast(unsigned, b); }
#define WAIT_BAR(N) asm volatile("s_waitcnt vmcnt(" #N ") lgkmcnt(0)\n\ts_barrier" ::: "memory")
#define MFMA8(a, b, c) __builtin_amdgcn_mfma_f32_32x32x8bf16_1k(__builtin_bit_cast(v4i16_t, a), __builtin_bit_cast(v4i16_t, b), c, 0, 0, 0)
__device__ __forceinline__ float quant2(float v, unsigned& pk) { const unsigned h = att::f2bf(v); const float hf = __builtin_bit_cast(float, h << 16); const unsigned l = att::f2bf(v - hf);
  pk = h | (l << 16); return hf + __builtin_bit_cast(float, l << 16); }

__device__ __forceinline__ void qkt(f32x16& p0, f32x16& p1, lds_cptr Kslot, const bf16x8* qr, u32x2 ax0, u32x2 ax1, u32x2 bx, int r32, int hi) {
  const lds_cptr kb = Kslot + hi * 1024 + r32 * 16;
  p0 = MFMA8(ax0, bx, f32x16{}); p1 = MFMA8(ax1, bx, f32x16{});
  #pragma unroll
  for (int d0 = 0; d0 < 4; ++d0) {
    const bf16x8 b0 = *(const FXL bf16x8*)(kb + d0 * 2048);
    const bf16x8 b1 = *(const FXL bf16x8*)(kb + d0 * 2048 + 512);
    p0 = __builtin_amdgcn_mfma_f32_32x32x16_bf16(b0, qr[d0], p0, 0, 0, 0); p1 = __builtin_amdgcn_mfma_f32_32x32x16_bf16(b1, qr[d0], p1, 0, 0, 0); }
}
__device__ __forceinline__ void kload8(bf16x8* kf, lds_cptr kp) {
  kf[0] = *(const FXL bf16x8*)(kp);        kf[1] = *(const FXL bf16x8*)(kp + 512);
  kf[2] = *(const FXL bf16x8*)(kp + 2048); kf[3] = *(const FXL bf16x8*)(kp + 2560);
  kf[4] = *(const FXL bf16x8*)(kp + 4096); kf[5] = *(const FXL bf16x8*)(kp + 4608);
  kf[6] = *(const FXL bf16x8*)(kp + 6144); kf[7] = *(const FXL bf16x8*)(kp + 6656);
}
__device__ __forceinline__ void kload2(bf16x8* kf, lds_cptr kp, int j) { kf[2 * j] = *(const FXL bf16x8*)(kp + j * 2048); kf[2 * j + 1] = *(const FXL bf16x8*)(kp + j * 2048 + 512); }
__device__ __forceinline__ s16x4 vtr(lds_cptr p) { return __builtin_bit_cast(s16x4, __builtin_amdgcn_ds_read_tr16_b64_v4i16((FXL v4i16_t*)p)); }
__device__ __forceinline__ float rowmax(const f32x16& p0, const f32x16& p1) {
  float a = max3f(p0[0], p0[1], p1[0]), b = max3f(p0[2], p0[3], p1[1]); a = max3f(a, p1[2], p1[3]);
  #pragma unroll
  for (int r = 4; r < 16; r += 4) { a = max3f(a, p0[r], p0[r + 1]); b = max3f(b, p0[r + 2], p0[r + 3]); a = max3f(a, p1[r], p1[r + 1]); b = max3f(b, p1[r + 2], p1[r + 3]); }
  const float m = max2f(a, b);
  auto rr = __builtin_amdgcn_permlane32_swap(__float_as_uint(m), __float_as_uint(m), false, false);
  return max2f(__uint_as_float(rr[0]), __uint_as_float(rr[1]));
}
__device__ __forceinline__ void pv(f32x16* o, int vb, bf16x8 pa0, bf16x8 pa1, bf16x8 pa2, bf16x8 pa3) {
  #pragma unroll
  for (int d0 = 0; d0 < 2; ++d0) { s16x4 lo[4], hi[4];
    #pragma unroll
    for (int ks = 0; ks < 4; ++ks) {
      asm volatile("ds_read_b64_tr_b16 %0,%1 offset:%c2" : "=&v"(lo[ks]) : "v"(vb), "i"(d0 * 4096 + ks * 1024) : "memory");
      asm volatile("ds_read_b64_tr_b16 %0,%1 offset:%c2" : "=&v"(hi[ks]) : "v"(vb), "i"(d0 * 4096 + ks * 1024 + 512) : "memory"); }
    asm volatile("s_waitcnt lgkmcnt(0)" ::: "memory"); SBAR();
    #define PK(k) (bf16x8){lo[k][0], lo[k][1], lo[k][2], lo[k][3], hi[k][0], hi[k][1], hi[k][2], hi[k][3]}
    o[d0] = __builtin_amdgcn_mfma_f32_32x32x16_bf16(pa0, PK(0), o[d0], 0, 0, 0);
    o[d0] = __builtin_amdgcn_mfma_f32_32x32x16_bf16(pa1, PK(1), o[d0], 0, 0, 0);
    o[d0] = __builtin_amdgcn_mfma_f32_32x32x16_bf16(pa2, PK(2), o[d0], 0, 0, 0);
    o[d0] = __builtin_amdgcn_mfma_f32_32x32x16_bf16(pa3, PK(3), o[d0], 0, 0, 0);
    #undef PK
  }
}

template <int LDQ, int LDK, int LDO, int THRL> __device__ __forceinline__ void fox_unit(const bf16* Qb, const bf16* __restrict__ Kh, const bf16* __restrict__ Vh, bf16* Ob, int q0, FXL char* shm) {
  const int tid = threadIdx.x, lane = tid & 63, r32 = lane & 31, hi = lane >> 5; const int wid = __builtin_amdgcn_readfirstlane(tid >> 6);
  const bf16* Qw = Qb + (long)(wid * QBLK) * LDQ;
  const unsigned lds0 = (unsigned)(uintptr_t)shm;
  FXL float* wsf = (FXL float*)(shm + LDS_WS) + wid * 64;
  const FXL unsigned* etab = (const FXL unsigned*)(shm + LDS_TAB);
  const unsigned koff = (unsigned)(lane * LDK + wid * 8) * 2u;
  const unsigned voff = (unsigned)((16 * (wid & 3) + (lane >> 2)) * LDK + (wid >> 2) * 32 + (lane & 3) * 8) * 2u;
  const unsigned kdst = lds0 + LDS_K + wid * 1024, vdst = lds0 + LDS_V + wid * 1024;
  #define DMA_K(t, slot) glds16(Kh + (long)(t) * KVBLK * LDK, koff, (unsigned)__builtin_amdgcn_readfirstlane(kdst + (slot)))
  #define DMA_V(t, slot) glds16(Vh + (long)(t) * KVBLK * LDK, voff, (unsigned)__builtin_amdgcn_readfirstlane(vdst + (slot)))
  bf16x8 kf[8];
  const lds_cptr shm3 = (lds_cptr)shm; const lds_cptr kp0 = shm3 + LDS_K + hi * 1024 + r32 * 16; const lds_cptr vp0 = shm3 + LDS_V + ((lane >> 4) & 1) * 32 + (lane & 3) * 8 + (4 * hi + ((lane & 15) >> 2)) * 64;
  const int NT = (q0 + QB) / KVBLK;
  DMA_K(0, 0); DMA_V(0, 0); DMA_K(1, SLOTB);
  bf16x8 qr[4];
  #pragma unroll
  for (int d0 = 0; d0 < 4; ++d0) qr[d0] = *reinterpret_cast<const bf16x8*>(&Qw[(long)r32 * LDQ + d0 * 16 + hi * 8]);
  u32x2 ax0 = {etab[r32], hi ? 0u : ONES}, ax1 = {etab[32 + r32], hi ? 0u : ONES}, bx = {hi ? 0u : ONES, 0u};
  float l_reg = 0.f; f32x16 o[2]; o[0] = f32x16{}; o[1] = f32x16{};
  #define CMASK(P0, P1, t) do { int jb_ = (t) - (NT - 4); if (jb_ >= 0) { int l_ = lane; asm volatile("" : "+v"(l_)); cmask(P0, P1, jb_, wid * QBLK + (l_ & 31), l_ >> 5); } } while (0)
  #define SETREF(NEWREF) do { unsigned pk_; (void)quant2(-(NEWREF), pk_); bx.y = pk_; asm volatile("" : "+v"(bx)); } while (0)
  #define CURREF() (-(__builtin_bit_cast(float, bx.y << 16) + __builtin_bit_cast(float, bx.y & 0xffff0000u)))
  bool resc = false;
  #define START(P0, P1) do { const float rm = rowmax(P0, P1); resc = false; \
    { SETREF(rm); const float dl = CURREF(); \
      _Pragma("unroll") for (int r = 0; r < 16; ++r) { P0[r] = fsub_s(P0[r], dl); P1[r] = fsub_s(P1[r], dl); } } \
    _Pragma("unroll") for (int r = 0; r < 16; ++r) P0[r] = __builtin_amdgcn_exp2f(P0[r]); } while (0)
  #define RESC() do { if (resc) { asm volatile("s_waitcnt lgkmcnt(0)" ::: "memory"); \
      _Pragma("unroll") for (int d_ = 0; d_ < 2; ++d_) _Pragma("unroll") for (int r = 0; r < 16; ++r) o[d_][r] *= wsf[crow(r, hi)]; } } while (0)
  f32x16 pA0, pA1, pB0, pB1;
  int sl_prev = 0, sl_cur = 0, sl_next = SLOTB;
  #define ROT() do { sl_prev = sl_cur; sl_cur = sl_next; sl_next = (sl_next == (NSLOT - 1) * SLOTB) ? 0 : sl_next + SLOTB; } while (0)
  DMA_K(2, 2 * SLOTB);
  WAIT_BAR(3);
  qkt(pA0, pA1, shm3 + LDS_K, qr, ax0, ax1, bx, r32, hi); asm volatile("s_nop 15\n\ts_nop 7" : "+v"(pA0), "+v"(pA1)); CMASK(pA0, pA1, 0);
  START(pA0, pA1);
  _Pragma("unroll") for (int r = 0; r < 16; ++r) pA1[r] = __builtin_amdgcn_exp2f(pA1[r]);
  WAIT_BAR(0);
  DMA_K(3, 0); DMA_V(1, SLOTB);
  ROT();
  kload8(kf, kp0 + sl_cur); ax0.x = etab[64 + r32]; ax1.x = etab[96 + r32];
  WAIT_BAR(2);
  s16x4 vlo[8], vhi[8]; u32x4 pw0, pw1, pw2, pw3;
  #define PKW(P, B) cvtpk_s(P[B], P[B + 1])
  #define PAF(k) __builtin_bit_cast(bf16x8, pw##k)
  #define VFR(i) (bf16x8){vlo[i][0], vlo[i][1], vlo[i][2], vlo[i][3], vhi[i][0], vhi[i][1], vhi[i][2], vhi[i][3]}
  #define PIN(x) asm volatile("" : "+v"(x))
  #define MX3(a, b, c) __builtin_fmaxf(__builtin_fmaxf((a), (b)), (c))
  #define GAPA(MF, A0, A1, A2, A3, W0, W1, PW) do { MF; sacc += A0; sacc += A1; sacc += A2; sacc += A3; PIN(sacc); W0; W1; PIN(PW); SBAR(); } while (0)
  #define EX(v) __builtin_amdgcn_exp2f(v)
  #define GAPB(MF, X, B) do { MF; X[B] = EX(X[B]); X[B + 1] = EX(X[B + 1]); X[B + 2] = EX(X[B + 2]); X[B + 3] = EX(X[B + 3]); PIN(X); SBAR(); } while (0)
  #define VRD(i) do { vlo[i] = vtr(vp_ + (((i) >> 2) * 4096 + ((i) & 3) * 1024)); vhi[i] = vtr(vp_ + (((i) >> 2) * 4096 + ((i) & 3) * 1024 + 512)); } while (0)
  #define KRD(G, j) do { if (G) { kload2(kf, kp0 + sl_next, j); SBAR(); } } while (0)
  #define ERD(G, t) do { if (G) { ax0.x = etab[((t) + 1) * 64 + r32]; ax1.x = etab[((t) + 1) * 64 + 32 + r32]; SBAR(); } } while (0)
  #define STEP(C0, C1, P0, P1, t, GK, GV, GL) do { SBAR(); \
    const lds_cptr vp_ = vp0 + sl_prev; \
    VRD(0); SBAR(); float sacc = (P0[0] + P0[1]); \
    C0 = MFMA8(ax0, bx, f32x16{}); C1 = MFMA8(ax1, bx, f32x16{}); SBAR(); \
    GAPA(C0 = __builtin_amdgcn_mfma_f32_32x32x16_bf16(kf[0], qr[0], C0, 0, 0, 0), P0[2], P0[3], P0[4], P0[5],     pw0[0] = PKW(P0, 0), pw0[1] = PKW(P0, 2), pw0); \
    VRD(4); SBAR(); GAPA(C1 = __builtin_amdgcn_mfma_f32_32x32x16_bf16(kf[1], qr[0], C1, 0, 0, 0), P0[6], P0[7], P0[8], P0[9],     pw0[2] = PKW(P0, 4), pw0[3] = PKW(P0, 6), pw0); \
    VRD(1); SBAR(); GAPA(C0 = __builtin_amdgcn_mfma_f32_32x32x16_bf16(kf[2], qr[1], C0, 0, 0, 0),   P0[10], P0[11], P0[12], P0[13], pw1[0] = PKW(P0, 8), pw1[1] = PKW(P0, 10), pw1); \
    VRD(5); SBAR(); GAPA(C1 = __builtin_amdgcn_mfma_f32_32x32x16_bf16(kf[3], qr[1], C1, 0, 0, 0),   P0[14], P0[15], P1[0], P1[1],   pw1[2] = PKW(P0, 12), pw1[3] = PKW(P0, 14), pw1); \
    VRD(2); SBAR(); GAPA(C0 = __builtin_amdgcn_mfma_f32_32x32x16_bf16(kf[4], qr[2], C0, 0, 0, 0),   P1[2], P1[3], P1[4], P1[5],     pw2[0] = PKW(P1, 0), pw2[1] = PKW(P1, 2), pw2); \
    VRD(6); SBAR(); GAPA(C1 = __builtin_amdgcn_mfma_f32_32x32x16_bf16(kf[5], qr[2], C1, 0, 0, 0),   P1[6], P1[7], P1[8], P1[9],     pw2[2] = PKW(P1, 4), pw2[3] = PKW(P1, 6), pw2); \
    VRD(3); SBAR(); GAPA(C0 = __builtin_amdgcn_mfma_f32_32x32x16_bf16(kf[6], qr[3], C0, 0, 0, 0),   P1[10], P1[11], P1[12], P1[13], pw3[0] = PKW(P1, 8), pw3[1] = PKW(P1, 10), pw3); \
    VRD(7); SBAR(); GAPA(C1 = __builtin_amdgcn_mfma_f32_32x32x16_bf16(kf[7], qr[3], C1, 0, 0, 0),   P1[14], P1[15], 0.f, 0.f,       pw3[2] = PKW(P1, 12), pw3[3] = PKW(P1, 14), pw3); \
    l_reg += sacc; \
    if (GK) { DMA_K((t) + 3, sl_cur); } if (GV) { DMA_V((t) + 1, sl_next); } \
    CMASK(C0, C1, t); \
    { float a = MX3(C0[0], C0[1], C1[0]), b = MX3(C0[2], C0[3], C1[1]); a = MX3(a, C1[2], C1[3]); \
      _Pragma("unroll") for (int r = 4; r < 16; r += 4) { a = MX3(a, C0[r], C0[r + 1]); b = MX3(b, C0[r + 2], C0[r + 3]); a = MX3(a, C1[r], C1[r + 1]); b = MX3(b, C1[r + 2], C1[r + 3]); } \
      float rm = __builtin_fmaxf(a, b); { auto rr = __builtin_amdgcn_permlane32_swap(__float_as_uint(rm), __float_as_uint(rm), false, false); rm = __builtin_fmaxf(__uint_as_float(rr[0]), __uint_as_float(rr[1])); } \
      resc = false; \
      if (__builtin_expect(__any(rm > (float)THRL), 0)) { const float old_ = CURREF(); SETREF(old_ + __builtin_fmaxf(rm, 0.f)); const float dl = CURREF() - old_; \
        _Pragma("unroll") for (int r = 0; r < 16; ++r) { C0[r] -= dl; C1[r] -= dl; } \
        const float f = __builtin_amdgcn_exp2f(-dl); l_reg *= f; if (hi == 0) wsf[r32] = f; resc = true; } } \
    SBAR(); \
    GAPB(o[0] = __builtin_amdgcn_mfma_f32_32x32x16_bf16(PAF(0), VFR(0), o[0], 0, 0, 0), C0, 0); \
    GAPB(o[1] = __builtin_amdgcn_mfma_f32_32x32x16_bf16(PAF(0), VFR(4), o[1], 0, 0, 0), C0, 4); \
    KRD(GL, 0); GAPB(o[0] = __builtin_amdgcn_mfma_f32_32x32x16_bf16(PAF(1), VFR(1), o[0], 0, 0, 0), C0, 8); \
    KRD(GL, 1); GAPB(o[1] = __builtin_amdgcn_mfma_f32_32x32x16_bf16(PAF(1), VFR(5), o[1], 0, 0, 0), C0, 12); \
    KRD(GL, 2); GAPB(o[0] = __builtin_amdgcn_mfma_f32_32x32x16_bf16(PAF(2), VFR(2), o[0], 0, 0, 0), C1, 0); \
    KRD(GL, 3); GAPB(o[1] = __builtin_amdgcn_mfma_f32_32x32x16_bf16(PAF(2), VFR(6), o[1], 0, 0, 0), C1, 4); \
    ERD(GL, t); GAPB(o[0] = __builtin_amdgcn_mfma_f32_32x32x16_bf16(PAF(3), VFR(3), o[0], 0, 0, 0), C1, 8); \
    GAPB(o[1] = __builtin_amdgcn_mfma_f32_32x32x16_bf16(PAF(3), VFR(7), o[1], 0, 0, 0), C1, 12); \
    } while (0)
  int t = 1;
  #undef CMASK
  #define CMASK(P0, P1, t) do {} while (0)
  for (; t + 5 < NT; t += 2) {
    STEP(pB0, pB1, pA0, pA1, t, true, true, true);     WAIT_BAR(2); RESC(); ROT();
    STEP(pA0, pA1, pB0, pB1, t + 1, true, true, true); WAIT_BAR(2); RESC(); ROT();
  }
  #undef CMASK
  #define CMASK(P0, P1, t) do { int jb_ = (t) - (NT - 4); if (jb_ >= 0) { int l_ = lane; asm volatile("" : "+v"(l_)); cmask(P0, P1, jb_, wid * QBLK + (l_ & 31), l_ >> 5); } } while (0)
  #define ENDW(tt) do { if ((tt) + 3 < NT) { WAIT_BAR(2); } else if ((tt) + 2 < NT) { WAIT_BAR(1); } else { WAIT_BAR(0); } } while (0)
  for (; t + 1 < NT; t += 2) {
    STEP(pB0, pB1, pA0, pA1, t, (t + 3 < NT), (t + 1 < NT), (t + 1 < NT));         ENDW(t);     RESC(); ROT();
    STEP(pA0, pA1, pB0, pB1, t + 1, (t + 4 < NT), (t + 2 < NT), (t + 2 < NT));     ENDW(t + 1); RESC(); ROT();
  }
  STEP(pB0, pB1, pA0, pA1, NT - 1, false, false, false); RESC();
  { float sacc = pB0[0] + pB0[1]; _Pragma("unroll") for (int r = 2; r < 16; ++r) sacc += pB0[r]; _Pragma("unroll") for (int r = 0; r < 16; ++r) sacc += pB1[r]; l_reg += sacc;
    pw0 = (u32x4){PKW(pB0, 0), PKW(pB0, 2), PKW(pB0, 4), PKW(pB0, 6)}; pw1 = (u32x4){PKW(pB0, 8), PKW(pB0, 10), PKW(pB0, 12), PKW(pB0, 14)}; pw2 = (u32x4){PKW(pB1, 0), PKW(pB1, 2), PKW(pB1, 4), PKW(pB1, 6)}; pw3 = (u32x4){PKW(pB1, 8), PKW(pB1, 10), PKW(pB1, 12), PKW(pB1, 14)};
    int lane_d = lane; asm volatile("" : "+v"(lane_d));
    const int vb0 = (int)(lds0 + LDS_V) + ((lane_d >> 4) & 1) * 32 + (lane_d & 3) * 8 + (4 * (lane_d >> 5) + ((lane_d & 15) >> 2)) * 64;
    SBAR(); pv(o, vb0 + sl_cur, PAF(0), PAF(1), PAF(2), PAF(3)); }
  #undef PKW
  #undef PAF
  #undef VFR
  #undef PIN
  #undef MX3
  #undef GAPA
  #undef GAPB
  #undef EX
  #undef VRD
  #undef KRD
  #undef ERD
  #undef STEP
  #undef ENDW
  { auto rr = __builtin_amdgcn_permlane32_swap(__float_as_uint(l_reg), __float_as_uint(l_reg), false, false); l_reg = __uint_as_float(rr[0]) + __uint_as_float(rr[1]); }
  if (hi == 0) wsf[32 + r32] = l_reg; asm volatile("s_waitcnt lgkmcnt(0)" ::: "memory");
  float rli[16];
  #pragma unroll
  for (int r = 0; r < 16; ++r) rli[r] = __builtin_amdgcn_rcpf(wsf[32 + crow(r, hi)]);
  bf16* Ow = Ob + (long)(wid * QBLK) * LDO;
  int lane_e = lane; asm volatile("" : "+v"(lane_e));
  { FXL bf16* stg = (FXL bf16*)(shm + LDS_OST) + wid * 2048;
    #pragma unroll
    for (int r = 0; r < 16; ++r) { const int orow = crow(r, hi);
      #pragma unroll
      for (int d0 = 0; d0 < 2; ++d0) stg[orow * 64 + d0 * 32 + r32] = att::f2bf(o[d0][r] * rli[r]); }
    asm volatile("s_waitcnt lgkmcnt(0)" ::: "memory");
    #pragma unroll
    for (int i = 0; i < 4; ++i) { const int row = i * 8 + (lane_e >> 3), ch = lane_e & 7; const u32x4 v = *(const FXL u32x4*)(stg + row * 64 + ch * 8); *(u32x4*)(Ow + (long)row * LDO + ch * 8) = v; } }
  asm volatile("s_waitcnt lgkmcnt(0)\n\ts_barrier" ::: "memory");
  #undef DMA_K
  #undef DMA_V
  #undef CMASK
  #undef SETREF
  #undef CURREF
  #undef START
  #undef RESC
  #undef ROT
}
#undef SBAR
#undef WAIT_BAR
#undef MFMA8
#undef FXL
}
namespace attd {
using att::bf16; using att::bf16x8; using att::f32x16; using att::crow;
#define LDS3 __attribute__((address_space(3)))
#define ASBAR() __builtin_amdgcn_sched_barrier(0)
template <int DQK, int DV> struct Geo {
    static constexpr int SHM_K = 64 * DQK * 2, SHM_V = 64 * DV * 2, NCB = DV / 32;
    static constexpr int WS_OFF = 3 * SHM_V + 3 * SHM_K, TAB_OFF = WS_OFF + 2048, EXT_OFF = TAB_OFF + 512, EXT_PITCH = 2080, BYTES = TAB_OFF + 12288;
};
__device__ __forceinline__ void dma16(const void* sbase, unsigned voff, unsigned lds_dst) { unsigned keep;
    asm volatile("s_mov_b32 %0, m0\n\ts_mov_b32 m0, %2\n\ts_nop 0\n\tglobal_load_lds_dwordx4 %1, %3\n\ts_mov_b32 m0, %0" : "=&s"(keep) : "v"(voff), "s"(lds_dst), "s"(sbase) : "memory"); }
typedef unsigned u32x2 __attribute__((ext_vector_type(2)));
typedef short v4i16_t __attribute__((ext_vector_type(4)));
constexpr unsigned ONES = 0x3F803F80u;
#define ATD_MFMA8(a, b, c) __builtin_amdgcn_mfma_f32_32x32x8bf16_1k(__builtin_bit_cast(v4i16_t, a), __builtin_bit_cast(v4i16_t, b), c, 0, 0, 0)
__device__ __forceinline__ float quant2(float v, unsigned& pk) { const unsigned h = att::f2bf(v); const float hf = __builtin_bit_cast(float, h << 16); const unsigned l = att::f2bf(v - hf);
    pk = h | (l << 16); return hf + __builtin_bit_cast(float, l << 16); }
template <int DQK> __device__ __forceinline__ void qkt_ref(f32x16& p0, f32x16& p1, const LDS3 char* Ks, const bf16x8* qr, int r32, int hi, u32x2 ax, u32x2 bx) {
    p0 = ATD_MFMA8(ax, bx, f32x16{}); p1 = ATD_MFMA8(ax, bx, f32x16{});
#pragma unroll
    for (int d0 = 0; d0 < DQK / 16; ++d0) { const int cb = (d0 * 16 + hi * 8) * 2;
        const bf16x8 b0 = *(const LDS3 bf16x8*)(Ks + att::kswz<DQK>(r32, cb));
        const bf16x8 b1 = *(const LDS3 bf16x8*)(Ks + att::kswz<DQK>(32 + r32, cb));
        p0 = __builtin_amdgcn_mfma_f32_32x32x16_bf16(b0, qr[d0], p0, 0, 0, 0);
        p1 = __builtin_amdgcn_mfma_f32_32x32x16_bf16(b1, qr[d0], p1, 0, 0, 0); }
}
__device__ __forceinline__ float rowmax32(const f32x16& p0, const f32x16& p1) {
    float a = __builtin_fmaxf(__builtin_fmaxf(p0[0], p0[1]), p1[0]), b = __builtin_fmaxf(__builtin_fmaxf(p0[2], p0[3]), p1[1]); a = __builtin_fmaxf(__builtin_fmaxf(a, p1[2]), p1[3]);
#pragma unroll
    for (int r = 4; r < 16; r += 4) { a = __builtin_fmaxf(__builtin_fmaxf(a, p0[r]), p0[r + 1]); b = __builtin_fmaxf(__builtin_fmaxf(b, p0[r + 2]), p0[r + 3]); a = __builtin_fmaxf(__builtin_fmaxf(a, p1[r]), p1[r + 1]); b = __builtin_fmaxf(__builtin_fmaxf(b, p1[r + 2]), p1[r + 3]); }
    float m = __builtin_fmaxf(a, b);
    auto rr = __builtin_amdgcn_permlane32_swap(__float_as_uint(m), __float_as_uint(m), false, false);
    return __builtin_fmaxf(__uint_as_float(rr[0]), __uint_as_float(rr[1]));
}
__device__ __forceinline__ void bias_t5(f32x16& p0, f32x16& p1, const LDS3 char* ext, int dq) {
    const int B = dq - 3 + 256, sft = B & 3; const LDS3 char* e0 = ext + sft * 2080 + (B - sft) * 4;
#pragma unroll
    for (int g4 = 0; g4 < 4; ++g4) { const att::f32x4 v0 = *(const LDS3 att::f32x4*)(e0 - 32 * g4), v1 = *(const LDS3 att::f32x4*)(e0 - 32 * g4 - 128);
#pragma unroll
        for (int i = 0; i < 4; ++i) { p0[4 * g4 + i] += v0[3 - i]; p1[4 * g4 + i] += v1[3 - i]; } }
}
template <int DQK, int DV, int MODE, int LDQ, int LDK, int LDO>
__device__ __forceinline__ void attn_unit(const bf16* __restrict__ Qb, const bf16* __restrict__ Kh, const bf16* __restrict__ Vh, bf16* __restrict__ Ob, int NT, int q0, LDS3 char* lds) {
    using G = Geo<DQK, DV>;
    constexpr int SHM_K = G::SHM_K, SHM_V = G::SHM_V, NCB = G::NCB, NKP = SHM_K / 8192, NVP = SHM_V / 8192, NI = NKP + NVP;
    constexpr int RPP = 1024 / (DQK * 2), LPR = DQK * 2 / 16;
    static_assert(MODE == 0 || MODE == 2, "modes 0 and 2");
    const int tid = threadIdx.x, wid = __builtin_amdgcn_readfirstlane(tid >> 6), lane = tid & 63, r32 = lane & 31, hi = lane >> 5;
    LDS3 char* V_lds = lds; LDS3 char* K_lds = lds + 3 * SHM_V;
    LDS3 float* ws = (LDS3 float*)(lds + G::WS_OFF) + wid * 64; LDS3 float* li_l = ws; LDS3 float* al_l = ws + 32;
    const LDS3 float* tab = (const LDS3 float*)(lds + G::TAB_OFF);
    const int q0w = q0 + wid * 32, qabs = q0w + r32;
    float b31 = 0.f;
    if constexpr (MODE == 2) b31 = tab[127];
    float m_reg = -1e30f, l_reg = 0; f32x16 o[NCB]; bf16x8 qr[DQK / 16];
    const u32x2 ax = {hi ? 0u : ONES, 0u};
    u32x2 bx = {0u, 0u};
    float refq = 0.f, cad = 0.f;
    const LDS3 char* ext = (const LDS3 char*)lds + G::EXT_OFF;
#pragma unroll
    for (int d = 0; d < NCB; ++d) o[d] = f32x16{};
    const bf16* Qw = Qb + (long)(wid * 32 + r32) * LDQ + hi * 8;
#pragma unroll
    for (int d0 = 0; d0 < DQK / 16; ++d0) qr[d0] = *reinterpret_cast<const bf16x8*>(Qw + d0 * 16);
    unsigned kgo[NKP], vgo[NVP];
#pragma unroll
    for (int i = 0; i < NKP; ++i) { const int p = wid + 8 * i, row = p * RPP + lane / LPR, c = (lane % LPR) ^ (row & 7); kgo[i] = (unsigned)(row * LDK + c * 8) * 2u; }
#pragma unroll
    for (int i = 0; i < NVP; ++i) { const int p = wid + 8 * i, s = 2 * p + (lane >> 5), kk = (s / NCB) * 8 + ((lane & 31) >> 2), k = (kk & ~0xC) | ((kk & 4) << 1) | ((kk & 8) >> 1), c = (s % NCB) * 32 + (lane & 3) * 8;
        vgo[i] = (unsigned)(k * LDK + c) * 2u; }
    const unsigned lds0 = (unsigned)(uintptr_t)lds, kd0 = lds0 + 3 * SHM_V + wid * 1024, vd0 = lds0 + wid * 1024;
    const int vb0 = (int)lds0 + att::v_rd_base(lane);
#define ATD_DMA_K(t, slot) do { _Pragma("unroll") for (int i_ = 0; i_ < NKP; ++i_) dma16(Kh + (long)(t) * 64 * LDK, kgo[i_], (unsigned)__builtin_amdgcn_readfirstlane(kd0 + (slot) * SHM_K + i_ * 8192)); } while (0)
#define ATD_DMA_V(t, slot) do { _Pragma("unroll") for (int i_ = 0; i_ < NVP; ++i_) dma16(Vh + (long)(t) * 64 * LDK, vgo[i_], (unsigned)__builtin_amdgcn_readfirstlane(vd0 + (slot) * SHM_V + i_ * 8192)); } while (0)
#define ATD_WAITBAR(N) asm volatile("s_waitcnt vmcnt(%0) lgkmcnt(0)\n\ts_barrier" :: "n"(N) : "memory")
#define ATD_RESC(a) do { if (__any((a) < 1.f)) { if (hi == 0) al_l[r32] = (a); asm volatile("s_waitcnt lgkmcnt(0)" ::: "memory"); \
    _Pragma("unroll") for (int d = 0; d < NCB; ++d) _Pragma("unroll") for (int r = 0; r < 16; ++r) o[d][r] *= al_l[crow(r, hi)]; } } while (0)
    f32x16 pA0, pA1, pB0, pB1; float alA, alB; bf16x8 pa0, pa1, pa2, pa3;
    int s_prev = 2, s_cur = 0, s_next = 1;
#define ATD_ROT() do { const int t_ = s_prev; s_prev = s_cur; s_cur = s_next; s_next = t_; } while (0)
#define ATD_SETSHIFT(S_) do { unsigned pk_; refq = -quant2(-(S_), pk_); bx.x = hi ? 0u : pk_; asm volatile("" : "+v"(bx)); } while (0)
#define ATD_CADD(kt) do { if constexpr (MODE == 2) { const float c_ = att::t5_far<MODE>((kt), q0w) ? b31 : 0.f; if (c_ != cad) { ATD_SETSHIFT(refq + cad - c_); cad = c_; } } } while (0)
#define ATD_BIAS(P0, P1, kt) do { if constexpr (MODE == 2) { if (!att::t5_far<MODE>((kt), q0w)) bias_t5(P0, P1, ext, qabs - (kt) * 64 - 4 * hi); } } while (0)
#define ATD_PSM(FIRST_, P0, P1, AL) do { if constexpr (MODE == 0) { att::partialSM_abs(P0, P1, m_reg, AL, 0.f); } else { const float pm_ = rowmax32(P0, P1); AL = 1.f; \
        if (FIRST_ || !__builtin_expect(__all(pm_ <= att::THR2), 1)) { const float old_ = refq, dl0_ = FIRST_ ? pm_ : fmaxf(pm_, 0.f); ATD_SETSHIFT(old_ + dl0_); const float dl_ = refq - old_; \
            if (!FIRST_) AL = __builtin_amdgcn_exp2f(-dl_); \
            _Pragma("unroll") for (int r = 0; r < 16; ++r) { P0[r] -= dl_; P1[r] -= dl_; } } \
        _Pragma("unroll") for (int r = 0; r < 16; ++r) P0[r] = __builtin_amdgcn_exp2f(P0[r]); } } while (0)
#define ATD_QKT(C0, C1, KS) do { if constexpr (MODE == 0) att::qkt<DQK, false>(C0, C1, KS, qr, r32, hi, f32x16{}); else qkt_ref<DQK>(C0, C1, KS, qr, r32, hi, ax, bx); } while (0)
#define ATD_STEP(C0, C1, ALC, P0, P1, ALP, j) do { \
        if ((j) + 1 < NT) ATD_WAITBAR(NI); else ATD_WAITBAR(0); \
        if ((j) + 2 < NT) ATD_DMA_K((j) + 2, s_prev); if ((j) + 1 < NT) ATD_DMA_V((j) + 1, s_next); \
        ATD_CADD(j); ASBAR(); ATD_QKT(C0, C1, K_lds + s_cur * SHM_K); \
        att::finishSM(P0, P1, ALP, l_reg, pa0, pa1, pa2, pa3); ASBAR(); \
        att::pv_all<NCB, MODE == 2>(o, vb0 + s_prev * SHM_V, pa0, pa1, pa2, pa3); ATD_BIAS(C0, C1, (j)); ATD_PSM(false, C0, C1, ALC); \
        ATD_RESC(ALC); ATD_ROT(); } while (0)
    ATD_DMA_K(0, 0); ATD_DMA_V(0, 0); ATD_DMA_K(1, 1);
    ATD_WAITBAR(NI);
    if (2 < NT) ATD_DMA_K(2, 2); ATD_DMA_V(1, 1);
    ATD_CADD(0); ATD_QKT(pA0, pA1, K_lds); ATD_BIAS(pA0, pA1, 0); ATD_PSM(true, pA0, pA1, alA);
    ATD_ROT();
    int j = 1;
    for (; j + 1 < NT; j += 2) {
        ATD_STEP(pB0, pB1, alB, pA0, pA1, alA, j);
        ATD_STEP(pA0, pA1, alA, pB0, pB1, alB, j + 1);
    }
    ATD_STEP(pB0, pB1, alB, pA0, pA1, alA, j);
    att::finishSM(pB0, pB1, alB, l_reg, pa0, pa1, pa2, pa3); ASBAR();
    att::pv_all<NCB, MODE == 2>(o, vb0 + s_prev * SHM_V, pa0, pa1, pa2, pa3);
    if (hi == 0) li_l[r32] = l_reg; asm volatile("s_waitcnt lgkmcnt(0)" ::: "memory");
    float rli[16];
#pragma unroll
    for (int r = 0; r < 16; ++r) rli[r] = __builtin_amdgcn_rcpf(li_l[crow(r, hi)]);
    bf16* Ow = Ob + (long)(wid * 32) * LDO;
#pragma unroll
    for (int r = 0; r < 16; ++r) { const int orow = crow(r, hi);
#pragma unroll
        for (int d0 = 0; d0 < NCB; ++d0) Ow[(long)orow * LDO + d0 * 32 + r32] = att::f2bf(o[d0][r] * rli[r]); }
    asm volatile("s_waitcnt lgkmcnt(0)\n\ts_barrier" ::: "memory");
#undef ATD_DMA_K
#undef ATD_DMA_V
#undef ATD_WAITBAR
#undef ATD_RESC
#undef ATD_ROT
#undef ATD_PSM
#undef ATD_QKT
#undef ATD_SETSHIFT
#undef ATD_CADD
#undef ATD_BIAS
#undef ATD_STEP
}
#undef ATD_MFMA8
#undef ASBAR
#undef LDS3
}

#define GAS __attribute__((address_space(1)))
#define LAS __attribute__((address_space(3)))
typedef unsigned short bf16;
typedef unsigned v4u __attribute__((ext_vector_type(4)));
typedef float f32x4 __attribute__((ext_vector_type(4)));
typedef short bf16x8 __attribute__((ext_vector_type(8)));
typedef GAS unsigned gu32;
typedef GAS unsigned long long gu64;
#define RLX_AGENT __ATOMIC_RELAXED, __HIP_MEMORY_SCOPE_AGENT
#define LDS_WAIT() asm volatile("s_waitcnt lgkmcnt(0)" ::: "memory")
#define VM_WAIT() asm volatile("s_waitcnt vmcnt(0)" ::: "memory")
__device__ __forceinline__ unsigned long long rt() { return __builtin_amdgcn_s_memrealtime(); }
__device__ __forceinline__ unsigned f2bf(float f) { unsigned u = __builtin_bit_cast(unsigned, f); return (u + 0x7fffu + ((u >> 16) & 1u)) >> 16; }
__device__ __forceinline__ unsigned pk2(float lo, float hi) { return f2bf(lo) | (f2bf(hi) << 16); }

#define XB_TMO      128
#define XB_XCNT(j)  (256  + 64 * (j))
#define XB_XSUB(j)  (1280 + 64 * (j))
#define XB_XGEN(j)  (2304 + 64 * (j))
#define XB_TOP      3328
#define XB_TOPGEN   3392
#define XCD_BAR_WORDS 3456
#define XB_SPIN_CAP (1u << 18)

__device__ __forceinline__ unsigned xb_ld(unsigned* p)              { return __hip_atomic_load(p, __ATOMIC_RELAXED, __HIP_MEMORY_SCOPE_AGENT); }
__device__ __forceinline__ unsigned xb_add(unsigned* p, unsigned v) { return __hip_atomic_fetch_add(p, v, __ATOMIC_RELAXED, __HIP_MEMORY_SCOPE_AGENT); }
__device__ __forceinline__ unsigned xb_xcc_id() { return (unsigned)__builtin_amdgcn_s_getreg((3 << 11) | 20) & 0xFu; }
#define XB_SPIN(cond, bar) do { unsigned _sp = 0; while (cond) { __builtin_amdgcn_s_sleep(1); \
    if ((++_sp & 255u) == 0u) { if (xb_ld(&(bar)[XB_TMO])) break; if (_sp > XB_SPIN_CAP) { atomicAdd(&(bar)[XB_TMO], 1u); break; } } } } while (0)

struct XcdBarrier {
    unsigned* bar; unsigned x;
    volatile LAS unsigned* st;
};

__device__ __forceinline__ XcdBarrier xcd_barrier_post(unsigned* bar, volatile LAS unsigned* st) {
    XcdBarrier b; b.bar = bar; b.x = xb_xcc_id(); b.st = st;
    if (threadIdx.x == 0) (void)xb_add(&bar[XB_XCNT(b.x)], 1u);
    return b;
}
__device__ __forceinline__ void xcd_barrier_complete(unsigned* bar, unsigned x, unsigned& nloc, unsigned& nx) {
    const unsigned G = gridDim.x * gridDim.y * gridDim.z;
    unsigned sum, cnt, mine, sp = 0u;
    for (;;) {
        sum = 0u; cnt = 0u; mine = 0u;
#pragma unroll
        for (unsigned j = 0; j < 16; ++j) { const unsigned c = xb_ld(&bar[XB_XCNT(j)]); sum += c; cnt += (c > 0u) ? 1u : 0u; mine = (j == x) ? c : mine; }
        if (sum == G) break;
        __builtin_amdgcn_s_sleep(1);
        if ((++sp & 255u) == 0u) { if (xb_ld(&bar[XB_TMO])) break; if (sp > XB_SPIN_CAP) { atomicAdd(&bar[XB_TMO], 1u); break; } }
    }
    nloc = mine > 0u ? mine : 1u; nx = cnt > 0u ? cnt : 1u;
}

__device__ __forceinline__ void xcd_barrier(const XcdBarrier& b) {
    asm volatile("s_waitcnt vmcnt(0)" ::: "memory");
    __syncthreads();
    if (threadIdx.x == 0) {
        unsigned* bar = b.bar;
        __builtin_amdgcn_s_waitcnt(0);
        unsigned nloc = b.st[0], nx = b.st[1];
        if (nloc == 0u) { xcd_barrier_complete(bar, b.x, nloc, nx); b.st[0] = nloc; b.st[1] = nx; }
        const unsigned old = xb_add(&bar[XB_XSUB(b.x)], 1u);
        const unsigned gen = old / nloc;
        if (old + 1u == (gen + 1u) * nloc) {
            __builtin_amdgcn_fence(__ATOMIC_RELEASE, "agent");
            asm volatile("s_waitcnt vmcnt(0)" ::: "memory");
            const unsigned og = xb_add(&bar[XB_TOP], 1u);
            const unsigned tg = og / nx;
            if (og + 1u == (tg + 1u) * nx) xb_add(&bar[XB_TOPGEN], 1u);
            else XB_SPIN(xb_ld(&bar[XB_TOPGEN]) == tg, bar);
            __builtin_amdgcn_fence(__ATOMIC_ACQUIRE, "agent");
            xb_add(&bar[XB_XGEN(b.x)], 1u);
            asm volatile("s_waitcnt vmcnt(0)" ::: "memory");
        } else {
            XB_SPIN(xb_ld(&bar[XB_XGEN(b.x)]) == gen, bar);
            __builtin_amdgcn_fence(__ATOMIC_ACQUIRE, "agent");
            asm volatile("s_waitcnt vmcnt(0)" ::: "memory");
        }
    }
    __syncthreads();
}

constexpr int NWAVES = 8;
#ifndef FFN_FP8
#define FFN_FP8 2
#endif
#ifndef MK_PER_PHASE
#define MK_PER_PHASE 0
#endif
constexpr int BATCH = 8, SEQ = 2048, D = 1024, M = BATCH * SEQ, MEMLEN = 256, MMEM = BATCH * MEMLEN;
constexpr int EV_SRC_N = 2568, PW = 2560  , OD_SRC_N = 3072;
constexpr int FF = 2816, FE = 3584, NE = 8, XW = 512;
constexpr int PAIR_ROWS = 2 * M + NE * 256;
constexpr float EPS = 1e-6f;
constexpr float LOG2E = 1.4426950408889634f;
constexpr float C2_64 = 0.125f * LOG2E, C2_128 = 0.08838834764831845f * LOG2E;
constexpr float LAM_INIT = 0.35550906759096926f;
constexpr size_t MiB = 1u << 20;
constexpr size_t WS_CTL = 0, CTL_ZERO_BYTES = 1 * MiB;
constexpr size_t WS_W_EVIN = 1 * MiB;
constexpr size_t WS_W_MKV = WS_W_EVIN + 5 * MiB;
constexpr size_t WS_W_EVOUT = WS_W_MKV + 4 * MiB;
constexpr size_t WS_W_XQ = WS_W_EVOUT + 2 * MiB;
constexpr size_t WS_W_XO = WS_W_XQ + 2 * MiB;
constexpr size_t WS_W_F13 = WS_W_XO + 2 * MiB;
constexpr size_t WS_W_F2 = WS_W_F13 + 11 * MiB;
constexpr size_t WS_W_ODIN = WS_W_F2 + 6 * MiB;
constexpr size_t WS_W_ODOUT = WS_W_ODIN + 6 * MiB;
constexpr size_t WS_W_M13 = WS_W_ODOUT + 2 * MiB;
constexpr size_t WS_W_M2 = WS_W_M13 + 112 * MiB;
constexpr size_t WS_XB = WS_W_M2 + 56 * MiB;
constexpr size_t WS_SSQ = WS_XB + 32 * MiB;
constexpr size_t WS_FLOG = WS_SSQ + 1 * MiB;
constexpr size_t WS_C2 = WS_FLOG + 1 * MiB;
constexpr size_t WS_TOK = WS_C2 + 1 * MiB;
constexpr size_t WS_GATE = WS_TOK + 1 * MiB;
constexpr size_t WS_P = WS_GATE + 1 * MiB;
constexpr size_t WS_AG = WS_P + 80 * MiB;
constexpr size_t WS_OD = WS_AG + 32 * MiB;
constexpr size_t WS_MEMN = WS_OD + 32 * MiB;
constexpr size_t WS_KVM = WS_MEMN + 4 * MiB;
constexpr size_t WS_QX = WS_KVM + 8 * MiB;
constexpr size_t WS_OX = WS_QX + 16 * MiB;
constexpr size_t WS_ACT = WS_OX + 16 * MiB;
constexpr size_t WS_Y = WS_ACT + 238 * MiB;
constexpr size_t WS_HG = WS_P;
constexpr size_t WS_XB8 = WS_Y + 68 * MiB;
constexpr size_t WS_END = WS_XB8 + 16 * MiB;
static_assert((size_t)PAIR_ROWS * 1024 * 2 <= 68 * MiB && (size_t)PAIR_ROWS * 3584 * 2 <= 238 * MiB && (size_t)M * PW * 2 <= 80 * MiB, "d_ws map");
constexpr int CW_CNT = 64;
constexpr int CW_NT = 128;
constexpr int CW_TID = 256;
constexpr int CW_TEXP = 1024;
constexpr int CW_BAR = 4096;
constexpr int RING_OFF = 0, RING_BYTES = 131072;
constexpr int TEXP_LDS = RING_BYTES + 2048;
constexpr int LDS_BYTES = 147456;
constexpr int LDSCTL_OFF = LDS_BYTES - 1024, MISC_OFF = LDSCTL_OFF + 320;

struct Args { const float* in[31]; float* out; unsigned char* ws; int ph_lo, ph_hi; };
struct Frame {
    LAS unsigned char* lds;
    volatile LAS unsigned* MISC;
    gu32* ctl;
    int tid, lane, wave;
    int vcu, G;
    const Args* a;
    float* out; unsigned char* ws;
};
#define ROWPIPE(BUF_T, M_, LOAD, PROC) do { BUF_T ra_, rb_; int m_ = gw; if (m_ < (M_)) LOAD(ra_, m_); \
    while (m_ < (M_)) { int n_ = m_ + NGW; if (n_ < (M_)) LOAD(rb_, n_); PROC(ra_, m_); m_ = n_; if (m_ >= (M_)) break; \
        n_ = m_ + NGW; if (n_ < (M_)) LOAD(ra_, n_); PROC(rb_, m_); m_ = n_; } } while (0)
#define ROWPIPE4(BUF_T, M_, LOAD, PROC) do { if (NGW * 8 == (M_)) { BUF_T r0_, r1_, r2_, r3_; const int m_ = gw; \
        LOAD(r0_, m_); LOAD(r1_, m_ + NGW); LOAD(r2_, m_ + 2 * NGW); \
        LOAD(r3_, m_ + 3 * NGW); PROC(r0_, m_); \
        LOAD(r0_, m_ + 4 * NGW); PROC(r1_, m_ + NGW); \
        LOAD(r1_, m_ + 5 * NGW); PROC(r2_, m_ + 2 * NGW); \
        LOAD(r2_, m_ + 6 * NGW); PROC(r3_, m_ + 3 * NGW); \
        LOAD(r3_, m_ + 7 * NGW); PROC(r0_, m_ + 4 * NGW); \
        PROC(r1_, m_ + 5 * NGW); PROC(r2_, m_ + 6 * NGW); PROC(r3_, m_ + 7 * NGW); \
    } else ROWPIPE(BUF_T, M_, LOAD, PROC); } while (0)
struct RowF32 { f32x4 v[4]; };
struct RowBf16 { unsigned long long w[4]; };
__device__ __forceinline__ float wave_sum(float v) {
#pragma unroll
    for (int o = 1; o < 64; o <<= 1) v += __shfl_xor(v, o);
    return v;
}
__device__ __forceinline__ float bf2f(unsigned short b) { return __builtin_bit_cast(float, (unsigned)b << 16); }
__device__ __forceinline__ float bflo(unsigned w) { return __builtin_bit_cast(float, w << 16); }
__device__ __forceinline__ float bfhi(unsigned w) { return __builtin_bit_cast(float, w & 0xffff0000u); }

__device__ __forceinline__ unsigned pk4_fp8(float a, float b, float c, float d) { int w = __builtin_amdgcn_cvt_pk_fp8_f32(a, b, 0, false); w = __builtin_amdgcn_cvt_pk_fp8_f32(c, d, w, true); return (unsigned)w; }
#ifndef MOE_Q
#define MOE_Q 40
#endif
constexpr int M13_Q = MOE_Q;
struct XtDesc { const float* W; int ldw, scol0, k0; unsigned char* WT; int K, drow0; const float* gain; float scale; int fp8; };
struct XtRegs { f32x4 v[8]; f32x4 g0, g1; };
#define XT_BAR() asm volatile("s_waitcnt lgkmcnt(0)\n\ts_barrier" ::: "memory")
__device__ __forceinline__ void xt_load(XtRegs& r, const XtDesc& d, int wave, int lane) {
    const int kk = d.k0 + 16 * wave + 8 * (lane >> 5);
    const float* wp = d.W + (size_t)kk * d.ldw + d.scol0 + 4 * (lane & 31);
#pragma unroll
    for (int i = 0; i < 8; ++i) r.v[i] = __builtin_nontemporal_load((const f32x4*)(wp + (size_t)i * d.ldw));
    const float* gp = d.gain ? d.gain + kk : d.W;
    r.g0 = *(const f32x4*)gp; r.g1 = *(const f32x4*)(gp + 4);
}
__device__ __forceinline__ void xt_store(const XtRegs& r, const XtDesc& d, LAS unsigned char* buf, int wave, int lane) {
    const int q = lane & 31, half = lane >> 5, c = 2 * wave + half;
    float g[8] = {r.g0.x, r.g0.y, r.g0.z, r.g0.w, r.g1.x, r.g1.y, r.g1.z, r.g1.w};
#pragma unroll
    for (int i = 0; i < 8; ++i) g[i] = d.gain ? g[i] * d.scale : d.scale;
    if (!d.fp8) {
#pragma unroll
        for (int e = 0; e < 4; ++e) { const int n = 4 * q + e;
            v4u w; w.x = pk2(r.v[0][e] * g[0], r.v[1][e] * g[1]); w.y = pk2(r.v[2][e] * g[2], r.v[3][e] * g[3]); w.z = pk2(r.v[4][e] * g[4], r.v[5][e] * g[5]); w.w = pk2(r.v[6][e] * g[6], r.v[7][e] * g[7]);
            *(LAS v4u*)(buf + n * 256 + ((c ^ (q & 15)) << 4)) = w; }
    } else {
#pragma unroll
        for (int e = 0; e < 4; ++e) { const int n = 4 * q + e;
            const unsigned lo = pk4_fp8(r.v[0][e] * g[0], r.v[1][e] * g[1], r.v[2][e] * g[2], r.v[3][e] * g[3]), hi = pk4_fp8(r.v[4][e] * g[4], r.v[5][e] * g[5], r.v[6][e] * g[6], r.v[7][e] * g[7]);
            *(LAS unsigned long long*)(buf + n * 128 + ((c ^ (2 * (q & 7))) << 3)) = (unsigned long long)lo | ((unsigned long long)hi << 32); }
    }
    XT_BAR();
    if (!d.fp8) {
#pragma unroll
        for (int j = 0; j < 4; ++j) { const int row = 16 * wave + 4 * j + (lane >> 4), p = lane & 15;
            const v4u w = *(const LAS v4u*)(buf + row * 256 + ((p ^ ((row >> 2) & 15)) << 4));
            *(GAS v4u*)((bf16*)d.WT + (size_t)(d.drow0 + row) * d.K + d.k0 + 8 * p) = w; }
    } else {
#pragma unroll
        for (int j = 0; j < 2; ++j) { const int row = 16 * wave + 8 * j + (lane >> 3), p = lane & 7;
            const v4u w = *(const LAS v4u*)(buf + row * 128 + ((p ^ ((row >> 2) & 7)) << 4));
            *(GAS v4u*)(d.WT + (size_t)(d.drow0 + row) * d.K + d.k0 + 16 * p) = w; }
    }
}
template <class DEC> __device__ __forceinline__ void xt_run(Frame& F, int t0, int step, int n, const DEC& dec) {
    if (t0 >= n) return;
    LAS unsigned char* b0 = F.lds + RING_OFF; LAS unsigned char* b1 = b0 + 32768;
    XT_BAR();
    XtRegs A, B; XtDesc dA = dec(t0), dB; xt_load(A, dA, F.wave, F.lane);
    for (int t = t0; t < n; t += 2 * step) {
        const int t1 = t + step, t2 = t + 2 * step;
        dB = dec(t1 < n ? t1 : t); if (t1 >= n) { dB.ldw = 0; dB.k0 = 0; dB.scol0 = 0; dB.gain = nullptr; }
        xt_load(B, dB, F.wave, F.lane);
        xt_store(A, dA, b0, F.wave, F.lane);
        dA = dec(t2 < n ? t2 : t); if (t2 >= n) { dA.ldw = 0; dA.k0 = 0; dA.scol0 = 0; dA.gain = nullptr; }
        xt_load(A, dA, F.wave, F.lane);
        if (t1 < n) xt_store(B, dB, b1, F.wave, F.lane);
    }
    XT_BAR();
}
enum { MAP_ID = 0, MAP_EVIN = 1, MAP_ODIN = 2, MAP_SWIGLU = 3 };
struct XtJob { const float* W; int ldw, K, N, Fh; unsigned char* WT; const float* gain; float scale; int map, fp8; };
__device__ __forceinline__ int xt_job_tiles(const XtJob& j) { return (j.K >> 7) * (j.N >> 7); }
__device__ __forceinline__ XtDesc xt_job_dec(const XtJob& j, int t) {
    const int nnb = j.N >> 7, kb = t / nnb, nb = t % nnb; int scol = 128 * nb; float sc = j.scale;
    if (j.map == MAP_EVIN) { if (nb < 4) sc *= C2_64; scol = nb < 12 ? 128 * nb : 1544 + 128 * (nb - 12); }
    else if (j.map == MAP_ODIN) { if (nb >= 4 && nb < 12) { const int u = nb - 4; scol = 512 + (u & 1) * 512 + (u >> 1) * 128; } else if (nb >= 12) { scol = 1536 + 128 * (nb - 12); if (nb < 16) sc *= C2_64; } }
    else if (j.map == MAP_SWIGLU) scol = (nb & 1) * j.Fh + (nb >> 1) * 128;
    return XtDesc{j.W, j.ldw, scol, 128 * kb, j.WT, j.K, 128 * nb, j.gain, sc, j.fp8};
}
constexpr int MOE_T13 = NE * 8 * 56, MOE_T2 = NE * 28 * 8, MOE_TILES = MOE_T13 + MOE_T2, MOE_TQ = MOE_Q / 4, MOE_SLOT_TILES = (64 + 3 * 128) * MOE_TQ;
static_assert(MOE_SLOT_TILES <= MOE_TILES && MOE_Q % 4 == 0, "expert weight conversion slots");
__device__ __forceinline__ XtDesc moe_dec(const float* W13, const float* W2, unsigned char* ws, int t) {
    if (t < MOE_T13) { const int e = t / 448, r = t % 448, kb = r / 56, nb = r % 56;
        return XtDesc{W13 + (size_t)e * D * 2 * FE, 2 * FE, (nb & 1) * FE + (nb >> 1) * 128, 128 * kb, ws + WS_W_M13 + (size_t)e * 2 * FE * D, D, 128 * nb, nullptr, 64.f, 1}; }
    t -= MOE_T13; const int e = t / 224, r = t % 224, kb = r / 8, nb = r % 8;
    return XtDesc{W2 + (size_t)e * FE * D, D, 128 * nb, 128 * kb, ws + WS_W_M2 + (size_t)e * D * FE, FE, 128 * nb, nullptr, 128.f, 1};
}
constexpr int P0_DENSE_TILES = 64 + 192 + 352 + 176 + 64 + 64 + 64 + 128 + 160;
__device__ __forceinline__ XtDesc p0_dec(Frame& F, int g) {
    unsigned char* ws = F.ws;
    const int moe_first = (F.G == 256) ? MOE_SLOT_TILES : 0, moe_n = MOE_TILES - moe_first;
    if (g < moe_n) return moe_dec(F.a->in[24], F.a->in[25], ws, moe_first + g);
    g -= moe_n;
#define P0_JOB(...) { const XtJob j_{__VA_ARGS__}; const int n_ = xt_job_tiles(j_); if (g < n_) return xt_job_dec(j_, g); g -= n_; }
    P0_JOB(F.a->in[22], D, D, D, 0, ws + WS_W_ODOUT, nullptr, 1.f, MAP_ID, 0)
    P0_JOB(F.a->in[15], OD_SRC_N, D, 3072, 0, ws + WS_W_ODIN, F.a->in[14], 1.f, MAP_ODIN, 0)
    P0_JOB(F.a->in[12], 2 * FF, D, 2 * FF, FF, ws + WS_W_F13, F.a->in[30], (FFN_FP8 == 1) ? 64.f : 1.f, MAP_SWIGLU, (FFN_FP8 == 1) ? 1 : 0)
    P0_JOB(F.a->in[13], D, FF, D, 0, ws + WS_W_F2, nullptr, (FFN_FP8 >= 1) ? 128.f : 1.f, MAP_ID, (FFN_FP8 >= 1) ? 1 : 0)
    P0_JOB(F.a->in[29], D, XW, D, 0, ws + WS_W_XO, nullptr, 1.f, MAP_ID, 0)
    P0_JOB(F.a->in[29] + (size_t)XW * D, D, XW, D, 0, ws + WS_W_XO + (size_t)D * XW * 2, nullptr, 1.f, MAP_ID, 0)
    P0_JOB(F.a->in[27], XW, D, XW, 0, ws + WS_W_XQ, F.a->in[26], C2_128, MAP_ID, 0)
    P0_JOB(F.a->in[27] + (size_t)D * XW, XW, D, XW, 0, ws + WS_W_XQ + (size_t)XW * D * 2, F.a->in[26] + D, C2_128, MAP_ID, 0)
    P0_JOB(F.a->in[11], D, D, D, 0, ws + WS_W_EVOUT, nullptr, 1.f, MAP_ID, 0)
    P0_JOB(F.a->in[28], 1024, D, 1024, 0, ws + WS_W_MKV, nullptr, 1.f, MAP_ID, 0)
    P0_JOB(F.a->in[28] + (size_t)D * 1024, 1024, D, 1024, 0, ws + WS_W_MKV + (size_t)1024 * D * 2, nullptr, 1.f, MAP_ID, 0)
    { const XtJob j_{F.a->in[6], EV_SRC_N, D, 2560, 0, ws + WS_W_EVIN, F.a->in[5], 1.f, MAP_EVIN, 0}; return xt_job_dec(j_, g); }
#undef P0_JOB
}
__device__ __forceinline__ void p0_prologue(Frame& F) {
    unsigned char* ws = F.ws;
    __syncthreads();
    const int gw = F.vcu * NWAVES + F.wave, NGW = F.G * NWAVES, lane = F.lane;
    {
        const float* Ws = F.a->in[9]; bf16* WSB = (bf16*)(ws + WS_C2 + 512 * 1024);
        for (int u = (F.vcu * NWAVES + F.wave) * 64 + lane; u < 4 * 128 * 128 / 4; u += F.G * NWAVES * 64) { const int t = (u >> 5) & 127, s0 = (u & 31) * 4; f32x4 w = ((const f32x4*)Ws)[u];
            w.x = (s0 + 0 <= t) ? w.x : 0.f; w.y = (s0 + 1 <= t) ? w.y : 0.f; w.z = (s0 + 2 <= t) ? w.z : 0.f; w.w = (s0 + 3 <= t) ? w.w : 0.f;
            *(unsigned long long*)(WSB + (size_t)u * 4) = (unsigned long long)pk2(w.x, w.y) | ((unsigned long long)pk2(w.z, w.w) << 32); }
    }
    { const int moe_n = MOE_TILES - ((F.G == 256) ? MOE_SLOT_TILES : 0);
      xt_run(F, F.vcu, F.G, moe_n + P0_DENSE_TILES, [&](int g) { return p0_dec(F, g); }); }
    __syncthreads();
    {
        LAS float* wfg = (LAS float*)(F.lds);
        const float* Win = F.a->in[6]; const float* gn = F.a->in[5];
        for (int u = F.tid; u < 8 * 1024; u += NWAVES * 64) { const int k = u >> 3, j = u & 7; wfg[j * 1024 + k] = Win[(size_t)k * EV_SRC_N + 1536 + j] * gn[k]; }
        __syncthreads();
        const float* x = F.a->in[0]; const float* bfp = F.a->in[7];
        bf16* XB = (bf16*)(ws + WS_XB); float* SSQ = (float*)(ws + WS_SSQ); float* FLOG = (float*)(ws + WS_FLOG);
        const float bfv = bfp[lane & 7];
        auto xload = [&](RowF32& b, int m) { const GAS f32x4* xr = (const GAS f32x4*)(x + (size_t)m * D) + lane;
#pragma unroll
            for (int j = 0; j < 4; ++j) b.v[j] = __builtin_nontemporal_load((const f32x4*)xr + 64 * j); };
        auto xproc = [&](const RowF32& b, int m) {
            float s = 0.f;
#pragma unroll
            for (int j = 0; j < 4; ++j) s += (b.v[j].x * b.v[j].x + b.v[j].y * b.v[j].y) + (b.v[j].z * b.v[j].z + b.v[j].w * b.v[j].w);
            const float ssq = wave_sum(s), rs = __builtin_amdgcn_rsqf(ssq * (1.0f / D) + EPS);
            GAS unsigned long long* o8 = (GAS unsigned long long*)(XB + (size_t)m * D) + lane;
#pragma unroll
            for (int j = 0; j < 4; ++j) o8[64 * j] = (unsigned long long)pk2(b.v[j].x, b.v[j].y) | ((unsigned long long)pk2(b.v[j].z, b.v[j].w) << 32);
            float f[8];
#pragma unroll
            for (int c = 0; c < 8; ++c) { float a = 0.f;
#pragma unroll
                for (int j = 0; j < 4; ++j) { const f32x4 w = *(const LAS f32x4*)(wfg + c * 1024 + 4 * lane + 256 * j); a += (b.v[j].x * w.x + b.v[j].y * w.y) + (b.v[j].z * w.z + b.v[j].w * w.w); }
                f[c] = wave_sum(a); }
            float fl = f[0];
#pragma unroll
            for (int c = 1; c < 8; ++c) fl = (lane == c) ? f[c] : fl;
            if (lane < 8) { const float z = fl * rs + bfv; FLOG[(size_t)m * 8 + lane] = fminf(z, 0.f) - log1pf(expf(-fabsf(z))); }
            if (lane < 16) SSQ[(size_t)m * 16 + lane] = (lane == 0) ? ssq : 0.f; };
        ROWPIPE4(RowF32, M, xload, xproc);
        const float* mem = F.a->in[1]; const float* mg = F.a->in[3]; bf16* MEMN = (bf16*)(ws + WS_MEMN);
        for (int m = gw; m < MMEM; m += NGW) {
            const GAS f32x4* xr = (const GAS f32x4*)(mem + (size_t)m * D) + lane; const GAS f32x4* gr = (const GAS f32x4*)mg + lane;
            f32x4 v[4]; float s = 0.f;
#pragma unroll
            for (int j = 0; j < 4; ++j) { v[j] = xr[64 * j]; s += (v[j].x * v[j].x + v[j].y * v[j].y) + (v[j].z * v[j].z + v[j].w * v[j].w); }
            const float rs = __builtin_amdgcn_rsqf(wave_sum(s) * (1.0f / D) + EPS);
            GAS unsigned long long* o8 = (GAS unsigned long long*)(MEMN + (size_t)m * D) + lane;
#pragma unroll
            for (int j = 0; j < 4; ++j) { const f32x4 g = gr[64 * j]; o8[64 * j] = (unsigned long long)pk2(v[j].x * rs * g.x, v[j].y * rs * g.y) | ((unsigned long long)pk2(v[j].z * rs * g.z, v[j].w * rs * g.w) << 32); }
        }
        __syncthreads();
    }
}
__device__ __forceinline__ void m13_slot(Frame& F, int item0, int first_block) {
    const int rank = (int)blockIdx.x - first_block; if (rank < 0 || F.G != 256) return;
    const float* W13 = F.a->in[24]; const float* W2 = F.a->in[25]; unsigned char* ws = F.ws; const int base = item0 / 4 + rank * MOE_TQ;
    xt_run(F, 0, 1, MOE_TQ, [&](int k) { return moe_dec(W13, W2, ws, base + k); });
}
__device__ __forceinline__ void cumsum_seq(Frame& F, int sq) {
    const float* FLOG = (const float*)(F.ws + WS_FLOG); float* C2 = (float*)(F.ws + WS_C2);
    const int b = sq >> 3, h = sq & 7, lane = F.lane;
    const float* src = FLOG + ((size_t)b * SEQ + 32 * lane) * 8 + h;
    float v[32]; float run = 0.f;
#pragma unroll
    for (int i = 0; i < 32; ++i) { run += src[i * 8]; v[i] = run; }
    float tot = run;
#pragma unroll
    for (int o = 1; o < 64; o <<= 1) { const float t = __shfl_up(tot, o); if (lane >= o) tot += t; }
    const float base = tot - run;
    float* dst = C2 + (size_t)sq * SEQ + 32 * lane;
#pragma unroll
    for (int i = 0; i < 32; ++i) dst[i] = (base + v[i]) * LOG2E;
}
__device__ __forceinline__ void sgu_unit(Frame& F, int b, int c, int g) {
    typedef att::bf16x8 bf16x8; typedef att::f32x16 f32x16;
    constexpr int LP = 136;
    constexpr int V_OFF = 40960, ST_OFF = 73728;
    LAS unsigned short* Wl = (LAS unsigned short*)(F.lds); LAS char* Vl = (LAS char*)(F.lds + V_OFF); LAS unsigned short* St = (LAS unsigned short*)(F.lds + ST_OFF);
    const int tid = F.tid, lane = F.lane, wid = F.wave, r32 = lane & 31, hi = lane >> 5;
    const bf16* P = (const bf16*)(F.ws + WS_P); bf16* AG = (bf16*)(F.ws + WS_AG); const bf16* WSB = (const bf16*)(F.ws + WS_C2 + 512 * 1024);
    const size_t row0 = (size_t)b * SEQ + (size_t)c * 128;
    {
        const int t = tid >> 2, s0 = (tid & 3) * 32; const v4u* wp = (const v4u*)(WSB + ((size_t)g * 128 + t) * 128 + s0);
#pragma unroll
        for (int i = 0; i < 4; ++i) *(LAS v4u*)(Wl + t * LP + s0 + 8 * i) = wp[i];
    }
    {
        const int s = tid >> 2, d0 = (tid & 3) * 32; const bf16* vp = P + (row0 + s) * PW + 2048 + g * 128 + d0; const float* gn = F.a->in[8] + g * 128 + d0;
        float v[32]; float ss = 0.f;
#pragma unroll
        for (int i = 0; i < 4; ++i) { const v4u w = ((const v4u*)vp)[i];
            v[8 * i + 0] = bflo(w.x); v[8 * i + 1] = bfhi(w.x); v[8 * i + 2] = bflo(w.y); v[8 * i + 3] = bfhi(w.y); v[8 * i + 4] = bflo(w.z); v[8 * i + 5] = bfhi(w.z); v[8 * i + 6] = bflo(w.w); v[8 * i + 7] = bfhi(w.w); }
#pragma unroll
        for (int i = 0; i < 32; ++i) ss += v[i] * v[i];
        ss += __shfl_xor(ss, 1); ss += __shfl_xor(ss, 2);
        const float rs = __builtin_amdgcn_rsqf(ss * (1.0f / 128.0f) + EPS);
#pragma unroll
        for (int i = 0; i < 4; ++i) { const f32x4 ga = *(const f32x4*)(gn + 8 * i), gb = *(const f32x4*)(gn + 8 * i + 4);
            const v4u o = {pk2(v[8 * i] * rs * ga.x, v[8 * i + 1] * rs * ga.y), pk2(v[8 * i + 2] * rs * ga.z, v[8 * i + 3] * rs * ga.w), pk2(v[8 * i + 4] * rs * gb.x, v[8 * i + 5] * rs * gb.y), pk2(v[8 * i + 6] * rs * gb.z, v[8 * i + 7] * rs * gb.w)};
            *(LAS v4u*)(Vl + (s >> 6) * 16384 + att::v_st<4>(s & 63, d0 + 8 * i)) = o; }
    }
    __syncthreads();
    const int wt = wid >> 1, wd = wid & 1;
    f32x16 acc0 = f32x16{}, acc1 = f32x16{};
    const int vb = (int)(unsigned)(uintptr_t)Vl + att::v_rd_base(lane);
    for (int sb = 0; sb <= (wt >> 1); ++sb) {
        const LAS unsigned short* wr_ = Wl + (32 * wt + r32) * LP + 64 * sb + 8 * hi;
        const bf16x8 pa0 = *(const LAS bf16x8*)(wr_), pa1 = *(const LAS bf16x8*)(wr_ + 16), pa2 = *(const LAS bf16x8*)(wr_ + 32), pa3 = *(const LAS bf16x8*)(wr_ + 48);
        if (wd == 0) { att::pv_one<4, 0, false>(acc0, vb + sb * 16384, pa0, pa1, pa2, pa3); att::pv_one<4, 1, false>(acc1, vb + sb * 16384, pa0, pa1, pa2, pa3); }
        else         { att::pv_one<4, 2, false>(acc0, vb + sb * 16384, pa0, pa1, pa2, pa3); att::pv_one<4, 3, false>(acc1, vb + sb * 16384, pa0, pa1, pa2, pa3); }
    }
    const float* bsp = F.a->in[10] + g * 128;
#pragma unroll
    for (int r = 0; r < 16; ++r) { const int t = 32 * wt + att::crow(r, hi); const float bs = bsp[t];
        St[t * LP + 64 * wd + r32] = (unsigned short)f2bf(acc0[r] + bs); St[t * LP + 64 * wd + 32 + r32] = (unsigned short)f2bf(acc1[r] + bs); }
    __syncthreads();
#pragma unroll
    for (int i = 0; i < 4; ++i) { const int ch = tid + 512 * i, t = ch >> 4, dc = (ch & 15) * 8;
        const v4u m = *(const LAS v4u*)(St + t * LP + dc); const v4u u = *(const v4u*)(P + (row0 + t) * PW + 1536 + g * 128 + dc);
        const v4u o = {pk2(bflo(u.x) * bflo(m.x), bfhi(u.x) * bfhi(m.x)), pk2(bflo(u.y) * bflo(m.y), bfhi(u.y) * bfhi(m.y)), pk2(bflo(u.z) * bflo(m.z), bfhi(u.z) * bfhi(m.z)), pk2(bflo(u.w) * bflo(m.w), bfhi(u.w) * bfhi(m.w))};
        *(v4u*)(AG + (row0 + t) * D + 512 + g * 128 + dc) = o; }
    __syncthreads();
}
__device__ __forceinline__ void odd_glue_phase(Frame& F) {
    const int gw = F.vcu * NWAVES + F.wave, NGW = F.G * NWAVES, lane = F.lane;
    const bf16* P = (const bf16*)(F.ws + WS_P); const bf16* OD0 = (const bf16*)(F.ws + WS_OD); const bf16* OD1 = OD0 + (size_t)M * 512; bf16* CD = (bf16*)(F.ws + WS_AG);
    const float lam = expf(wave_sum(F.a->in[17][lane] * F.a->in[18][lane])) - expf(wave_sum(F.a->in[19][lane] * F.a->in[20][lane])) + LAM_INIT;
    const float* cw = F.a->in[16]; const float* sub = F.a->in[21];
    float w0[8], w1[8], w2[8], sg[8];
#pragma unroll
    for (int i = 0; i < 8; ++i) { w0[i] = cw[8 * lane + i]; w1[i] = cw[512 + 8 * lane + i]; w2[i] = cw[1024 + 8 * lane + i]; sg[i] = sub[(8 * lane + i) & 127] * (1.0f - LAM_INIT); }
    struct OBuf { v4u bg, x2, x1, x0, o0, o1; };
    auto oload = [&](OBuf& b, int m) { const int t = m & (SEQ - 1); const bf16* pr = P + (size_t)m * PW + 8 * lane;
        b.bg = *(const v4u*)pr; b.x2 = *(const v4u*)(pr + 512);
        b.x1 = *(const v4u*)(pr + 512 - (t >= 1 ? PW : 0)); b.x0 = *(const v4u*)(pr + 512 - (t >= 2 ? 2 * PW : 0));
        b.o0 = *(const v4u*)(OD0 + (size_t)m * 512 + 8 * lane); b.o1 = *(const v4u*)(OD1 + (size_t)m * 512 + 8 * lane); };
    auto oproc = [&](const OBuf& b, int m) {
        const int t = m & (SEQ - 1); const unsigned k1 = t >= 1 ? 0xffffffffu : 0u, k0 = t >= 2 ? 0xffffffffu : 0u;
        const unsigned bgw[4] = {b.bg.x, b.bg.y, b.bg.z, b.bg.w}, a2[4] = {b.x2.x, b.x2.y, b.x2.z, b.x2.w}, a1[4] = {b.x1.x & k1, b.x1.y & k1, b.x1.z & k1, b.x1.w & k1}, a0[4] = {b.x0.x & k0, b.x0.y & k0, b.x0.z & k0, b.x0.w & k0};
        unsigned oc[4];
#pragma unroll
        for (int i = 0; i < 4; ++i) {
            const float lo = bflo(bgw[i]) * (w0[2 * i] * bflo(a0[i]) + w1[2 * i] * bflo(a1[i]) + w2[2 * i] * bflo(a2[i]));
            const float hi = bfhi(bgw[i]) * (w0[2 * i + 1] * bfhi(a0[i]) + w1[2 * i + 1] * bfhi(a1[i]) + w2[2 * i + 1] * bfhi(a2[i]));
            oc[i] = pk2(lo, hi); }
        *(v4u*)(CD + (size_t)m * D + 8 * lane) = (v4u){oc[0], oc[1], oc[2], oc[3]};
        const unsigned p0[4] = {b.o0.x, b.o0.y, b.o0.z, b.o0.w}, p1[4] = {b.o1.x, b.o1.y, b.o1.z, b.o1.w};
        float dv[8]; float ss = 0.f;
#pragma unroll
        for (int i = 0; i < 4; ++i) { dv[2 * i] = bflo(p0[i]) - lam * bflo(p1[i]); dv[2 * i + 1] = bfhi(p0[i]) - lam * bfhi(p1[i]); ss += dv[2 * i] * dv[2 * i] + dv[2 * i + 1] * dv[2 * i + 1]; }
        ss += __shfl_xor(ss, 1); ss += __shfl_xor(ss, 2); ss += __shfl_xor(ss, 4); ss += __shfl_xor(ss, 8);
        const float rs = __builtin_amdgcn_rsqf(ss * (1.0f / 128.0f) + EPS);
        *(v4u*)(CD + (size_t)m * D + 512 + 8 * lane) = (v4u){pk2(dv[0] * rs * sg[0], dv[1] * rs * sg[1]), pk2(dv[2] * rs * sg[2], dv[3] * rs * sg[3]), pk2(dv[4] * rs * sg[4], dv[5] * rs * sg[5]), pk2(dv[6] * rs * sg[6], dv[7] * rs * sg[7])}; };
    ROWPIPE4(OBuf, M, oload, oproc);
}
__device__ __forceinline__ void load_row_bf16(const bf16* row, int lane, f32x4 (&v)[4]) {
    const GAS unsigned long long* p = (const GAS unsigned long long*)row + lane;
#pragma unroll
    for (int j = 0; j < 4; ++j) { const unsigned long long w = p[64 * j]; v[j] = (f32x4){bflo((unsigned)w), bfhi((unsigned)w), bflo((unsigned)(w >> 32)), bfhi((unsigned)(w >> 32))}; }
}
__device__ __forceinline__ void router_phase(Frame& F) {
    const int gw = F.vcu * NWAVES + F.wave, NGW = F.G * NWAVES, lane = F.lane;
    LAS float* wrl = (LAS float*)(F.lds);
    LAS int* rec_e = (LAS int*)(F.lds + 32768);
    LAS int* rec_r = rec_e + 512;
    LAS float* rec_w = (LAS float*)(rec_r + 512);
    LAS int* lcnt = (LAS int*)(rec_w + 1024); LAS int* lbase = lcnt + 8; LAS int* ltile = lbase + 8;
    { const float* Wr = F.a->in[23]; const float* gn = F.a->in[30] + D;
      for (int u = F.tid; u < 8 * 1024; u += NWAVES * 64) { const int k = u >> 3, e = u & 7; wrl[e * 1024 + k] = Wr[u] * gn[k]; }
      if (F.tid < 8) lcnt[F.tid] = 0; }
    __syncthreads();
    const bf16* X = (const bf16*)(F.ws + WS_XB); unsigned* cnt = (unsigned*)(F.ctl + CW_CNT);
    int* TOKP = (int*)(F.ws + WS_TOK + 512 * 1024); unsigned char* HG = F.ws + WS_HG; float* GATE = (float*)(F.ws + WS_GATE);
    const GAS f32x4* gr = (const GAS f32x4*)(F.a->in[30] + D) + lane;
    auto rload = [&](RowBf16& b, int m) { const GAS unsigned long long* p = (const GAS unsigned long long*)(X + (size_t)m * D) + lane;
#pragma unroll
        for (int j = 0; j < 4; ++j) b.w[j] = p[64 * j]; };
    auto rproc = [&](const RowBf16& b, int m) {
        f32x4 v[4]; float s = 0.f;
#pragma unroll
        for (int j = 0; j < 4; ++j) { v[j] = (f32x4){bflo((unsigned)b.w[j]), bfhi((unsigned)b.w[j]), bflo((unsigned)(b.w[j] >> 32)), bfhi((unsigned)(b.w[j] >> 32))};
            s += (v[j].x * v[j].x + v[j].y * v[j].y) + (v[j].z * v[j].z + v[j].w * v[j].w); }
        const float rs = __builtin_amdgcn_rsqf(wave_sum(s) * (1.0f / D) + EPS);
        float lg[8];
#pragma unroll
        for (int e = 0; e < 8; ++e) { float a = 0.f;
#pragma unroll
            for (int j = 0; j < 4; ++j) { const f32x4 w = *(const LAS f32x4*)(wrl + e * 1024 + 4 * lane + 256 * j); a += (v[j].x * w.x + v[j].y * w.y) + (v[j].z * w.z + v[j].w * w.w); }
            lg[e] = wave_sum(a) * rs; }
        int i1 = 0; float v1 = lg[0];
#pragma unroll
        for (int e = 1; e < 8; ++e) if (lg[e] > v1) { v1 = lg[e]; i1 = e; }
        int i2 = -1; float v2 = -INFINITY;
#pragma unroll
        for (int e = 0; e < 8; ++e) if (e != i1 && lg[e] > v2) { v2 = lg[e]; i2 = e; }
        const float w1 = 1.0f / (1.0f + expf(v2 - v1));
        if (lane == 0) { const int k = (m - gw) / NGW, ri = F.wave * 64 + k;
            const int r1 = __hip_atomic_fetch_add(lcnt + i1, 1, __ATOMIC_RELAXED, __HIP_MEMORY_SCOPE_WORKGROUP), r2 = __hip_atomic_fetch_add(lcnt + i2, 1, __ATOMIC_RELAXED, __HIP_MEMORY_SCOPE_WORKGROUP);
            rec_e[ri] = i1 | (i2 << 8); rec_r[ri] = r1 | (r2 << 16); rec_w[2 * ri] = w1; rec_w[2 * ri + 1] = rs; } };
    const bool keep8 = (NGW * 8 == M);
    RowBf16 r8[8];
    if (keep8) {
#pragma unroll
        for (int k = 0; k < 8; ++k) rload(r8[k], gw + k * NGW);
#pragma unroll
        for (int k = 0; k < 8; ++k) rproc(r8[k], gw + k * NGW);
    } else ROWPIPE(RowBf16, M, rload, rproc);
    __syncthreads();
    if (F.tid < 8) { const int e = F.tid, n = lcnt[e]; unsigned bs = 0u;
        if (n > 0) { bs = __hip_atomic_fetch_add(cnt + e, (unsigned)n, RLX_AGENT);
            for (unsigned sl = (bs + 255u) & ~255u; sl < bs + (unsigned)n; sl += 256u) { const unsigned t = __hip_atomic_fetch_add(F.ctl + CW_NT, 1u, RLX_AGENT);
                __hip_atomic_store(F.ctl + CW_TEXP + t, (unsigned)e, RLX_AGENT); __hip_atomic_store(F.ctl + CW_TID + e * 64 + (int)(sl >> 8), t + 1u, RLX_AGENT); } }
        lbase[e] = (int)bs; }
    __syncthreads();
    if (F.tid < 16) { const int e = F.tid >> 1, n = lcnt[e]; int tv = 0;
        if (n > 0) { const unsigned bs = (unsigned)lbase[e], sl = (F.tid & 1) ? bs + (unsigned)n - 1u : bs; gu32* tp = F.ctl + CW_TID + e * 64 + (int)(sl >> 8); unsigned t, k = 0u;
            while ((t = __hip_atomic_load(tp, RLX_AGENT)) == 0u) { __builtin_amdgcn_s_sleep(1); if (++k > (1u << 16)) { t = 1u; break; } }
            tv = (int)(t - 1u); }
        ltile[F.tid] = tv; }
    __syncthreads();
    f32x4 g4[4];
#pragma unroll
    for (int j = 0; j < 4; ++j) g4[j] = gr[64 * j];
    auto wproc = [&](const RowBf16& b, int m) {
        const int k = (m - gw) / NGW, ri = F.wave * 64 + k;
        const int ee = rec_e[ri], rr = rec_r[ri]; const float w1 = rec_w[2 * ri], rs = rec_w[2 * ri + 1];
        const int e1 = ee & 255, e2 = ee >> 8; const unsigned s1 = (unsigned)(lbase[e1] + (rr & 0xffff)), s2 = (unsigned)(lbase[e2] + (rr >> 16));
        const int t1 = ltile[2 * e1 + (((s1 >> 8) != ((unsigned)lbase[e1] >> 8)) ? 1 : 0)], t2 = ltile[2 * e2 + (((s2 >> 8) != ((unsigned)lbase[e2] >> 8)) ? 1 : 0)];
        const int p1 = __builtin_amdgcn_readfirstlane(t1 * 256 + (int)(s1 & 255u)), p2 = __builtin_amdgcn_readfirstlane(t2 * 256 + (int)(s2 & 255u));
        if (lane == 0) { GATE[p1] = w1; GATE[p2] = 1.0f - w1; *(int2*)(TOKP + (size_t)m * 2) = make_int2(p1, p2); }
        GAS unsigned* o1 = (GAS unsigned*)(HG + (size_t)p1 * D) + lane; GAS unsigned* o2 = (GAS unsigned*)(HG + (size_t)p2 * D) + lane;
#pragma unroll
        for (int j = 0; j < 4; ++j) { const f32x4 g = g4[j];
            const unsigned w = pk4_fp8(bflo((unsigned)b.w[j]) * rs * g.x, bfhi((unsigned)b.w[j]) * rs * g.y, bflo((unsigned)(b.w[j] >> 32)) * rs * g.z, bfhi((unsigned)(b.w[j] >> 32)) * rs * g.w);
            o1[64 * j] = w; o2[64 * j] = w; } };
    if (keep8) {
#pragma unroll
        for (int k = 0; k < 8; ++k) wproc(r8[k], gw + k * NGW);
    } else ROWPIPE(RowBf16, M, rload, wproc);
}
__device__ __forceinline__ int moe_base(const unsigned* cnt, int e) {
    int b = 0;
#pragma unroll
    for (int j = 0; j < 8; ++j) b += (j < e) ? (int)((cnt[j] + 255u) >> 8) : 0;
    return b * 256;
}
__device__ __forceinline__ void final_phase(Frame& F) {
    const int gw = F.vcu * NWAVES + F.wave, NGW = F.G * NWAVES, lane = F.lane;
    const bf16* X = (const bf16*)(F.ws + WS_XB); float* OUT = F.out; const int* TOKP = (const int*)(F.ws + WS_TOK + 512 * 1024); const bf16* Y = (const bf16*)(F.ws + WS_Y); const float* gn = F.a->in[4];
    struct FBuf { unsigned long long x[4], a[4], b[4]; };
    const bf16* YP = (const bf16*)(F.ws + WS_OD);
    auto yfast = [&](unsigned long long (&d)[4], int p) { const GAS unsigned long long* y = (const GAS unsigned long long*)(Y + (size_t)(p & 32767) * D) + lane;
#pragma unroll
        for (int j = 0; j < 4; ++j) d[j] = y[64 * j]; };
    auto yslow = [&](unsigned long long (&d)[4], int p) {
        if (p >= 32768) { unsigned long long w[7][4];
#pragma unroll
            for (int sl = 0; sl < 7; ++sl) { const GAS unsigned long long* y = (const GAS unsigned long long*)(YP + ((size_t)sl * 2048 + (p - 32768)) * D) + lane;
#pragma unroll
                for (int j = 0; j < 4; ++j) w[sl][j] = y[64 * j]; }
#pragma unroll
            for (int j = 0; j < 4; ++j) { float a0 = 0.f, a1 = 0.f, a2 = 0.f, a3 = 0.f;
#pragma unroll
                for (int sl = 0; sl < 7; ++sl) { a0 += bflo((unsigned)w[sl][j]); a1 += bfhi((unsigned)w[sl][j]); a2 += bflo((unsigned)(w[sl][j] >> 32)); a3 += bfhi((unsigned)(w[sl][j] >> 32)); }
                d[j] = (unsigned long long)pk2(a0, a1) | ((unsigned long long)pk2(a2, a3) << 32); } } };
    const GAS f32x4* gr = (const GAS f32x4*)gn + lane;
    int2 ppv = make_int2(0, 0);
    { const int mk = gw + lane * NGW; if (mk < M) ppv = *(const int2*)(TOKP + (size_t)mk * 2); }
    auto fload = [&](FBuf& b, int m) { const int k = (m - gw) / NGW; const int p1 = __builtin_amdgcn_readlane(ppv.x, k), p2 = __builtin_amdgcn_readlane(ppv.y, k);
        const GAS unsigned long long* px = (const GAS unsigned long long*)(X + (size_t)m * D) + lane;
#pragma unroll
        for (int j = 0; j < 4; ++j) b.x[j] = px[64 * j];
        yfast(b.a, p1); yfast(b.b, p2); };
    f32x4 g4[4];
#pragma unroll
    for (int j = 0; j < 4; ++j) g4[j] = gr[64 * j];
    auto fproc = [&](FBuf& b, int m) {
        { const int k = (m - gw) / NGW; yslow(b.a, __builtin_amdgcn_readlane(ppv.x, k)); yslow(b.b, __builtin_amdgcn_readlane(ppv.y, k)); }
        GAS f32x4* xr = (GAS f32x4*)(OUT + (size_t)m * D) + lane;
        f32x4 v[4]; float s = 0.f;
#pragma unroll
        for (int j = 0; j < 4; ++j) { const unsigned long long x = b.x[j], a = b.a[j], c = b.b[j];
            v[j].x = bflo((unsigned)x) + bflo((unsigned)a) + bflo((unsigned)c); v[j].y = bfhi((unsigned)x) + bfhi((unsigned)a) + bfhi((unsigned)c);
            v[j].z = bflo((unsigned)(x >> 32)) + bflo((unsigned)(a >> 32)) + bflo((unsigned)(c >> 32)); v[j].w = bfhi((unsigned)(x >> 32)) + bfhi((unsigned)(a >> 32)) + bfhi((unsigned)(c >> 32));
            s += (v[j].x * v[j].x + v[j].y * v[j].y) + (v[j].z * v[j].z + v[j].w * v[j].w); }
        const float rs = __builtin_amdgcn_rsqf(wave_sum(s) * (1.0f / D) + EPS);
#pragma unroll
        for (int j = 0; j < 4; ++j) { const f32x4 g = g4[j]; __builtin_nontemporal_store((f32x4){v[j].x * rs * g.x, v[j].y * rs * g.y, v[j].z * rs * g.z, v[j].w * rs * g.w}, (f32x4*)xr + 64 * j); } };
    ROWPIPE4(FBuf, M, fload, fproc);
}
__device__ __forceinline__ void fox_sgu_phase(Frame& F) {
    using G = att::Geo<64, 64>;
    LAS char* lds = (LAS char*)F.lds;
    const bf16* P = (const bf16*)(F.ws + WS_P); bf16* AG = (bf16*)(F.ws + WS_AG); const float* C2 = (const float*)(F.ws + WS_C2);
    for (int pr = F.vcu; pr < 256; pr += F.G) {
        const int bh = pr >> 2, s = pr & 3, b = bh >> 3, h = bh & 7;
        LAS v4u* tab = (LAS v4u*)(lds + fx::LDS_TAB);
        int tid_o = F.tid; asm volatile("" : "+v"(tid_o));
        for (int u = tid_o; u < SEQ / 4; u += NWAVES * 64) { const f32x4 c = ((const f32x4*)(C2 + (size_t)bh * SEQ))[u]; v4u e;
            { const unsigned h_ = f2bf(-c.x); e.x = h_ | (f2bf(-c.x - bf2f((unsigned short)h_)) << 16); } { const unsigned h_ = f2bf(-c.y); e.y = h_ | (f2bf(-c.y - bf2f((unsigned short)h_)) << 16); }
            { const unsigned h_ = f2bf(-c.z); e.z = h_ | (f2bf(-c.z - bf2f((unsigned short)h_)) << 16); } { const unsigned h_ = f2bf(-c.w); e.w = h_ | (f2bf(-c.w - bf2f((unsigned short)h_)) << 16); }
            tab[u] = e; }
        __syncthreads();
        for (int k = 0; k < 2; ++k) { const int qb = (k == 0) ? 7 - s : s; const size_t row0 = (size_t)b * SEQ + (size_t)qb * 256, kv0 = (size_t)b * SEQ * PW;
            fx::fox_unit<PW, PW, D, FOX_THR>(P + row0 * PW + h * 64, P + kv0 + 512 + h * 64, P + kv0 + 1024 + h * 64, AG + row0 * D + h * 64, qb * 256, lds); }
    }
    Frame F2 = F; asm volatile("" : "+v"(F2.tid), "+v"(F2.lane));
    for (int u = F.vcu; u < 512; u += F.G) sgu_unit(F2, u >> 6, (u >> 2) & 15, u & 3);
}
__device__ __forceinline__ void diff_phase(Frame& F) {
    using G = attd::Geo<64, 128>;
    LAS char* lds = (LAS char*)F.lds;
    const bf16* P = (const bf16*)(F.ws + WS_P); bf16* OD = (bf16*)(F.ws + WS_OD); const float* RB = F.a->in[2];
    for (int pr = F.vcu; pr < 256; pr += F.G) {
        const int bhi = pr >> 2, s = pr & 3, b = bhi >> 3, h = (bhi >> 1) & 3, i = bhi & 1;
        LAS float* tab = (LAS float*)(lds + G::TAB_OFF);
        if (F.tid < 128) { const int d = F.tid; int bk = d;
            if (d >= 16) { bk = 16 + (int)(logf((float)d * (1.0f / 16.0f)) / logf(8.0f) * 16.0f); bk = bk > 31 ? 31 : bk; }
            tab[d] = RB[bk * 4 + h] * LOG2E; }
        __syncthreads();
        for (int u = F.tid; u < 4 * 520; u += NWAVES * 64) { const int c = u / 520, j = u - c * 520, d = j + c - 256;
            ((LAS float*)(lds + G::EXT_OFF))[c * 520 + j] = d < 0 ? -INFINITY : tab[d > 127 ? 127 : d]; }
        __syncthreads();
        for (int k = 0; k < 2; ++k) { const int qb = (k == 0) ? 7 - s : s; const size_t row0 = (size_t)b * SEQ + (size_t)qb * 256, kv0 = (size_t)b * SEQ * PW;
            attd::attn_unit<64, 128, 2, PW, PW, 512>(P + row0 * PW + 1024 + h * 128 + i * 64, P + kv0 + 1536 + h * 128 + i * 64, P + kv0 + 2048 + h * 128, OD + (size_t)i * M * 512 + row0 * 512 + h * 128, 4 * (qb + 1), qb * 256, lds); }
    }
}
__device__ __forceinline__ void xattn_phase(Frame& F, int layer) {
    LAS char* lds = (LAS char*)F.lds;
    const bf16* QX = (const bf16*)(F.ws + WS_QX); const bf16* KVM = (const bf16*)(F.ws + WS_KVM); bf16* OX = (bf16*)(F.ws + WS_OX);
    for (int u = F.vcu; u < 256; u += F.G) { const int b = u >> 5, h = (u >> 3) & 3, qb = u & 7; const size_t row0 = (size_t)b * SEQ + (size_t)qb * 256;
        const bf16* kp = KVM + (size_t)b * MEMLEN * 2048 + layer * 1024 + h * 128;
        attd::attn_unit<128, 128, 0, 512, 2048, 512>(QX + row0 * 512 + h * 128, kp, kp + 512, OX + row0 * 512 + h * 128, 4, 0, lds); }
}

constexpr int N_PHASES = 21;
__global__ void __launch_bounds__(NWAVES * 64, 2) hyb_fwd(Args args) {
    extern __shared__ __attribute__((aligned(16))) unsigned char lds[];
    Frame F;
    F.lds = (LAS unsigned char*)lds;
    F.MISC = (volatile LAS unsigned*)(F.lds + MISC_OFF);
    F.tid = threadIdx.x; F.lane = F.tid & 63; F.wave = __builtin_amdgcn_readfirstlane(F.tid >> 6);
    F.G = gridDim.x; { const int bx = blockIdx.x; F.vcu = (F.G % 8 == 0) ? (bx % 8) * (F.G / 8) + bx / 8 : bx; }
    F.a = &args;
    F.out = args.out; F.ws = args.ws; F.ctl = (gu32*)(args.ws + WS_CTL);
    unsigned char* ws = args.ws;
    for (int u = F.tid; u < (LDS_BYTES - LDSCTL_OFF) / 4; u += NWAVES * 64) ((LAS unsigned*)(F.lds + LDSCTL_OFF))[u] = 0u;
    __syncthreads();
    XcdBarrier bar; bar.bar = (unsigned*)(F.ctl + CW_BAR); bar.x = 0; bar.st = nullptr;
    if (!MK_PER_PHASE) bar = xcd_barrier_post((unsigned*)(F.ctl + CW_BAR), F.MISC + 8);
#define GRID_BAR() do { if (!MK_PER_PHASE) xcd_barrier(bar); } while (0)
    const int lo = args.ph_lo, hi = args.ph_hi;
#ifndef PH_MASK
#define PH_MASK 0x1fffff
#endif
#define IN(k) (((PH_MASK >> (k)) & 1) && lo <= (k) && (k) < hi)
#ifndef DUP_MASK
#define DUP_MASK 0
#endif
#define DUP(k) (((DUP_MASK >> (k)) & 1) ? 2 : 1)
#define SEAM(k) do { if (IN(k) && IN((k) + 1)) GRID_BAR(); } while (0)
    const int bx = (int)blockIdx.x, G = F.G;
    bf16* XB = (bf16*)(ws + WS_XB); float* SSQ = (float*)(ws + WS_SSQ); bf16* P = (bf16*)(ws + WS_P); bf16* AG = (bf16*)(ws + WS_AG);
    bf16* QX = (bf16*)(ws + WS_QX); bf16* OX = (bf16*)(ws + WS_OX); bf16* ACT = (bf16*)(ws + WS_ACT);

    if (IN(0)) p0_prologue(F);
    SEAM(0);
    if (IN(1)) {
        if (F.wave == 0) for (int sq = G - 1 - bx; sq < 64; sq += G) cumsum_seq(F, sq);
        { pg8::Gemm g{XB, (const bf16*)(ws + WS_W_EVIN), M, 2560, D}; pg8::StaticOrder S; S.init(M, 2560, G, bx);
          pg8::EpiIn<0> E{P, SSQ}; pg8::gemm_phase<pg8::EpiIn<0>, pg8::StaticOrder, true, true>(F.lds + RING_OFF, g, S, E); }
        { pg8::Gemm g{(const bf16*)(ws + WS_MEMN), (const bf16*)(ws + WS_W_MKV), MMEM, 2048, D}; pg8::StaticOrder S; S.init(MMEM, 2048, G, (bx + G / 2) % G);
          pg8::EpiPlain<false> E{(bf16*)(ws + WS_KVM), 2048, nullptr}; pg8::gemm_phase<pg8::EpiPlain<false>, pg8::StaticOrder, true, true>(F.lds + RING_OFF, g, S, E); }
    }
    if (IN(1)) m13_slot(F, 0, 192);
    SEAM(1);
    if (IN(2)) fox_sgu_phase(F);
    SEAM(2);
    if (IN(3)) { pg8::Gemm g{AG, (const bf16*)(ws + WS_W_EVOUT), M, D, D}; pg8::StaticOrder S; S.init(M, D, G, bx);
        pg8::EpiResid<false> E{XB, SSQ, nullptr, 1.0f}; pg8::gemm_phase<pg8::EpiResid<false>, pg8::StaticOrder, true, true>(F.lds + RING_OFF, g, S, E); }
    SEAM(3);
    if (IN(4)) { pg8::Gemm g{XB, (const bf16*)(ws + WS_W_XQ), M, XW, D}; pg8::StaticOrder S; S.init(M, XW, G, bx);
        pg8::EpiPlain<true> E{QX, XW, SSQ}; pg8::gemm_phase<pg8::EpiPlain<true>, pg8::StaticOrder, true, true>(F.lds + RING_OFF, g, S, E); }
    if (IN(4)) m13_slot(F, 64 * M13_Q, 128);
    SEAM(4);
    if (IN(5)) xattn_phase(F, 0);
    SEAM(5);
#if FFN_FP8 == 1
    if (IN(6)) { pg8::Gemm g{OX, (const bf16*)(ws + WS_W_XO), M, D, XW}; pg8::StaticOrder S; S.init(M, D, G, bx);
        pg8::EpiResid<true> E{XB, SSQ, ws + WS_XB8, 1.0f}; pg8::gemm_phase<pg8::EpiResid<true>, pg8::StaticOrder, true, true>(F.lds + RING_OFF, g, S, E); }
#else
    if (IN(6)) { pg8::Gemm g{OX, (const bf16*)(ws + WS_W_XO), M, D, XW}; pg8::StaticOrder S; S.init(M, D, G, bx);
        pg8::EpiResid<false> E{XB, SSQ, nullptr, 1.0f}; pg8::gemm_phase<pg8::EpiResid<false>, pg8::StaticOrder, true, true>(F.lds + RING_OFF, g, S, E); }
#endif
    SEAM(6);
#if FFN_FP8 == 2
    if (IN(7)) { pg8::Gemm g{XB, (const bf16*)(ws + WS_W_F13), M, 2 * FF, D}; pg8::StaticOrder S; S.init(M, 2 * FF, G, bx);
        pg8::EpiSwigluF8<22, true> E{ws + WS_ACT, FF, 1.0f, SSQ}; pg8::gemm_phase<pg8::EpiSwigluF8<22, true>, pg8::StaticOrder, true, true>(F.lds + RING_OFF, g, S, E); }
#elif FFN_FP8 == 1
    if (IN(7)) { pg8::Gemm g{(const bf16*)(ws + WS_XB8), (const bf16*)(ws + WS_W_F13), M, 2 * FF, D}; pg8::StaticOrder S; S.init(M, 2 * FF, G, bx);
        pg8::EpiSwigluF8<22, true> E{ws + WS_ACT, FF, 1.0f / 64.0f, SSQ}; pg8::gemm_phase<pg8::EpiSwigluF8<22, true>, pg8::StaticOrder, true, true, true>(F.lds + RING_OFF, g, S, E); }
#else
    if (IN(7)) { pg8::Gemm g{XB, (const bf16*)(ws + WS_W_F13), M, 2 * FF, D}; pg8::StaticOrder S; S.init(M, 2 * FF, G, bx);
        pg8::EpiSwiglu<22> E{ACT, FF, SSQ}; pg8::gemm_phase<pg8::EpiSwiglu<22>, pg8::StaticOrder, true, true>(F.lds + RING_OFF, g, S, E); }
#endif
    if (IN(7)) m13_slot(F, (64 + 128) * M13_Q, 128);
    SEAM(7);
#if FFN_FP8 >= 1
    if (IN(8)) { pg8::Gemm g{(const bf16*)(ws + WS_ACT), (const bf16*)(ws + WS_W_F2), M, D, FF}; pg8::StaticOrder S; S.init(M, D, G, bx);
        pg8::EpiResid<false> E{XB, SSQ, nullptr, 1.0f / 128.0f}; pg8::gemm_phase<pg8::EpiResid<false>, pg8::StaticOrder, true, true, true>(F.lds + RING_OFF, g, S, E); }
#else
    if (IN(8)) { pg8::Gemm g{ACT, (const bf16*)(ws + WS_W_F2), M, D, FF}; pg8::StaticOrder S; S.init(M, D, G, bx);
        pg8::EpiResid<false> E{XB, SSQ, nullptr, 1.0f}; pg8::gemm_phase<pg8::EpiResid<false>, pg8::StaticOrder, true, true>(F.lds + RING_OFF, g, S, E); }
#endif
    SEAM(8);
    if (IN(9)) { pg8::Gemm g{XB, (const bf16*)(ws + WS_W_ODIN), M, 3072, D}; pg8::StaticOrder S; S.init(M, 3072, G, bx);
        pg8::EpiIn<1> E{P, SSQ}; pg8::gemm_phase<pg8::EpiIn<1>, pg8::StaticOrder, true, true>(F.lds + RING_OFF, g, S, E); }
    SEAM(9);
    if (IN(10)) diff_phase(F);
    SEAM(10);
    if (IN(11)) odd_glue_phase(F);
    SEAM(11);
    if (IN(12)) { pg8::Gemm g{AG, (const bf16*)(ws + WS_W_ODOUT), M, D, D}; pg8::StaticOrder S; S.init(M, D, G, bx);
        pg8::EpiResid<false> E{XB, SSQ, nullptr, 1.0f}; pg8::gemm_phase<pg8::EpiResid<false>, pg8::StaticOrder, true, true>(F.lds + RING_OFF, g, S, E); }
    SEAM(12);
    if (IN(13)) { pg8::Gemm g{XB, (const bf16*)(ws + WS_W_XQ) + (size_t)XW * D, M, XW, D}; pg8::StaticOrder S; S.init(M, XW, G, bx);
        pg8::EpiPlain<true> E{QX, XW, SSQ}; pg8::gemm_phase<pg8::EpiPlain<true>, pg8::StaticOrder, true, true>(F.lds + RING_OFF, g, S, E); }
    if (IN(13)) m13_slot(F, (64 + 256) * M13_Q, 128);
    SEAM(13);
    if (IN(14)) xattn_phase(F, 1);
    SEAM(14);
    if (IN(15)) { pg8::Gemm g{OX, (const bf16*)(ws + WS_W_XO) + (size_t)D * XW, M, D, XW}; pg8::StaticOrder S; S.init(M, D, G, bx);
        pg8::EpiResid<false> E{XB, SSQ, nullptr, 1.0f}; pg8::gemm_phase<pg8::EpiResid<false>, pg8::StaticOrder, true, true>(F.lds + RING_OFF, g, S, E); }
    SEAM(15);
    if (IN(16)) router_phase(F);
    SEAM(16);
    if (IN(18)) { const int T = __builtin_amdgcn_readfirstlane((int)F.ctl[CW_NT]); LAS int* texp = (LAS int*)(F.lds + TEXP_LDS);
        if (F.tid < 160) texp[F.tid] = (F.tid < T) ? (int)F.ctl[CW_TEXP + F.tid] : 0;
        __syncthreads();
        pg8::Gemm g{(const bf16*)(ws + WS_HG), (const bf16*)(ws + WS_W_M13), PAIR_ROWS, NE * 2 * FE, D}; pg8::MoeOrder S; S.init(T, texp, 28, G, bx);
        pg8::EpiSwigluF8<28, false> E{ws + WS_ACT, FE, 1.0f / 64.0f, nullptr}; pg8::gemm_phase<pg8::EpiSwigluF8<28, false>, pg8::MoeOrder, true, true, true>(F.lds + RING_OFF, g, S, E); }
    SEAM(18);
    if (IN(19)) { const int T = __builtin_amdgcn_readfirstlane((int)F.ctl[CW_NT]); LAS int* texp = (LAS int*)(F.lds + TEXP_LDS);
        if (F.tid < 160) texp[F.tid] = (F.tid < T) ? (int)F.ctl[CW_TEXP + F.tid] : 0;
        __syncthreads();
        pg8::Gemm g{(const bf16*)(ws + WS_ACT), (const bf16*)(ws + WS_W_M2), PAIR_ROWS, NE * D, FE}; pg8::MoeSplitOrder S; S.init(T, texp, G, bx, FE / 128);
        pg8::EpiY E{(bf16*)(ws + WS_Y), (const float*)(ws + WS_GATE), 1.0f / 128.0f, (bf16*)(ws + WS_OD)}; pg8::gemm_phase<pg8::EpiY, pg8::MoeSplitOrder, true, true, true>(F.lds + RING_OFF, g, S, E); }
    SEAM(19);
    if (IN(20)) final_phase(F);
#undef IN
#undef SEAM
#undef GRID_BAR
}

extern "C" void kernel_launch(void* const* d_in, const int* in_sizes, int n_in, void* d_out, int out_size, void* d_ws, size_t ws_size, hipStream_t stream) {
    static int grid = 0;
    if (grid == 0) {
        if (n_in != 31 || in_sizes[0] != M * D || out_size != M * D || ws_size < WS_END) { fprintf(stderr, "kernel_launch: built for 31 inputs, x/out of %d floats, >= %zu bytes of workspace; got n_in %d, in0 %d, out %d, ws %zu; nothing launched\n", M * D, (size_t)WS_END, n_in, n_in > 0 ? in_sizes[0] : -1, out_size, ws_size); grid = -1; return; }
        int dev = 0, cus = 0, per_cu = 0;
        if (hipGetDevice(&dev) != hipSuccess || hipDeviceGetAttribute(&cus, hipDeviceAttributeMultiprocessorCount, dev) != hipSuccess) { fprintf(stderr, "kernel_launch: hipGetDevice / hipDeviceGetAttribute failed\n"); grid = -1; return; }
        if (hipFuncSetAttribute((const void*)hyb_fwd, hipFuncAttributeMaxDynamicSharedMemorySize, LDS_BYTES) != hipSuccess) { fprintf(stderr, "kernel_launch: hipFuncSetAttribute failed\n"); grid = -1; return; }
        if (hipOccupancyMaxActiveBlocksPerMultiprocessor(&per_cu, (const void*)hyb_fwd, NWAVES * 64, LDS_BYTES) != hipSuccess || per_cu < 1)
            fprintf(stderr, "kernel_launch: note: occupancy query reports %d workgroups per CU\n", per_cu);
        (void)hipGetLastError();
        grid = cus;
    }
    if (grid < 0) return;
    if (hipMemsetAsync((char*)d_ws + WS_CTL, 0, CTL_ZERO_BYTES, stream) != hipSuccess) { fprintf(stderr, "kernel_launch: hipMemsetAsync failed\n"); return; }
    Args a{};
    for (int i = 0; i < 31; ++i) a.in[i] = (const float*)d_in[i];
    a.out = (float*)d_out; a.ws = (unsigned char*)d_ws;
#if MK_PER_PHASE
    for (int p = 0; p < N_PHASES; ++p) { a.ph_lo = p; a.ph_hi = p + 1; hipLaunchKernelGGL(hyb_fwd, dim3(grid), dim3(NWAVES * 64), LDS_BYTES, stream, a); }
#else
    a.ph_lo = 0; a.ph_hi = N_PHASES;
    hipLaunchKernelGGL(hyb_fwd, dim3(grid), dim3(NWAVES * 64), LDS_BYTES, stream, a);
#endif
    const hipError_t le = hipPeekAtLastError();
    if (le != hipSuccess) fprintf(stderr, "kernel_launch: launch failed: %s (grid %d)\n", hipGetErrorName(le), grid);
}
```

```cpp
#include <hip/hip_runtime.h>
#include <cstdio>
#include <cstdint>
namespace pg8 {
#define PG8_LAS __attribute__((address_space(3)))
typedef unsigned short bf16_t;
typedef short bf16x8 __attribute__((ext_vector_type(8)));
typedef float f32x4 __attribute__((ext_vector_type(4)));
typedef unsigned u32x4 __attribute__((ext_vector_type(4)));
constexpr int BM = 256, BK = 64, HALF = 128, HTB = HALF * BK * 2  , STAGE_BYTES = 8 * HTB, NXCD = 8, WGM = 8;

__host__ __device__ __forceinline__ int lds_byte(int r, int c) { const int st = (r >> 4) * 2 + (c >> 5), rr = r & 15, cc = c & 31, ob = rr * 64 + cc * 2; return st * 1024 + (ob ^ (((ob >> 9) & 1) << 5)); }
__host__ __device__ __forceinline__ void stage_rc(int b, int& R, int& C) { const int st = b / 1024, sb = b % 1024, swz = sb ^ (((sb >> 9) & 1) << 5); R = (st >> 1) * 16 + swz / 64; C = (st & 1) * 32 + (swz % 64) / 2; }
__host__ __device__ __forceinline__ int perm32(int rho) { const int n = rho >> 4, i = rho & 15; return 8 * (i >> 2) + 4 * n + (i & 3); }

struct Unit { int pm, pn; int kofs = 0, nt = 0; };
struct Gemm { const bf16_t* A; const bf16_t* Bt; int M, N, K; };

struct StaticOrder {
    static constexpr bool VARK = false;
    int nM, nN, nwg, G, c;
    __host__ __device__ void init(int M, int N, int G_, int c_) { nM = M / BM; nN = N / BM; nwg = nM * nN; G = G_; c = c_; }
    __host__ __device__ bool next(int i, Unit& u) const {
        const long L = (long)i * G + c; if (L >= nwg) return false;
        int wgid = (int)L; { const int q = nwg / NXCD, r = nwg % NXCD, xcd = wgid % NXCD, off = wgid / NXCD; wgid = (xcd < r ? xcd * (q + 1) : r * (q + 1) + (xcd - r) * q) + off; }
        const int nig = WGM * nN, gid = wgid / nig, fm = gid * WGM, gsz = (nM - fm) < WGM ? (nM - fm) : WGM;
        u.pm = fm + ((wgid % nig) % gsz); u.pn = (wgid % nig) / gsz; return true;
    }
    __device__ __forceinline__ void a_ready(const Unit&) const {}
    __device__ __forceinline__ void done(const Unit&) const {}
};


__device__ __forceinline__ unsigned cvt_pk_bf16(float lo, float hi) { unsigned r; asm volatile("v_cvt_pk_bf16_f32 %0, %1, %2" : "=v"(r) : "v"(lo), "v"(hi)); return r; }
typedef float f32x2 __attribute__((ext_vector_type(2)));

__device__ __forceinline__ float gelu_tanh(float x) {
    const float z = x * (0.7978845608f + 0.0356774081f * x * x);
    return x * __builtin_amdgcn_rcpf(1.0f + __builtin_amdgcn_exp2f(-2.8853900818f * z));
}
__device__ __forceinline__ float silu_f(float x) { return x * __builtin_amdgcn_rcpf(1.0f + __builtin_amdgcn_exp2f(-1.4426950409f * x)); }
__device__ __forceinline__ u32x4 pack8(const f32x4 v0, const f32x4 v1) { u32x4 w; w.x = cvt_pk_bf16(v0[0], v0[1]); w.y = cvt_pk_bf16(v0[2], v0[3]); w.z = cvt_pk_bf16(v1[0], v1[1]); w.w = cvt_pk_bf16(v1[2], v1[3]); return w; }
__device__ __forceinline__ float rs_row(const float* ssq16, int row) {
    const f32x4* p = (const f32x4*)(ssq16 + (size_t)row * 16);
    const f32x4 a = p[0], b = p[1], c = p[2], d = p[3];
    const float s = (((a[0] + a[1]) + (a[2] + a[3])) + ((b[0] + b[1]) + (b[2] + b[3]))) + (((c[0] + c[1]) + (c[2] + c[3])) + ((d[0] + d[1]) + (d[2] + d[3])));
    return __builtin_amdgcn_rsqf(s * (1.0f / 1024.0f) + 1e-6f);
}
struct RsPre { f32x4 a, b; };
__device__ __forceinline__ void rs_issue(RsPre& r, const float* ssq16, int pm, int tid) { const f32x4* p = (const f32x4*)(ssq16 + (size_t)(pm * BM + (tid >> 1)) * 16 + (tid & 1) * 8); r.a = p[0]; r.b = p[1]; }
__device__ __forceinline__ void rs_finish(const RsPre& r, PG8_LAS float* tab, int tid) {
    float s = ((r.a[0] + r.a[1]) + (r.a[2] + r.a[3])) + ((r.b[0] + r.b[1]) + (r.b[2] + r.b[3]));
    s += __shfl_xor(s, 1);
    if (!(tid & 1)) tab[tid >> 1] = __builtin_amdgcn_rsqf(s * (1.0f / 1024.0f) + 1e-6f);
}
template <int ODD> struct EpiIn {
    static constexpr bool PERM = true, AFTER_DRAIN = false, RS = true;
    bf16_t* O; const float* ssq16;
    __device__ __forceinline__ void operator()(const f32x4 (&acc)[2][2][4][2], const Unit& u, int wr, int wc, int fr, int fq, const PG8_LAS float* rst) const {
        const int row0 = u.pm * BM + wr * 64 + fr, cw = wc * 32 + 8 * fq;
        int kind, colbase;
        if (!ODD) { kind = (u.pn >= 6) ? 1 : 0; colbase = u.pn * 256; }
        else { if (u.pn < 2) { kind = 0; colbase = u.pn * 256; } else if (u.pn < 6) { kind = 2; colbase = 512 + (u.pn - 2) * 128; } else { kind = 0; colbase = 1024 + (u.pn - 6) * 256; } }
#pragma unroll
        for (int ai = 0; ai < 2; ++ai)
#pragma unroll
            for (int m = 0; m < 4; ++m) {
                const int row = row0 + ai * HALF + m * 16; const float rs = rst[ai * HALF + wr * 64 + m * 16 + fr]; bf16_t* rowp = O + (size_t)row * 2560 + colbase + cw;
                if (kind == 2) { const f32x4 v0 = (acc[ai][0][m][0] * rs) * (acc[ai][1][m][0] * rs), v1 = (acc[ai][0][m][1] * rs) * (acc[ai][1][m][1] * rs); *(u32x4*)rowp = pack8(v0, v1); }
                else {
#pragma unroll
                    for (int bj = 0; bj < 2; ++bj) { f32x4 v0 = acc[ai][bj][m][0] * rs, v1 = acc[ai][bj][m][1] * rs;
                        if (kind == 1) {
#pragma unroll
                            for (int j = 0; j < 4; ++j) { v0[j] = gelu_tanh(v0[j]); v1[j] = gelu_tanh(v1[j]); } }
                        *(u32x4*)(rowp + bj * HALF) = pack8(v0, v1); } }
            }
    }
};
template <bool RS_> struct EpiPlain {
    static constexpr bool PERM = true, AFTER_DRAIN = false, RS = RS_;
    bf16_t* O; int ldc; const float* ssq16;
    __device__ __forceinline__ void operator()(const f32x4 (&acc)[2][2][4][2], const Unit& u, int wr, int wc, int fr, int fq, const PG8_LAS float* rst = nullptr) const {
        const int row0 = u.pm * BM + wr * 64 + fr, cw = u.pn * BM + wc * 32 + 8 * fq;
#pragma unroll
        for (int ai = 0; ai < 2; ++ai)
#pragma unroll
            for (int m = 0; m < 4; ++m) {
                const int row = row0 + ai * HALF + m * 16; float rs = 1.0f; if constexpr (RS_) rs = rst[ai * HALF + wr * 64 + m * 16 + fr]; bf16_t* rowp = O + (size_t)row * ldc + cw;
#pragma unroll
                for (int bj = 0; bj < 2; ++bj) *(u32x4*)(rowp + bj * HALF) = pack8(acc[ai][bj][m][0] * rs, acc[ai][bj][m][1] * rs);
            }
    }
};
template <int NPN> struct EpiSwiglu {
    static constexpr bool PERM = true, AFTER_DRAIN = false, RS = true;
    bf16_t* O; int ldc; const float* ssq16;
    __device__ __forceinline__ void operator()(const f32x4 (&acc)[2][2][4][2], const Unit& u, int wr, int wc, int fr, int fq, const PG8_LAS float* rst) const {
        const int row0 = u.pm * BM + wr * 64 + fr, cw = (u.pn % NPN) * HALF + wc * 32 + 8 * fq;
#pragma unroll
        for (int ai = 0; ai < 2; ++ai)
#pragma unroll
            for (int m = 0; m < 4; ++m) {
                const int row = row0 + ai * HALF + m * 16; const float rs = rst[ai * HALF + wr * 64 + m * 16 + fr];
                f32x4 v0, v1;
#pragma unroll
                for (int j = 0; j < 4; ++j) { v0[j] = silu_f(acc[ai][0][m][0][j] * rs) * (acc[ai][1][m][0][j] * rs); v1[j] = silu_f(acc[ai][0][m][1][j] * rs) * (acc[ai][1][m][1][j] * rs); }
                *(u32x4*)(O + (size_t)row * ldc + cw) = pack8(v0, v1);
            }
    }
};
template <int NPN, bool RS_> struct EpiSwigluF8 {
    static constexpr bool PERM = true, AFTER_DRAIN = false, RS = RS_;
    unsigned char* O; int ldc; float sc; const float* ssq16;
    __device__ __forceinline__ void operator()(const f32x4 (&acc)[2][2][4][2], const Unit& u, int wr, int wc, int fr, int fq, const PG8_LAS float* rst = nullptr) const {
        const int row0 = u.pm * BM + wr * 64 + fr, cw = (u.pn % NPN) * HALF + wc * 32 + 8 * fq;
#pragma unroll
        for (int ai = 0; ai < 2; ++ai)
#pragma unroll
            for (int m = 0; m < 4; ++m) {
                const int row = row0 + ai * HALF + m * 16; float s_ = sc; if constexpr (RS_) s_ *= rst[ai * HALF + wr * 64 + m * 16 + fr];
                float v[8];
                const float c1_ = -1.4426950409f * s_, is2_ = __builtin_amdgcn_rcpf(s_ * s_);
#pragma unroll
                for (int j = 0; j < 4; ++j) { const float g0 = acc[ai][0][m][0][j], g1 = acc[ai][0][m][1][j];
                    v[j] = (g0 * acc[ai][1][m][0][j]) * __builtin_amdgcn_rcpf(__builtin_fmaf(__builtin_amdgcn_exp2f(g0 * c1_), is2_, is2_));
                    v[4 + j] = (g1 * acc[ai][1][m][1][j]) * __builtin_amdgcn_rcpf(__builtin_fmaf(__builtin_amdgcn_exp2f(g1 * c1_), is2_, is2_)); }
                int w0 = __builtin_amdgcn_cvt_pk_fp8_f32(v[0], v[1], 0, false); w0 = __builtin_amdgcn_cvt_pk_fp8_f32(v[2], v[3], w0, true);
                int w1 = __builtin_amdgcn_cvt_pk_fp8_f32(v[4], v[5], 0, false); w1 = __builtin_amdgcn_cvt_pk_fp8_f32(v[6], v[7], w1, true);
                typedef int i32x2_t __attribute__((ext_vector_type(2)));
                *(i32x2_t*)(O + (size_t)row * ldc + cw) = (i32x2_t){w0, w1};
            }
    }
};
template <bool X8> struct EpiResid {
    static constexpr bool PERM = true, AFTER_DRAIN = false, RS = false;
    bf16_t* xb; float* ssq16; unsigned char* x8; float sc;
    __device__ __forceinline__ void operator()(const f32x4 (&acc)[2][2][4][2], const Unit& u, int wr, int wc, int fr, int fq) const {
        const int row0 = u.pm * BM + wr * 64 + fr, cw = u.pn * BM + wc * 32 + 8 * fq;
#pragma unroll
        for (int ai = 0; ai < 2; ++ai)
#pragma unroll
            for (int m = 0; m < 4; ++m) {
                const int row = row0 + ai * HALF + m * 16; const size_t off = (size_t)row * 1024 + cw; float s = 0.f;
#pragma unroll
                for (int bj = 0; bj < 2; ++bj) {
                    const u32x4 xo = *(const u32x4*)(xb + off + bj * HALF);
                    const f32x4 b0 = {__builtin_bit_cast(float, xo.x << 16), __builtin_bit_cast(float, xo.x & 0xffff0000u), __builtin_bit_cast(float, xo.y << 16), __builtin_bit_cast(float, xo.y & 0xffff0000u)};
                    const f32x4 b1 = {__builtin_bit_cast(float, xo.z << 16), __builtin_bit_cast(float, xo.z & 0xffff0000u), __builtin_bit_cast(float, xo.w << 16), __builtin_bit_cast(float, xo.w & 0xffff0000u)};
                    const f32x4 v0 = acc[ai][bj][m][0] * sc + b0, v1 = acc[ai][bj][m][1] * sc + b1;
                    *(u32x4*)(xb + off + bj * HALF) = pack8(v0, v1);
                    if constexpr (X8) { int w0 = __builtin_amdgcn_cvt_pk_fp8_f32(v0[0], v0[1], 0, false); w0 = __builtin_amdgcn_cvt_pk_fp8_f32(v0[2], v0[3], w0, true);
                        int w1 = __builtin_amdgcn_cvt_pk_fp8_f32(v1[0], v1[1], 0, false); w1 = __builtin_amdgcn_cvt_pk_fp8_f32(v1[2], v1[3], w1, true);
                        typedef int i32x2_t __attribute__((ext_vector_type(2))); *(i32x2_t*)(x8 + off + bj * HALF) = (i32x2_t){w0, w1}; }
                    s += ((v0[0] * v0[0] + v0[1] * v0[1]) + (v0[2] * v0[2] + v0[3] * v0[3])) + ((v1[0] * v1[0] + v1[1] * v1[1]) + (v1[2] * v1[2] + v1[3] * v1[3]));
                }
                s += __shfl_xor(s, 16); s += __shfl_xor(s, 32);
                if (fq == 0) ssq16[(size_t)row * 16 + u.pn * 4 + wc] = s;
            }
    }
};
struct EpiY {
    static constexpr bool PERM = true, AFTER_DRAIN = false, RS = false;
    bf16_t* Y; const float* gate; float sc; bf16_t* YP;
    __device__ __forceinline__ void operator()(const f32x4 (&acc)[2][2][4][2], const Unit& u, int wr, int wc, int fr, int fq) const {
        const int row0 = u.pm * BM + wr * 64 + fr, cw = (u.pn & 3) * BM + wc * 32 + 8 * fq;
        bf16_t* base = Y; size_t rofs = 0;
        if (u.pm >= 128) { base = YP + (size_t)(u.kofs >> 9) * (2048 * 1024); rofs = (size_t)128 * BM; }
#pragma unroll
        for (int ai = 0; ai < 2; ++ai)
#pragma unroll
            for (int m = 0; m < 4; ++m) {
                const int row = row0 + ai * HALF + m * 16; const float g = gate[row] * sc; bf16_t* rowp = base + ((size_t)row - rofs) * 1024 + cw;
#pragma unroll
                for (int bj = 0; bj < 2; ++bj) *(u32x4*)(rowp + bj * HALF) = pack8(acc[ai][bj][m][0] * g, acc[ai][bj][m][1] * g);
            }
    }
};
struct MoeOrder {
    static constexpr bool VARK = false;
    StaticOrder so; int NPN; const PG8_LAS int* texp;
    __device__ __forceinline__ void init(int T, const PG8_LAS int* texp_, int NPN_, int G, int c) { NPN = NPN_; texp = texp_; so.nM = T; so.nN = NPN_; so.nwg = T * NPN_; so.G = G; so.c = c; }
    __device__ __forceinline__ bool next(int i, Unit& u) const {
        if (!so.next(i, u)) return false;
        u.pn += __builtin_amdgcn_readfirstlane(texp[u.pm]) * NPN; return true;
    }
    __device__ __forceinline__ void a_ready(const Unit&) const {}
    __device__ __forceinline__ void done(const Unit&) const {}
};
struct MoeSplitOrder {
    static constexpr bool VARK = true;
    StaticOrder so; int T, G, c, ntf; const PG8_LAS int* texp;
    __device__ __forceinline__ void init(int T_, const PG8_LAS int* texp_, int G_, int c_, int ntf_) { T = T_; texp = texp_; G = G_; c = c_; ntf = ntf_; so.nM = 128; so.nN = 4; so.nwg = 512; so.G = G_; so.c = c_; }
    __device__ __forceinline__ bool next(int i, Unit& u) const {
        const int L = i * G + c; int pnl;
        if (L < 512) { so.next(i, u); pnl = u.pn; u.kofs = 0; u.nt = ntf; }
        else { const int Ls = L - 512; if (Ls >= (T - 128) * 28) return false;
            const int su = Ls / 7, sl = Ls - su * 7; u.pm = 128 + (su >> 2); pnl = su & 3; u.kofs = sl * 512; u.nt = 4; }
        u.pn = __builtin_amdgcn_readfirstlane(texp[u.pm]) * 4 + pnl; return true;
    }
    __device__ __forceinline__ void a_ready(const Unit&) const {}
    __device__ __forceinline__ void done(const Unit&) const {}
};
template <class Epi, class Sched, bool ALIGN_EPI = false, bool SP2 = false, bool FP8 = false>
__device__ __forceinline__ void gemm_phase(PG8_LAS unsigned char* lds, const Gemm g, const Sched& S, const Epi& E) {
    const int tid = threadIdx.x, wid = __builtin_amdgcn_readfirstlane(tid >> 6), lane = tid & 63, wr = wid >> 2, wc = wid & 3, fr = lane & 15, fq = lane >> 4;
    const int K = FP8 ? g.K / 2 : g.K  , nt = K / BK;
    typedef int v8i32_t __attribute__((ext_vector_type(8))); typedef short s16x16_t __attribute__((ext_vector_type(16)));
    unsigned voffA[2], voffB[2];
#pragma unroll
    for (int i = 0; i < 2; ++i) { int R, C; stage_rc(tid * 16 + i * 8192, R, C); const int Rb = Epi::PERM ? ((R & ~31) + perm32(R & 31)) : R;
        voffA[i] = (unsigned)(R * K + C) * 2u; voffB[i] = (unsigned)(Rb * K + C) * 2u; }
    const size_t kstep = (size_t)(BK * 2);
    const size_t hstep = (size_t)HALF * K * 2;
    const size_t tstep = 2 * hstep;
    const unsigned ldsw = (unsigned)wid * 1024u;
    const int aoff = lds_byte(wr * 64 + fr, fq * 8), boff = lds_byte(wc * 32 + fr, fq * 8);
#define PG8_SA(b, h) (((b) * 2 + (h)) * HTB)
#define PG8_SB(b, h) ((4 + (b) * 2 + (h)) * HTB)
#define PG8_STAGE(bufoff, gbase, voff) do { _Pragma("unroll") for (int _i = 0; _i < 2; ++_i) \
        __builtin_amdgcn_global_load_lds((const unsigned*)((const char*)(gbase) + (voff)[_i]), (PG8_LAS unsigned*)(lds + (bufoff) + ldsw + _i * 8192), 16, 0, 0); } while (0)
#define PG8_LDA(dst, b, h) do { _Pragma("unroll") for (int m = 0; m < 4; ++m) _Pragma("unroll") for (int k = 0; k < 2; ++k) dst[m][k] = *(const PG8_LAS bf16x8*)(lds + PG8_SA(b, h) + aoff + m * 2048 + k * 1024); } while (0)
#define PG8_LDB(dst, b, h) do { _Pragma("unroll") for (int n = 0; n < 2; ++n) _Pragma("unroll") for (int k = 0; k < 2; ++k) dst[n][k] = *(const PG8_LAS bf16x8*)(lds + PG8_SB(b, h) + boff + n * 2048 + k * 1024); } while (0)
#define PG8_CAT(x, y) __builtin_bit_cast(v8i32_t, __builtin_shufflevector((x), (y), 0, 1, 2, 3, 4, 5, 6, 7, 8, 9, 10, 11, 12, 13, 14, 15))
#define PG8_MMA(ai, bj, At, Bt) do { __builtin_amdgcn_s_setprio(1); _Pragma("unroll") for (int m = 0; m < 4; ++m) _Pragma("unroll") for (int n = 0; n < 2; ++n) { \
        if constexpr (FP8) { const v8i32_t b8_ = PG8_CAT(Bt[n][0], Bt[n][1]), a8_ = PG8_CAT(At[m][0], At[m][1]); asm volatile("v_mfma_f32_16x16x128_f8f6f4 %0, %1, %2, %0" : "+v"(acc[ai][bj][m][n]) : "v"(b8_), "v"(a8_)); } \
        else { _Pragma("unroll") for (int k = 0; k < 2; ++k) acc[ai][bj][m][n] = __builtin_amdgcn_mfma_f32_16x16x32_bf16(Bt[n][k], At[m][k], acc[ai][bj][m][n], 0, 0, 0); } } \
        __builtin_amdgcn_s_setprio(0); } while (0)
#define PG8_WAIT_V(n) asm volatile("s_waitcnt vmcnt(" #n ")" ::: "memory")
#define PG8_WAIT_L(n) asm volatile("s_waitcnt lgkmcnt(" #n ")" ::: "memory")
#define PG8_BAR __builtin_amdgcn_s_barrier()
#define PG8_SCHED __builtin_amdgcn_sched_barrier(0)
    Unit cur, nxt; int ui = 0;
    if (!S.next(0, cur)) return;
    f32x4 acc[2][2][4][2];
#pragma unroll
    for (int a = 0; a < 2; ++a)
#pragma unroll
        for (int b = 0; b < 2; ++b)
#pragma unroll
            for (int m = 0; m < 4; ++m)
#pragma unroll
                for (int n = 0; n < 2; ++n) acc[a][b][m][n] = (f32x4){0.f, 0.f, 0.f, 0.f};
    bf16x8 At[4][2], B0[2][2], B1[2][2];
    const char* cA = (const char*)g.A + (size_t)cur.pm * tstep + (Sched::VARK ? cur.kofs : 0); const char* cB = (const char*)g.Bt + (size_t)cur.pn * tstep + (Sched::VARK ? cur.kofs : 0);
    S.a_ready(cur);
    PG8_LAS float* const rstab = (PG8_LAS float*)(lds + STAGE_BYTES);
    if constexpr (Epi::RS) { RsPre r0_; rs_issue(r0_, E.ssq16, cur.pm, tid); rs_finish(r0_, rstab, tid); }
    if constexpr (SP2) {
        PG8_STAGE(PG8_SB(0, 0), cB, voffB); PG8_STAGE(PG8_SB(0, 1), cB + hstep, voffB); PG8_STAGE(PG8_SA(0, 0), cA, voffA); PG8_STAGE(PG8_SA(0, 1), cA + hstep, voffA);
        if (wr == 1) PG8_BAR;
        PG8_WAIT_V(2); PG8_BAR;
        PG8_STAGE(PG8_SB(1, 0), cB + kstep, voffB); PG8_STAGE(PG8_SA(1, 0), cA + kstep, voffA); PG8_STAGE(PG8_SB(1, 1), cB + hstep + kstep, voffB);
        PG8_WAIT_V(6); PG8_BAR;
    } else {
        PG8_STAGE(PG8_SB(0, 0), cB, voffB); PG8_STAGE(PG8_SA(0, 0), cA, voffA); PG8_STAGE(PG8_SB(0, 1), cB + hstep, voffB); PG8_STAGE(PG8_SA(0, 1), cA + hstep, voffA);
        if (wr == 1) PG8_BAR;
        PG8_WAIT_V(4); PG8_BAR;
        PG8_STAGE(PG8_SB(1, 0), cB + kstep, voffB); PG8_STAGE(PG8_SA(1, 0), cA + kstep, voffA); PG8_STAGE(PG8_SB(1, 1), cB + hstep + kstep, voffB);
        PG8_WAIT_V(6); PG8_BAR;
    }
    for (;;) {
        const bool has_next = S.next(ui + 1, nxt);
        const char* nA = has_next ? (const char*)g.A + (size_t)nxt.pm * tstep + (Sched::VARK ? nxt.kofs : 0) : cA; const char* nB = has_next ? (const char*)g.Bt + (size_t)nxt.pn * tstep + (Sched::VARK ? nxt.kofs : 0) : cB;
        const int ntu = Sched::VARK ? cur.nt : nt;
#pragma nounroll
        for (int t = 0; t < ntu; t += 2) {
            const bool last = (t == ntu - 2);
            const char* a1 = cA + (size_t)(t + 1) * kstep;
            const char* a2 = last ? nA : cA + (size_t)(t + 2) * kstep; const char* b2 = last ? nB : cB + (size_t)(t + 2) * kstep;
            const char* a3 = a2 + kstep; const char* b3 = b2 + kstep;
            if (last && has_next) S.a_ready(nxt);
            if constexpr (SP2) {
            PG8_LDB(B0, 0, 0); PG8_LDB(B1, 0, 1); PG8_SCHED; PG8_LDA(At, 0, 0); PG8_STAGE(PG8_SA(1, 1), a1 + hstep, voffA);
            PG8_WAIT_V(8); PG8_WAIT_L(0); PG8_BAR; PG8_MMA(0, 0, At, B0); PG8_MMA(0, 1, At, B1); PG8_BAR; PG8_SCHED;
            PG8_LDA(At, 0, 1); PG8_STAGE(PG8_SB(0, 0), b2, voffB); PG8_STAGE(PG8_SB(0, 1), b2 + hstep, voffB); PG8_STAGE(PG8_SA(0, 0), a2, voffA);
            PG8_WAIT_V(8); PG8_WAIT_L(0); PG8_BAR; PG8_MMA(1, 0, At, B0); PG8_MMA(1, 1, At, B1); PG8_BAR; PG8_SCHED;
            PG8_LDB(B0, 1, 0); PG8_LDB(B1, 1, 1); PG8_SCHED; PG8_LDA(At, 1, 0); PG8_STAGE(PG8_SA(0, 1), a2 + hstep, voffA);
            PG8_WAIT_V(8); PG8_WAIT_L(0); PG8_BAR; PG8_MMA(0, 0, At, B0); PG8_MMA(0, 1, At, B1); PG8_BAR; PG8_SCHED;
            PG8_LDA(At, 1, 1); PG8_STAGE(PG8_SB(1, 0), b3, voffB); PG8_STAGE(PG8_SB(1, 1), b3 + hstep, voffB); PG8_STAGE(PG8_SA(1, 0), a3, voffA);
            PG8_WAIT_V(8); PG8_WAIT_L(0); PG8_BAR; PG8_MMA(1, 0, At, B0); PG8_MMA(1, 1, At, B1); PG8_BAR; PG8_SCHED;
            } else {
            PG8_LDB(B0, 0, 0); PG8_SCHED; PG8_LDA(At, 0, 0); PG8_STAGE(PG8_SA(1, 1), a1 + hstep, voffA);
            PG8_WAIT_L(8); PG8_BAR; PG8_WAIT_L(0); PG8_MMA(0, 0, At, B0); PG8_BAR; PG8_SCHED;
            PG8_LDB(B1, 0, 1); PG8_STAGE(PG8_SB(0, 0), b2, voffB);
            PG8_BAR; PG8_WAIT_L(0); PG8_MMA(0, 1, At, B1); PG8_BAR;
            PG8_LDA(At, 0, 1); PG8_STAGE(PG8_SA(0, 0), a2, voffA);
            PG8_BAR; PG8_WAIT_L(0); PG8_MMA(1, 0, At, B0); PG8_BAR; PG8_SCHED;
            PG8_STAGE(PG8_SB(0, 1), b2 + hstep, voffB);
            PG8_WAIT_V(6); PG8_BAR; PG8_MMA(1, 1, At, B1); PG8_BAR;
            PG8_LDB(B0, 1, 0); PG8_SCHED; PG8_LDA(At, 1, 0); PG8_STAGE(PG8_SA(0, 1), a2 + hstep, voffA);
            PG8_WAIT_L(8); PG8_BAR; PG8_WAIT_L(0); PG8_MMA(0, 0, At, B0); PG8_BAR; PG8_SCHED;
            PG8_LDB(B1, 1, 1); PG8_STAGE(PG8_SB(1, 0), b3, voffB);
            PG8_BAR; PG8_WAIT_L(0); PG8_MMA(0, 1, At, B1); PG8_BAR;
            PG8_LDA(At, 1, 1); PG8_STAGE(PG8_SA(1, 0), a3, voffA);
            PG8_BAR; PG8_WAIT_L(0); PG8_MMA(1, 0, At, B0); PG8_BAR; PG8_SCHED;
            PG8_STAGE(PG8_SB(1, 1), b3 + hstep, voffB);
            PG8_WAIT_V(6); PG8_BAR; PG8_MMA(1, 1, At, B1); PG8_BAR;
            }
        }
        if constexpr (FP8) asm volatile("s_nop 15\n\ts_nop 15" ::: "memory");
        if constexpr (ALIGN_EPI) { if (wr == 0) PG8_BAR; }
        if constexpr (!Epi::AFTER_DRAIN) {
            if constexpr (Epi::RS) { RsPre rn_; if (has_next) rs_issue(rn_, E.ssq16, nxt.pm, tid);
                E(acc, cur, wr, wc, fr, fq, rstab + (ui & 1) * 256);
                if (has_next) rs_finish(rn_, rstab + ((ui + 1) & 1) * 256, tid); }
            else E(acc, cur, wr, wc, fr, fq);
            S.done(cur); }
        if (!has_next) break;
#pragma unroll
        for (int a = 0; a < 2; ++a)
#pragma unroll
            for (int b = 0; b < 2; ++b)
#pragma unroll
                for (int m = 0; m < 4; ++m)
#pragma unroll
                    for (int n = 0; n < 2; ++n) acc[a][b][m][n] = (f32x4){0.f, 0.f, 0.f, 0.f};
        cur = nxt; cA = nA; cB = nB; ++ui;
        if constexpr (ALIGN_EPI) { if (wr == 1) PG8_BAR; }
    }
    PG8_WAIT_V(0);
    if constexpr (!ALIGN_EPI) { if (wr == 0) PG8_BAR; }
    PG8_BAR;
    if constexpr (Epi::AFTER_DRAIN) { E.fused(acc, cur, wr, wc, fr, fq, lds, wid, lane); S.done(cur); }
#undef PG8_SA
#undef PG8_SB
#undef PG8_STAGE
#undef PG8_LDA
#undef PG8_LDB
#undef PG8_MMA
#undef PG8_CAT
#undef PG8_WAIT_V
#undef PG8_WAIT_L
#undef PG8_BAR
#undef PG8_SCHED
}
}

namespace att {
typedef unsigned short bf16;
using bf16x8 = __attribute__((ext_vector_type(8))) short;
using s16x4  = __attribute__((ext_vector_type(4))) short;
using f32x16 = __attribute__((ext_vector_type(16))) float;
using f32x4  = __attribute__((ext_vector_type(4))) float;
using u32x4  = __attribute__((ext_vector_type(4))) unsigned;
#define ASBAR() __builtin_amdgcn_sched_barrier(0)
#define LDS3 __attribute__((address_space(3)))
constexpr float THR2 = 40.0f;
__device__ __forceinline__ int crow(int r, int hi) { return (r & 3) + 8 * (r >> 2) + 4 * hi; }
__device__ __forceinline__ unsigned cvtpk(float lo, float hi) { unsigned r; asm volatile("v_cvt_pk_bf16_f32 %0, %1, %2" : "=v"(r) : "v"(lo), "v"(hi)); return r; }
__device__ __forceinline__ unsigned short f2bf(float f) { unsigned u = __builtin_bit_cast(unsigned, f); return (unsigned short)((u + 0x7fffu + ((u >> 16) & 1u)) >> 16); }
template <int DQK> __device__ __forceinline__ int kswz(int row, int colB) { return row * (DQK * 2) + (colB ^ ((row & 7) << 4)); }
template <int DQK, int DV> struct Geo {
    static constexpr int SHM_K = 64 * DQK * 2, SHM_V = 64 * DV * 2, NCB = DV / 32;
    static constexpr int WS_OFF = 2 * SHM_V + 2 * SHM_K, TAB_OFF = WS_OFF + 2048, BYTES = TAB_OFF + 8192;
};
__device__ __forceinline__ void partialSM_abs(f32x16& p0, f32x16& p1, float& m_reg, float& alpha, float cadd) {
    float pmax = p0[0];
#pragma unroll
    for (int r = 1; r < 16; ++r) pmax = fmaxf(pmax, p0[r]);
#pragma unroll
    for (int r = 0; r < 16; ++r) pmax = fmaxf(pmax, p1[r]);
    { auto rr = __builtin_amdgcn_permlane32_swap(__float_as_uint(pmax), __float_as_uint(pmax), false, false); pmax = fmaxf(__uint_as_float(rr[0]), __uint_as_float(rr[1])); }
    pmax += cadd;
    float mn;
    if (__builtin_expect(__all(pmax - m_reg <= THR2), 1)) { mn = m_reg; alpha = 1.f; }
    else { mn = fmaxf(m_reg, pmax); alpha = __builtin_amdgcn_exp2f(m_reg - mn); m_reg = mn; }
    const float sh = cadd - mn;
#pragma unroll
    for (int r = 0; r < 16; ++r) { p0[r] += sh; p1[r] += sh; }
#pragma unroll
    for (int r = 0; r < 16; ++r) p0[r] = __builtin_amdgcn_exp2f(p0[r]);
}
template <bool FIRST> __device__ __forceinline__ void partialSM_rel(f32x16& p0, f32x16& p1, float& m_reg, float& alpha, f32x16& cini, float cq) {
    float pmax = p0[0];
#pragma unroll
    for (int r = 1; r < 16; ++r) pmax = fmaxf(pmax, p0[r]);
#pragma unroll
    for (int r = 0; r < 16; ++r) pmax = fmaxf(pmax, p1[r]);
    { auto rr = __builtin_amdgcn_permlane32_swap(__float_as_uint(pmax), __float_as_uint(pmax), false, false); pmax = fmaxf(__uint_as_float(rr[0]), __uint_as_float(rr[1])); }
    alpha = 1.f;
    if (FIRST || !__builtin_expect(__all(pmax <= THR2), 1)) {
        const float dl = FIRST ? pmax : fmaxf(pmax, 0.f);
        if (!FIRST) alpha = __builtin_amdgcn_exp2f(-dl);
        m_reg += dl;
#pragma unroll
        for (int r = 0; r < 16; ++r) { p0[r] -= dl; p1[r] -= dl; cini[r] = cq - m_reg; }
    }
#pragma unroll
    for (int r = 0; r < 16; ++r) p0[r] = __builtin_amdgcn_exp2f(p0[r]);
}
__device__ __forceinline__ void finishSM(f32x16& p0, f32x16& p1, float alpha, float& l_reg, bf16x8& pa0, bf16x8& pa1, bf16x8& pa2, bf16x8& pa3) {
#pragma unroll
    for (int r = 0; r < 16; ++r) p1[r] = __builtin_amdgcn_exp2f(p1[r]);
    float ps = 0;
#pragma unroll
    for (int r = 0; r < 16; ++r) ps += p0[r];
#pragma unroll
    for (int r = 0; r < 16; ++r) ps += p1[r];
    { auto rr = __builtin_amdgcn_permlane32_swap(__float_as_uint(ps), __float_as_uint(ps), false, false); ps = __uint_as_float(rr[0]) + __uint_as_float(rr[1]); }
    l_reg = l_reg * alpha + ps;
#define ATT_PK4(P, BASE, OUT) do { unsigned a0 = cvtpk(P[BASE + 0], P[BASE + 1]), a1 = cvtpk(P[BASE + 2], P[BASE + 3]);   \
    unsigned b0 = cvtpk(P[BASE + 4], P[BASE + 5]), b1 = cvtpk(P[BASE + 6], P[BASE + 7]);                              \
    auto r0 = __builtin_amdgcn_permlane32_swap(a0, b0, false, false); auto r1 = __builtin_amdgcn_permlane32_swap(a1, b1, false, false); \
    u32x4 w = {r0[0], r1[0], r0[1], r1[1]}; OUT = *reinterpret_cast<bf16x8*>(&w); } while (0)
    ATT_PK4(p0, 0, pa0); ATT_PK4(p0, 8, pa1); ATT_PK4(p1, 0, pa2); ATT_PK4(p1, 8, pa3);
#undef ATT_PK4
}
template <int DQK, bool REL> __device__ __forceinline__ void qkt(f32x16& p0, f32x16& p1, const LDS3 char* Ks, const bf16x8* qr, int r32, int hi, const f32x16& cini, unsigned e0 = 0u, unsigned e1 = 0u) {
    const f32x16 z = f32x16{};
#pragma unroll
    for (int d0 = 0; d0 < DQK / 16; ++d0) { const int cb = (d0 * 16 + hi * 8) * 2;
        const bf16x8 b0 = *(const LDS3 bf16x8*)(Ks + kswz<DQK>(r32, cb));
        const bf16x8 b1 = *(const LDS3 bf16x8*)(Ks + kswz<DQK>(32 + r32, cb));
        p0 = __builtin_amdgcn_mfma_f32_32x32x16_bf16(b0, qr[d0], d0 == 0 ? (REL ? cini : z) : p0, 0, 0, 0);
        p1 = __builtin_amdgcn_mfma_f32_32x32x16_bf16(b1, qr[d0], d0 == 0 ? (REL ? cini : z) : p1, 0, 0, 0); }
    if constexpr (REL) {
        const u32x4 a0 = {hi ? 0u : e0, 0u, 0u, 0u}, a1 = {hi ? 0u : e1, 0u, 0u, 0u}, on = {hi ? 0u : 0x3F803F80u, 0u, 0u, 0u};
        p0 = __builtin_amdgcn_mfma_f32_32x32x16_bf16(__builtin_bit_cast(bf16x8, a0), __builtin_bit_cast(bf16x8, on), p0, 0, 0, 0);
        p1 = __builtin_amdgcn_mfma_f32_32x32x16_bf16(__builtin_bit_cast(bf16x8, a1), __builtin_bit_cast(bf16x8, on), p1, 0, 0, 0);
    }
}
template <int NCB> __device__ __forceinline__ int v_st(int k, int c) { const int kk = (k & ~0xC) | ((k & 4) << 1) | ((k & 8) >> 1); return ((kk >> 3) * NCB + (c >> 5)) * 512 + ((kk & 7) * 32 + (c & 31)) * 2; }
__device__ __forceinline__ int v_rd_base(int lane) { return ((lane & 3) << 3) | (((lane >> 2) & 3) << 6) | (((lane >> 4) & 1) << 5) | (((lane >> 5) & 1) << 8); }
template <int NCB> constexpr int v_rd_off(int d0, int ks, int half) { return d0 * 512 + ks * (2 * NCB * 512) + half * (NCB * 512); }
template <int OFF> __device__ __forceinline__ s16x4 tr_read(int vb) { s16x4 r; asm volatile("ds_read_b64_tr_b16 %0, %1 offset:%2" : "=&v"(r) : "v"(vb), "i"(OFF) : "memory"); return r; }
template <int NCB, int D0, bool SPLIT> __device__ __forceinline__ void pv_one(f32x16& od, int vb, bf16x8 pa0, bf16x8 pa1, bf16x8 pa2, bf16x8 pa3) {
#define ATT_PK(L, H) (bf16x8){L[0], L[1], L[2], L[3], H[0], H[1], H[2], H[3]}
    if constexpr (!SPLIT) {
        const s16x4 l0 = tr_read<v_rd_off<NCB>(D0, 0, 0)>(vb), h0 = tr_read<v_rd_off<NCB>(D0, 0, 1)>(vb), l1 = tr_read<v_rd_off<NCB>(D0, 1, 0)>(vb), h1 = tr_read<v_rd_off<NCB>(D0, 1, 1)>(vb);
        const s16x4 l2 = tr_read<v_rd_off<NCB>(D0, 2, 0)>(vb), h2 = tr_read<v_rd_off<NCB>(D0, 2, 1)>(vb), l3 = tr_read<v_rd_off<NCB>(D0, 3, 0)>(vb), h3 = tr_read<v_rd_off<NCB>(D0, 3, 1)>(vb);
        asm volatile("s_waitcnt lgkmcnt(0)" ::: "memory"); ASBAR();
        od = __builtin_amdgcn_mfma_f32_32x32x16_bf16(pa0, ATT_PK(l0, h0), od, 0, 0, 0);
        od = __builtin_amdgcn_mfma_f32_32x32x16_bf16(pa1, ATT_PK(l1, h1), od, 0, 0, 0);
        od = __builtin_amdgcn_mfma_f32_32x32x16_bf16(pa2, ATT_PK(l2, h2), od, 0, 0, 0);
        od = __builtin_amdgcn_mfma_f32_32x32x16_bf16(pa3, ATT_PK(l3, h3), od, 0, 0, 0);
    } else {
        { const s16x4 l0 = tr_read<v_rd_off<NCB>(D0, 0, 0)>(vb), h0 = tr_read<v_rd_off<NCB>(D0, 0, 1)>(vb), l1 = tr_read<v_rd_off<NCB>(D0, 1, 0)>(vb), h1 = tr_read<v_rd_off<NCB>(D0, 1, 1)>(vb);
          asm volatile("s_waitcnt lgkmcnt(0)" ::: "memory"); ASBAR();
          od = __builtin_amdgcn_mfma_f32_32x32x16_bf16(pa0, ATT_PK(l0, h0), od, 0, 0, 0);
          od = __builtin_amdgcn_mfma_f32_32x32x16_bf16(pa1, ATT_PK(l1, h1), od, 0, 0, 0); ASBAR(); }
        { const s16x4 l2 = tr_read<v_rd_off<NCB>(D0, 2, 0)>(vb), h2 = tr_read<v_rd_off<NCB>(D0, 2, 1)>(vb), l3 = tr_read<v_rd_off<NCB>(D0, 3, 0)>(vb), h3 = tr_read<v_rd_off<NCB>(D0, 3, 1)>(vb);
          asm volatile("s_waitcnt lgkmcnt(0)" ::: "memory"); ASBAR();
          od = __builtin_amdgcn_mfma_f32_32x32x16_bf16(pa2, ATT_PK(l2, h2), od, 0, 0, 0);
          od = __builtin_amdgcn_mfma_f32_32x32x16_bf16(pa3, ATT_PK(l3, h3), od, 0, 0, 0); ASBAR(); }
    }
#undef ATT_PK
}
template <int NCB, bool SPLIT> __device__ __forceinline__ void pv_all(f32x16* o, int vb, bf16x8 pa0, bf16x8 pa1, bf16x8 pa2, bf16x8 pa3) {
    pv_one<NCB, 0, SPLIT>(o[0], vb, pa0, pa1, pa2, pa3); pv_one<NCB, 1, SPLIT>(o[1], vb, pa0, pa1, pa2, pa3);
    if constexpr (NCB == 4) { pv_one<NCB, 2, SPLIT>(o[2], vb, pa0, pa1, pa2, pa3); pv_one<NCB, 3, SPLIT>(o[3], vb, pa0, pa1, pa2, pa3); }
}
template <int MODE> __device__ __forceinline__ bool t5_far(int kt, int q0w) { return MODE == 2 && q0w - (kt * 64 + 63) >= 113; }
template <int MODE> __device__ __forceinline__ void apply_bias(f32x16& p0, f32x16& p1, int kt, const LDS3 float* tab, int qabs, int q0w, int hi) {
    const int k0 = kt * 64;
    if constexpr (MODE == 1) {
        if (k0 + 63 > q0w) {
#pragma unroll
            for (int r = 0; r < 16; ++r) { const int kv = k0 + crow(r, hi); if (kv > qabs) p0[r] = -INFINITY; if (kv + 32 > qabs) p1[r] = -INFINITY; } }
    } else if constexpr (MODE == 2) {
        if (!t5_far<MODE>(kt, q0w)) {
            const int dq = qabs - k0 - 4 * hi;
#pragma unroll
            for (int g4 = 0; g4 < 4; ++g4) {
#pragma unroll
                for (int i = 0; i < 4; ++i) { const int r = 4 * g4 + i, d = dq - 8 * g4 - i, d1 = d - 32;
                    const int dc = d < 0 ? 0 : (d > 127 ? 127 : d), dc1 = d1 < 0 ? 0 : (d1 > 127 ? 127 : d1);
                    const float t0 = tab[dc], t1 = tab[dc1];
                    p0[r] = d < 0 ? -INFINITY : p0[r] + t0; p1[r] = d1 < 0 ? -INFINITY : p1[r] + t1; }
                asm volatile("" ::: "memory");
            } }
    }
}
template <int DQK, int DV, int MODE, int LDQ, int LDK, int LDO>
__device__ __forceinline__ void attn_unit(const bf16* __restrict__ Qb, const bf16* __restrict__ Kh, const bf16* __restrict__ Vh, bf16* __restrict__ Ob, int NT, int q0, LDS3 char* lds) {
    using G = Geo<DQK, DV>;
    constexpr int SHM_K = G::SHM_K, SHM_V = G::SHM_V, NCB = G::NCB, NKC = DQK / 64, NVC = DV / 64, KCPR = DQK / 8, VCPR = DV / 8;
    const int tid = threadIdx.x, wid = __builtin_amdgcn_readfirstlane(tid >> 6), lane = tid & 63, r32 = lane & 31, hi = lane >> 5;
    LDS3 char* V_lds = lds; LDS3 char* K_lds = lds + 2 * SHM_V;
    LDS3 float* ws = (LDS3 float*)(lds + G::WS_OFF) + wid * 64; LDS3 float* li_l = ws; LDS3 float* al_l = ws + 32;
    const LDS3 float* tab = (const LDS3 float*)(lds + G::TAB_OFF); const LDS3 unsigned* etab = (const LDS3 unsigned*)(lds + G::TAB_OFF);
    const int q0w = q0 + wid * 32, qabs = q0w + r32;
    float cq = 0.f; float b31 = 0.f;
    if constexpr (MODE == 1) { const unsigned e = etab[qabs]; cq = -(__builtin_bit_cast(float, e << 16) + __builtin_bit_cast(float, e & 0xffff0000u)); }
    if constexpr (MODE == 2) b31 = tab[127];
    float m_reg = (MODE == 1) ? 0.f : -1e30f, l_reg = 0; f32x16 cini;
#pragma unroll
    for (int r = 0; r < 16; ++r) cini[r] = cq; f32x16 o[NCB]; bf16x8 qr[DQK / 16];
#pragma unroll
    for (int d = 0; d < NCB; ++d) o[d] = f32x16{};
    const bf16* Qw = Qb + (long)(wid * 32 + r32) * LDQ + hi * 8;
#pragma unroll
    for (int d0 = 0; d0 < DQK / 16; ++d0) qr[d0] = *reinterpret_cast<const bf16x8*>(Qw + d0 * 16);
    int kgo[NKC], klo[NKC], vgo[NVC], vlo[NVC];
#pragma unroll
    for (int j = 0; j < NKC; ++j) { const int ci = tid + 512 * j, row = ci / KCPR, col = (ci % KCPR) * 8; kgo[j] = row * LDK + col; klo[j] = kswz<DQK>(row, col * 2); }
#pragma unroll
    for (int j = 0; j < NVC; ++j) { const int ci = tid + 512 * j, row = ci / VCPR, col = (ci % VCPR) * 8; vgo[j] = row * LDK + col; vlo[j] = v_st<NCB>(row, col); }
    const int vb0 = (int)(unsigned)(uintptr_t)V_lds + v_rd_base(lane);
    constexpr int SD = (MODE == 0) ? 2 : 1;
    struct { bf16x8 vs[NVC], ks[NKC]; } sr_[SD];
#define ATT_SLOAD(i, k0) do { _Pragma("unroll") for (int j_ = 0; j_ < NVC; ++j_) sr_[i].vs[j_] = *reinterpret_cast<const bf16x8*>(&Vh[(long)(k0) * LDK + vgo[j_]]); \
    _Pragma("unroll") for (int j_ = 0; j_ < NKC; ++j_) sr_[i].ks[j_] = *reinterpret_cast<const bf16x8*>(&Kh[(long)(k0) * LDK + kgo[j_]]); } while (0)
#define ATT_SWRITE(b, i) do { _Pragma("unroll") for (int j_ = 0; j_ < NVC; ++j_) *(LDS3 bf16x8*)(V_lds + (b) * SHM_V + vlo[j_]) = sr_[i].vs[j_]; \
    _Pragma("unroll") for (int j_ = 0; j_ < NKC; ++j_) *(LDS3 bf16x8*)(K_lds + (b) * SHM_K + klo[j_]) = sr_[i].ks[j_]; } while (0)
#define ATT_SWAIT() asm volatile("s_waitcnt vmcnt(%0)" :: "n"(SD == 2 ? NKC + NVC : 0) : "memory")
#define ATT_RESC(a) do { if (__any((a) < 1.f)) { if (hi == 0) al_l[r32] = (a); asm volatile("s_waitcnt lgkmcnt(0)" ::: "memory"); \
    _Pragma("unroll") for (int d = 0; d < NCB; ++d) _Pragma("unroll") for (int r = 0; r < 16; ++r) o[d][r] *= al_l[crow(r, hi)]; } } while (0)
#define ATT_BAR() asm volatile("s_waitcnt lgkmcnt(0)\n\ts_barrier" ::: "memory")
    f32x16 pA0, pA1, pB0, pB1; float alA, alB; bf16x8 pa0, pa1, pa2, pa3;
#define ATT_QKT(P0, P1, KB, kt) do { if constexpr (MODE == 1) qkt<DQK, true>(P0, P1, KB, qr, r32, hi, cini, etab[(kt) * 64 + r32], etab[(kt) * 64 + 32 + r32]); else qkt<DQK, false>(P0, P1, KB, qr, r32, hi, cini); } while (0)
#define ATT_PSM(FIRST_, P0, P1, AL, kt) do { if constexpr (MODE == 1) partialSM_rel<FIRST_>(P0, P1, m_reg, AL, cini, cq); else partialSM_abs(P0, P1, m_reg, AL, t5_far<MODE>((kt), q0w) ? b31 : 0.f); } while (0)
    constexpr int SE = 0, SO = SD - 1;
    ATT_SLOAD(SE, 0); asm volatile("s_waitcnt vmcnt(0)" ::: "memory"); ATT_SWRITE(0, SE); ATT_BAR();
    ATT_QKT(pA0, pA1, K_lds, 0); apply_bias<MODE>(pA0, pA1, 0, tab, qabs, q0w, hi); ATT_PSM(true, pA0, pA1, alA, 0);
    ATT_SLOAD(SO, 64); if (SD == 2 && 2 < NT) ATT_SLOAD(SE, 128);
    ATT_SWAIT(); ATT_SWRITE(1, SO); ATT_BAR();
    for (int j = 1; j + 1 < NT; j += 2) {
        ASBAR(); ATT_QKT(pB0, pB1, K_lds + SHM_K, j);
        finishSM(pA0, pA1, alA, l_reg, pa0, pa1, pa2, pa3); ASBAR();
        ATT_SLOAD(SO, (j + SD) * 64); ASBAR();
        pv_all<NCB, MODE == 2>(o, vb0, pa0, pa1, pa2, pa3); apply_bias<MODE>(pB0, pB1, j, tab, qabs, q0w, hi); ATT_PSM(false, pB0, pB1, alB, j);
        ATT_BAR(); ATT_SWAIT(); ATT_SWRITE(0, SE);
        ATT_RESC(alB); ATT_BAR();
        ASBAR(); ATT_QKT(pA0, pA1, K_lds, j + 1);
        finishSM(pB0, pB1, alB, l_reg, pa0, pa1, pa2, pa3); ASBAR();
        if (SD == 1 || j + 3 < NT) ATT_SLOAD(SE, (j + 1 + SD) * 64); ASBAR();
        pv_all<NCB, MODE == 2>(o, vb0 + SHM_V, pa0, pa1, pa2, pa3); apply_bias<MODE>(pA0, pA1, j + 1, tab, qabs, q0w, hi); ATT_PSM(false, pA0, pA1, alA, j + 1);
        ATT_BAR(); ATT_SWAIT(); ATT_SWRITE(1, SO);
        ATT_RESC(alA); ATT_BAR();
    }
    ASBAR(); ATT_QKT(pB0, pB1, K_lds + SHM_K, NT - 1);
    finishSM(pA0, pA1, alA, l_reg, pa0, pa1, pa2, pa3); ASBAR();
    pv_all<NCB, MODE == 2>(o, vb0, pa0, pa1, pa2, pa3); apply_bias<MODE>(pB0, pB1, NT - 1, tab, qabs, q0w, hi); ATT_PSM(false, pB0, pB1, alB, NT - 1);
    ATT_BAR(); ATT_RESC(alB);
    finishSM(pB0, pB1, alB, l_reg, pa0, pa1, pa2, pa3); ASBAR();
    pv_all<NCB, MODE == 2>(o, vb0 + SHM_V, pa0, pa1, pa2, pa3);
    if (hi == 0) li_l[r32] = l_reg; asm volatile("s_waitcnt lgkmcnt(0)" ::: "memory");
    float rli[16];
#pragma unroll
    for (int r = 0; r < 16; ++r) rli[r] = __builtin_amdgcn_rcpf(li_l[crow(r, hi)]);
    bf16* Ow = Ob + (long)(wid * 32) * LDO;
#pragma unroll
    for (int r = 0; r < 16; ++r) { const int orow = crow(r, hi);
#pragma unroll
        for (int d0 = 0; d0 < NCB; ++d0) Ow[(long)orow * LDO + d0 * 32 + r32] = f2bf(o[d0][r] * rli[r]); }
    __syncthreads();
#undef ATT_SLOAD
#undef ATT_SWRITE
#undef ATT_SWAIT
#undef ATT_RESC
#undef ATT_QKT
#undef ATT_BAR
#undef ATT_PSM
}
#undef ASBAR
#undef LDS3
}
#ifndef FOX_THR
#define FOX_THR 40
#endif
namespace fx {
using att::bf16; using att::bf16x8; using att::s16x4; using att::f32x16; using att::u32x4; using att::crow;
typedef unsigned u32x2 __attribute__((ext_vector_type(2)));
typedef __attribute__((address_space(3))) const char* lds_cptr;
typedef short v4i16_t __attribute__((ext_vector_type(4)));
#define FXL __attribute__((address_space(3)))
#define SBAR() __builtin_amdgcn_sched_barrier(0)
constexpr int NW = 8, QBLK = 32, QB = QBLK * NW, KVBLK = 64;
constexpr int NSLOT = 3, SLOTB = 8192;
constexpr int LDS_K = 0, LDS_V = NSLOT * SLOTB, LDS_WS = 2 * NSLOT * SLOTB, LDS_OST = LDS_WS + NW * 64 * 4, LDS_TAB = LDS_OST + NW * 4096, LDS_BYTES = LDS_TAB + 8192;
constexpr unsigned ONES = 0x3F803F80u;
__device__ __forceinline__ void cmask(f32x16& p0, f32x16& p1, int jb, int qrel, int hi) {
  const float NEG = -INFINITY; int kb = 64 * jb + 4 * hi;
  #pragma unroll
  for (int r = 0; r < 16; ++r) { int kv = kb + (r & 3) + 8 * (r >> 2); if (kv > qrel) p0[r] = NEG; if (kv + 32 > qrel) p1[r] = NEG; }
}
__device__ __forceinline__ void glds16(const void* sbase, unsigned voff, unsigned lds_dst) { unsigned keep;
  asm volatile("s_mov_b32 %0, m0\n\ts_mov_b32 m0, %2\n\ts_nop 0\n\tglobal_load_lds_dwordx4 %1, %3\n\ts_mov_b32 m0, %0" : "=&s"(keep) : "v"(voff), "s"(lds_dst), "s"(sbase) : "memory"); }
__device__ __forceinline__ float max3f(float a, float b, float c) { float r; asm("v_max3_f32 %0, %1, %2, %3" : "=v"(r) : "v"(a), "v"(b), "v"(c)); return r; }
__device__ __forceinline__ float max2f(float a, float b) { float r; asm("v_max_f32_e32 %0, %1, %2" : "=v"(r) : "v"(a), "v"(b)); return r; }
__device__ __forceinline__ float fsub_s(float a, float b) { float r; asm("v_sub_f32_e32 %0, %1, %2" : "=v"(r) : "v"(a), "v"(b)); return r; }
typedef float f32x2_t __attribute__((ext_vector_type(2))); typedef __bf16 bf16x2_t __attribute__((ext_vector_type(2)));
__device__ __forceinline__ unsigned cvtpk_s(float lo, float hi) { f32x2_t v = {lo, hi}; bf16x2_t b = __builtin_convertvector(v, bf16x2_t); return __builtin_bit_cast(unsigned, b); }
#define WAIT_BAR(N) asm volatile("s_waitcnt vmcnt(" #N ") lgkmcnt(0)\n\ts_barrier" ::: "memory")
#define MFMA8(a, b, c) __builtin_amdgcn_mfma_f32_32x32x8bf16_1k(__builtin_bit_cast(v4i16_t, a), __builtin_bit_cast(v4i16_t, b), c, 0, 0, 0)
__device__ __forceinline__ float quant2(float v, unsigned& pk) { const unsigned h = att::f2bf(v); const float hf = __builtin_bit_cast(float, h << 16); const unsigned l = att::f2bf(v - hf);
  pk = h | (l << 16); return hf + __builtin_bit_cast(float, l << 16); }

__device__ __forceinline__ void qkt(f32x16& p0, f32x16& p1, lds_cptr Kslot, const bf16x8* qr, u32x2 ax0, u32x2 ax1, u32x2 bx, int r32, int hi) {
  const lds_cptr kb = Kslot + hi * 1024 + r32 * 16;
  p0 = MFMA8(ax0, bx, f32x16{}); p1 = MFMA8(ax1, bx, f32x16{});
  #pragma unroll
  for (int d0 = 0; d0 < 4; ++d0) {
    const bf16x8 b0 = *(const FXL bf16x8*)(kb + d0 * 2048);
    const bf16x8 b1 = *(const FXL bf16x8*)(kb + d0 * 2048 + 512);
    p0 = __builtin_amdgcn_mfma_f32_32x32x16_bf16(b0, qr[d0], p0, 0, 0, 0); p1 = __builtin_amdgcn_mfma_f32_32x32x16_bf16(b1, qr[d0], p1, 0, 0, 0); }
}
__device__ __forceinline__ void kload8(bf16x8* kf, lds_cptr kp) {
  kf[0] = *(const FXL bf16x8*)(kp);        kf[1] = *(const FXL bf16x8*)(kp + 512);
  kf[2] = *(const FXL bf16x8*)(kp + 2048); kf[3] = *(const FXL bf16x8*)(kp + 2560);
  kf[4] = *(const FXL bf16x8*)(kp + 4096); kf[5] = *(const FXL bf16x8*)(kp + 4608);
  kf[6] = *(const FXL bf16x8*)(kp + 6144); kf[7] = *(const FXL bf16x8*)(kp + 6656);
}
__device__ __forceinline__ void kload2(bf16x8* kf, lds_cptr kp, int j) { kf[2 * j] = *(const FXL bf16x8*)(kp + j * 2048); kf[2 * j + 1] = *(const FXL bf16x8*)(kp + j * 2048 + 512); }
__device__ __forceinline__ s16x4 vtr(lds_cptr p) { return __builtin_bit_cast(s16x4, __builtin_amdgcn_ds_read_tr16_b64_v4i16((FXL v4i16_t*)p)); }
__device__ __forceinline__ float rowmax(const f32x16& p0, const f32x16& p1) {
  float a = max3f(p0[0], p0[1], p1[0]), b = max3f(p0[2], p0[3], p1[1]); a = max3f(a, p1[2], p1[3]);
  #pragma unroll
  for (int r = 4; r < 16; r += 4) { a = max3f(a, p0[r], p0[r + 1]); b = max3f(b, p0[r + 2], p0[r + 3]); a = max3f(a, p1[r], p1[r + 1]); b = max3f(b, p1[r + 2], p1[r + 3]); }
  const float m = max2f(a, b);
  auto rr = __builtin_amdgcn_permlane32_swap(__float_as_uint(m), __float_as_uint(m), false, false);
  return max2f(__uint_as_float(rr[0]), __uint_as_float(rr[1]));
}
__device__ __forceinline__ void pv(f32x16* o, int vb, bf16x8 pa0, bf16x8 pa1, bf16x8 pa2, bf16x8 pa3) {
  #pragma unroll
  for (int d0 = 0; d0 < 2; ++d0) { s16x4 lo[4], hi[4];
    #pragma unroll
    for (int ks = 0; ks < 4; ++ks) {
      asm volatile("ds_read_b64_tr_b16 %0,%1 offset:%c2" : "=&v"(lo[ks]) : "v"(vb), "i"(d0 * 4096 + ks * 1024) : "memory");
      asm volatile("ds_read_b64_tr_b16 %0,%1 offset:%c2" : "=&v"(hi[ks]) : "v"(vb), "i"(d0 * 4096 + ks * 1024 + 512) : "memory"); }
    asm volatile("s_waitcnt lgkmcnt(0)" ::: "memory"); SBAR();
    #define PK(k) (bf16x8){lo[k][0], lo[k][1], lo[k][2], lo[k][3], hi[k][0], hi[k][1], hi[k][2], hi[k][3]}
    o[d0] = __builtin_amdgcn_mfma_f32_32x32x16_bf16(pa0, PK(0), o[d0], 0, 0, 0);
    o[d0] = __builtin_amdgcn_mfma_f32_32x32x16_bf16(pa1, PK(1), o[d0], 0, 0, 0);
    o[d0] = __builtin_amdgcn_mfma_f32_32x32x16_bf16(pa2, PK(2), o[d0], 0, 0, 0);
    o[d0] = __builtin_amdgcn_mfma_f32_32x32x16_bf16(pa3, PK(3), o[d0], 0, 0, 0);
    #undef PK
  }
}

template <int LDQ, int LDK, int LDO, int THRL> __device__ __forceinline__ void fox_unit(const bf16* Qb, const bf16* __restrict__ Kh, const bf16* __restrict__ Vh, bf16* Ob, int q0, FXL char* shm) {
  const int tid = threadIdx.x, lane = tid & 63, r32 = lane & 31, hi = lane >> 5; const int wid = __builtin_amdgcn_readfirstlane(tid >> 6);
  const bf16* Qw = Qb + (long)(wid * QBLK) * LDQ;
  const unsigned lds0 = (unsigned)(uintptr_t)shm;
  FXL float* wsf = (FXL float*)(shm + LDS_WS) + wid * 64;
  const FXL unsigned* etab = (const FXL unsigned*)(shm + LDS_TAB);
  const unsigned koff = (unsigned)(lane * LDK + wid * 8) * 2u;
  const unsigned voff = (unsigned)((16 * (wid & 3) + (lane >> 2)) * LDK + (wid >> 2) * 32 + (lane & 3) * 8) * 2u;
  const unsigned kdst = lds0 + LDS_K + wid * 1024, vdst = lds0 + LDS_V + wid * 1024;
  #define DMA_K(t, slot) glds16(Kh + (long)(t) * KVBLK * LDK, koff, (unsigned)__builtin_amdgcn_readfirstlane(kdst + (slot)))
  #define DMA_V(t, slot) glds16(Vh + (long)(t) * KVBLK * LDK, voff, (unsigned)__builtin_amdgcn_readfirstlane(vdst + (slot)))
  bf16x8 kf[8];
  const lds_cptr shm3 = (lds_cptr)shm; const lds_cptr kp0 = shm3 + LDS_K + hi * 1024 + r32 * 16; const lds_cptr vp0 = shm3 + LDS_V + ((lane >> 4) & 1) * 32 + (lane & 3) * 8 + (4 * hi + ((lane & 15) >> 2)) * 64;
  const int NT = (q0 + QB) / KVBLK;
  DMA_K(0, 0); DMA_V(0, 0); DMA_K(1, SLOTB);
  bf16x8 qr[4];
  #pragma unroll
  for (int d0 = 0; d0 < 4; ++d0) qr[d0] = *reinterpret_cast<const bf16x8*>(&Qw[(long)r32 * LDQ + d0 * 16 + hi * 8]);
  u32x2 ax0 = {etab[r32], hi ? 0u : ONES}, ax1 = {etab[32 + r32], hi ? 0u : ONES}, bx = {hi ? 0u : ONES, 0u};
  float l_reg = 0.f; f32x16 o[2]; o[0] = f32x16{}; o[1] = f32x16{};
  #define CMASK(P0, P1, t) do { int jb_ = (t) - (NT - 4); if (jb_ >= 0) { int l_ = lane; asm volatile("" : "+v"(l_)); cmask(P0, P1, jb_, wid * QBLK + (l_ & 31), l_ >> 5); } } while (0)
  #define SETREF(NEWREF) do { unsigned pk_; (void)quant2(-(NEWREF), pk_); bx.y = pk_; asm volatile("" : "+v"(bx)); } while (0)
  #define CURREF() (-(__builtin_bit_cast(float, bx.y << 16) + __builtin_bit_cast(float, bx.y & 0xffff0000u)))
  bool resc = false;
  #define START(P0, P1) do { const float rm = rowmax(P0, P1); resc = false; \
    { SETREF(rm); const float dl = CURREF(); \
      _Pragma("unroll") for (int r = 0; r < 16; ++r) { P0[r] = fsub_s(P0[r], dl); P1[r] = fsub_s(P1[r], dl); } } \
    _Pragma("unroll") for (int r = 0; r < 16; ++r) P0[r] = __builtin_amdgcn_exp2f(P0[r]); } while (0)
  #define RESC() do { if (resc) { asm volatile("s_waitcnt lgkmcnt(0)" ::: "memory"); \
      _Pragma("unroll") for (int d_ = 0; d_ < 2; ++d_) _Pragma("unroll") for (int r = 0; r < 16; ++r) o[d_][r] *= wsf[crow(r, hi)]; } } while (0)
  f32x16 pA0, pA1, pB0, pB1;
  int sl_prev = 0, sl_cur = 0, sl_next = SLOTB;
  #define ROT() do { sl_prev = sl_cur; sl_cur = sl_next; sl_next = (sl_next == (NSLOT - 1) * SLOTB) ? 0 : sl_next + SLOTB; } while (0)
  DMA_K(2, 2 * SLOTB);
  WAIT_BAR(3);
  qkt(pA0, pA1, shm3 + LDS_K, qr, ax0, ax1, bx, r32, hi); asm volatile("s_nop 15\n\ts_nop 7" : "+v"(pA0), "+v"(pA1)); CMASK(pA0, pA1, 0);
  START(pA0, pA1);
  _Pragma("unroll") for (int r = 0; r < 16; ++r) pA1[r] = __builtin_amdgcn_exp2f(pA1[r]);
  WAIT_BAR(0);
  DMA_K(3, 0); DMA_V(1, SLOTB);
  ROT();
  kload8(kf, kp0 + sl_cur); ax0.x = etab[64 + r32]; ax1.x = etab[96 + r32];
  WAIT_BAR(2);
  s16x4 vlo[8], vhi[8]; u32x4 pw0, pw1, pw2, pw3;
  #define PKW(P, B) cvtpk_s(P[B], P[B + 1])
  #define PAF(k) __builtin_bit_cast(bf16x8, pw##k)
  #define VFR(i) (bf16x8){vlo[i][0], vlo[i][1], vlo[i][2], vlo[i][3], vhi[i][0], vhi[i][1], vhi[i][2], vhi[i][3]}
  #define PIN(x) asm volatile("" : "+v"(x))
  #define MX3(a, b, c) __builtin_fmaxf(__builtin_fmaxf((a), (b)), (c))
  #define GAPA(MF, A0, A1, A2, A3, W0, W1, PW) do { MF; sacc += A0; sacc += A1; sacc += A2; sacc += A3; PIN(sacc); W0; W1; PIN(PW); SBAR(); } while (0)
  #define EX(v) __builtin_amdgcn_exp2f(v)
  #define GAPB(MF, X, B) do { MF; X[B] = EX(X[B]); X[B + 1] = EX(X[B + 1]); X[B + 2] = EX(X[B + 2]); X[B + 3] = EX(X[B + 3]); PIN(X); SBAR(); } while (0)
  #define VRD(i) do { vlo[i] = vtr(vp_ + (((i) >> 2) * 4096 + ((i) & 3) * 1024)); vhi[i] = vtr(vp_ + (((i) >> 2) * 4096 + ((i) & 3) * 1024 + 512)); } while (0)
  #define KRD(G, j) do { if (G) { kload2(kf, kp0 + sl_next, j); SBAR(); } } while (0)
  #define ERD(G, t) do { if (G) { ax0.x = etab[((t) + 1) * 64 + r32]; ax1.x = etab[((t) + 1) * 64 + 32 + r32]; SBAR(); } } while (0)
  #define STEP(C0, C1, P0, P1, t, GK, GV, GL) do { SBAR(); \
    const lds_cptr vp_ = vp0 + sl_prev; \
    VRD(0); SBAR(); float sacc = (P0[0] + P0[1]); \
    C0 = MFMA8(ax0, bx, f32x16{}); C1 = MFMA8(ax1, bx, f32x16{}); SBAR(); \
    GAPA(C0 = __builtin_amdgcn_mfma_f32_32x32x16_bf16(kf[0], qr[0], C0, 0, 0, 0), P0[2], P0[3], P0[4], P0[5],     pw0[0] = PKW(P0, 0), pw0[1] = PKW(P0, 2), pw0); \
    VRD(4); SBAR(); GAPA(C1 = __builtin_amdgcn_mfma_f32_32x32x16_bf16(kf[1], qr[0], C1, 0, 0, 0), P0[6], P0[7], P0[8], P0[9],     pw0[2] = PKW(P0, 4), pw0[3] = PKW(P0, 6), pw0); \
    VRD(1); SBAR(); GAPA(C0 = __builtin_amdgcn_mfma_f32_32x32x16_bf16(kf[2], qr[1], C0, 0, 0, 0),   P0[10], P0[11], P0[12], P0[13], pw1[0] = PKW(P0, 8), pw1[1] = PKW(P0, 10), pw1); \
    VRD(5); SBAR(); GAPA(C1 = __builtin_amdgcn_mfma_f32_32x32x16_bf16(kf[3], qr[1], C1, 0, 0, 0),   P0[14], P0[15], P1[0], P1[1],   pw1[2] = PKW(P0, 12), pw1[3] = PKW(P0, 14), pw1); \
    VRD(2); SBAR(); GAPA(C0 = __builtin_amdgcn_mfma_f32_32x32x16_bf16(kf[4], qr[2], C0, 0, 0, 0),   P1[2], P1[3], P1[4], P1[5],     pw2[0] = PKW(P1, 0), pw2[1] = PKW(P1, 2), pw2); \
    VRD(6); SBAR(); GAPA(C1 = __builtin_amdgcn_mfma_f32_32x32x16_bf16(kf[5], qr[2], C1, 0, 0, 0),   P1[6], P1[7], P1[8], P1[9],     pw2[2] = PKW(P1, 4), pw2[3] = PKW(P1, 6), pw2); \
    VRD(3); SBAR(); GAPA(C0 = __builtin_amdgcn_mfma_f32_32x32x16_bf16(kf[6], qr[3], C0, 0, 0, 0),   P1[10], P1[11], P1[12], P1[13], pw3[0] = PKW(P1, 8), pw3[1] = PKW(P1, 10), pw3); \
    VRD(7); SBAR(); GAPA(C1 = __builtin_amdgcn_mfma_f32_32x32x16_bf16(kf[7], qr[3], C1, 0, 0, 0),   P1[14], P1[15], 0.f, 0.f,       pw3[2] = PKW(P1, 12), pw3[3] = PKW(P1, 14), pw3); \
    l_reg += sacc; \
    if (GK) { DMA_K((t) + 3, sl_cur); } if (GV) { DMA_V((t) + 1, sl_next); } \
    CMASK(C0, C1, t); \
    { float a = MX3(C0[0], C0[1], C1[0]), b = MX3(C0[2], C0[3], C1[1]); a = MX3(a, C1[2], C1[3]); \
      _Pragma("unroll") for (int r = 4; r < 16; r += 4) { a = MX3(a, C0[r], C0[r + 1]); b = MX3(b, C0[r + 2], C0[r + 3]); a = MX3(a, C1[r], C1[r + 1]); b = MX3(b, C1[r + 2], C1[r + 3]); } \
      float rm = __builtin_fmaxf(a, b); { auto rr = __builtin_amdgcn_permlane32_swap(__float_as_uint(rm), __float_as_uint(rm), false, false); rm = __builtin_fmaxf(__uint_as_float(rr[0]), __uint_as_float(rr[1])); } \
      resc = false; \
      if (__builtin_expect(__any(rm > (float)THRL), 0)) { const float old_ = CURREF(); SETREF(old_ + __builtin_fmaxf(rm, 0.f)); const float dl = CURREF() - old_; \
        _Pragma("unroll") for (int r = 0; r < 16; ++r) { C0[r] -= dl; C1[r] -= dl; } \
        const float f = __builtin_amdgcn_exp2f(-dl); l_reg *= f; if (hi == 0) wsf[r32] = f; resc = true; } } \
    SBAR(); \
    GAPB(o[0] = __builtin_amdgcn_mfma_f32_32x32x16_bf16(PAF(0), VFR(0), o[0], 0, 0, 0), C0, 0); \
    GAPB(o[1] = __builtin_amdgcn_mfma_f32_32x32x16_bf16(PAF(0), VFR(4), o[1], 0, 0, 0), C0, 4); \
    KRD(GL, 0); GAPB(o[0] = __builtin_amdgcn_mfma_f32_32x32x16_bf16(PAF(1), VFR(1), o[0], 0, 0, 0), C0, 8); \
    KRD(GL, 1); GAPB(o[1] = __builtin_amdgcn_mfma_f32_32x32x16_bf16(PAF(1), VFR(5), o[1], 0, 0, 0), C0, 12); \
    KRD(GL, 2); GAPB(o[0] = __builtin_amdgcn_mfma_f32_32x32x16_bf16(PAF(2), VFR(2), o[0], 0, 0, 0), C1, 0); \
    KRD(GL, 3); GAPB(o[1] = __builtin_amdgcn_mfma_f32_32x32x16_bf16(PAF(2), VFR(6), o[1], 0, 0, 0), C1, 4); \
    ERD(GL, t); GAPB(o[0] = __builtin_amdgcn_mfma_f32_32x32x16_bf16(PAF(3), VFR(3), o[0], 0, 0, 0), C1, 8); \
    GAPB(o[1] = __builtin_amdgcn_mfma_f32_32x32x16_bf16(PAF(3), VFR(7), o[1], 0, 0, 0), C1, 12); \
    } while (0)
  int t = 1;
  #undef CMASK
  #define CMASK(P0, P1, t) do {} while (0)
  for (; t + 5 < NT; t += 2) {
    STEP(pB0, pB1, pA0, pA1, t, true, true, true);     WAIT_BAR(2); RESC(); ROT();
    STEP(pA0, pA1, pB0, pB1, t + 1, true, true, true); WAIT_BAR(2); RESC(); ROT();
  }
  #undef CMASK
  #define CMASK(P0, P1, t) do { int jb_ = (t) - (NT - 4); if (jb_ >= 0) { int l_ = lane; asm volatile("" : "+v"(l_)); cmask(P0, P1, jb_, wid * QBLK + (l_ & 31), l_ >> 5); } } while (0)
  #define ENDW(tt) do { if ((tt) + 3 < NT) { WAIT_BAR(2); } else if ((tt) + 2 < NT) { WAIT_BAR(1); } else { WAIT_BAR(0); } } while (0)
  for (; t + 1 < NT; t += 2) {
    STEP(pB0, pB1, pA0, pA1, t, (t + 3 < NT), (t + 1 < NT), (t + 1 < NT));         ENDW(t);     RESC(); ROT();
    STEP(pA0, pA1, pB0, pB1, t + 1, (t + 4 < NT), (t + 2 < NT), (t + 2 < NT));     ENDW(t + 1); RESC(); ROT();
  }
  STEP(pB0, pB1, pA0, pA1, NT - 1, false, false, false); RESC();
  { float sacc = pB0[0] + pB0[1]; _Pragma("unroll") for (int r = 2; r < 16; ++r) sacc += pB0[r]; _Pragma("unroll") for (int r = 0; r < 16; ++r) sacc += pB1[r]; l_reg += sacc;
    pw0 = (u32x4){PKW(pB0, 0), PKW(pB0, 2), PKW(pB0, 4), PKW(pB0, 6)}; pw1 = (u32x4){PKW(pB0, 8), PKW(pB0, 10), PKW(pB0, 12), PKW(pB0, 14)}; pw2 = (u32x4){PKW(pB1, 0), PKW(pB1, 2), PKW(pB1, 4), PKW(pB1, 6)}; pw3 = (u32x4){PKW(pB1, 8), PKW(pB1, 10), PKW(pB1, 12), PKW(pB1, 14)};
    int lane_d = lane; asm volatile("" : "+v"(lane_d));
    const int vb0 = (int)(lds0 + LDS_V) + ((lane_d >> 4) & 1) * 32 + (lane_d & 3) * 8 + (4 * (lane_d >> 5) + ((lane_d & 15) >> 2)) * 64;
    SBAR(); pv(o, vb0 + sl_cur, PAF(0), PAF(1), PAF(2), PAF(3)); }
  #undef PKW
  #undef PAF
  #undef VFR
  #undef PIN
  #undef MX3
  #undef GAPA
  #undef GAPB
  #undef EX
  #undef VRD
  #undef KRD
  #undef ERD
  #undef STEP
  #undef ENDW
  { auto rr = __builtin_amdgcn_permlane32_swap(__float_as_uint(l_reg), __float_as_uint(l_reg), false, false); l_reg = __uint_as_float(rr[0]) + __uint_as_float(rr[1]); }
  if (hi == 0) wsf[32 + r32] = l_reg; asm volatile("s_waitcnt lgkmcnt(0)" ::: "memory");
  float rli[16];
  #pragma unroll
  for (int r = 0; r < 16; ++r) rli[r] = __builtin_amdgcn_rcpf(wsf[32 + crow(r, hi)]);
  bf16* Ow = Ob + (long)(wid * QBLK) * LDO;
  int lane_e = lane; asm volatile("" : "+v"(lane_e));
  { FXL bf16* stg = (FXL bf16*)(shm + LDS_OST) + wid * 2048;
    #pragma unroll
    for (int r = 0; r < 16; ++r) { const int orow = crow(r, hi);
      #pragma unroll
      for (int d0 = 0; d0 < 2; ++d0) stg[orow * 64 + d0 * 32 + r32] = att::f2bf(o[d0][r] * rli[r]); }
    asm volatile("s_waitcnt lgkmcnt(0)" ::: "memory");
    #pragma unroll
    for (int i = 0; i < 4; ++i) { const int row = i * 8 + (lane_e >> 3), ch = lane_e & 7; const u32x4 v = *(const FXL u32x4*)(stg + row * 64 + ch * 8); *(u32x4*)(Ow + (long)row * LDO + ch * 8) = v; } }
  asm volatile("s_waitcnt lgkmcnt(0)\n\ts_barrier" ::: "memory");
  #undef DMA_K
  #undef DMA_V
  #undef CMASK
  #undef SETREF
  #undef CURREF
  #undef START
  #undef RESC
  #undef ROT
}
#undef SBAR
#undef WAIT_BAR
#undef MFMA8
#undef FXL
}
namespace attd {
using att::bf16; using att::bf16x8; using att::f32x16; using att::crow;
#define LDS3 __attribute__((address_space(3)))
#define ASBAR() __builtin_amdgcn_sched_barrier(0)
template <int DQK, int DV> struct Geo {
    static constexpr int SHM_K = 64 * DQK * 2, SHM_V = 64 * DV * 2, NCB = DV / 32;
    static constexpr int WS_OFF = 3 * SHM_V + 3 * SHM_K, TAB_OFF = WS_OFF + 2048, EXT_OFF = TAB_OFF + 512, EXT_PITCH = 2080, BYTES = TAB_OFF + 12288;
};
__device__ __forceinline__ void dma16(const void* sbase, unsigned voff, unsigned lds_dst) { unsigned keep;
    asm volatile("s_mov_b32 %0, m0\n\ts_mov_b32 m0, %2\n\ts_nop 0\n\tglobal_load_lds_dwordx4 %1, %3\n\ts_mov_b32 m0, %0" : "=&s"(keep) : "v"(voff), "s"(lds_dst), "s"(sbase) : "memory"); }
typedef unsigned u32x2 __attribute__((ext_vector_type(2)));
typedef short v4i16_t __attribute__((ext_vector_type(4)));
constexpr unsigned ONES = 0x3F803F80u;
#define ATD_MFMA8(a, b, c) __builtin_amdgcn_mfma_f32_32x32x8bf16_1k(__builtin_bit_cast(v4i16_t, a), __builtin_bit_cast(v4i16_t, b), c, 0, 0, 0)
__device__ __forceinline__ float quant2(float v, unsigned& pk) { const unsigned h = att::f2bf(v); const float hf = __builtin_bit_cast(float, h << 16); const unsigned l = att::f2bf(v - hf);
    pk = h | (l << 16); return hf + __builtin_bit_cast(float, l << 16); }
template <int DQK> __device__ __forceinline__ void qkt_ref(f32x16& p0, f32x16& p1, const LDS3 char* Ks, const bf16x8* qr, int r32, int hi, u32x2 ax, u32x2 bx) {
    p0 = ATD_MFMA8(ax, bx, f32x16{}); p1 = ATD_MFMA8(ax, bx, f32x16{});
#pragma unroll
    for (int d0 = 0; d0 < DQK / 16; ++d0) { const int cb = (d0 * 16 + hi * 8) * 2;
        const bf16x8 b0 = *(const LDS3 bf16x8*)(Ks + att::kswz<DQK>(r32, cb));
        const bf16x8 b1 = *(const LDS3 bf16x8*)(Ks + att::kswz<DQK>(32 + r32, cb));
        p0 = __builtin_amdgcn_mfma_f32_32x32x16_bf16(b0, qr[d0], p0, 0, 0, 0);
        p1 = __builtin_amdgcn_mfma_f32_32x32x16_bf16(b1, qr[d0], p1, 0, 0, 0); }
}
__device__ __forceinline__ float rowmax32(const f32x16& p0, const f32x16& p1) {
    float a = __builtin_fmaxf(__builtin_fmaxf(p0[0], p0[1]), p1[0]), b = __builtin_fmaxf(__builtin_fmaxf(p0[2], p0[3]), p1[1]); a = __builtin_fmaxf(__builtin_fmaxf(a, p1[2]), p1[3]);
#pragma unroll
    for (int r = 4; r < 16; r += 4) { a = __builtin_fmaxf(__builtin_fmaxf(a, p0[r]), p0[r + 1]); b = __builtin_fmaxf(__builtin_fmaxf(b, p0[r + 2]), p0[r + 3]); a = __builtin_fmaxf(__builtin_fmaxf(a, p1[r]), p1[r + 1]); b = __builtin_fmaxf(__builtin_fmaxf(b, p1[r + 2]), p1[r + 3]); }
    float m = __builtin_fmaxf(a, b);
    auto rr = __builtin_amdgcn_permlane32_swap(__float_as_uint(m), __float_as_uint(m), false, false);
    return __builtin_fmaxf(__uint_as_float(rr[0]), __uint_as_float(rr[1]));
}
__device__ __forceinline__ void bias_t5(f32x16& p0, f32x16& p1, const LDS3 char* ext, int dq) {
    const int B = dq - 3 + 256, sft = B & 3; const LDS3 char* e0 = ext + sft * 2080 + (B - sft) * 4;
#pragma unroll
    for (int g4 = 0; g4 < 4; ++g4) { const att::f32x4 v0 = *(const LDS3 att::f32x4*)(e0 - 32 * g4), v1 = *(const LDS3 att::f32x4*)(e0 - 32 * g4 - 128);
#pragma unroll
        for (int i = 0; i < 4; ++i) { p0[4 * g4 + i] += v0[3 - i]; p1[4 * g4 + i] += v1[3 - i]; } }
}
template <int NCB> __device__ __forceinline__ void pv_pipe(f32x16* o, int vb, bf16x8 pa0, bf16x8 pa1, bf16x8 pa2, bf16x8 pa3) {
    att::s16x4 l[2][4], h[2][4];
#define ATD_RD(D, S) do { l[S][0] = att::tr_read<att::v_rd_off<NCB>(D, 0, 0)>(vb); h[S][0] = att::tr_read<att::v_rd_off<NCB>(D, 0, 1)>(vb); l[S][1] = att::tr_read<att::v_rd_off<NCB>(D, 1, 0)>(vb); h[S][1] = att::tr_read<att::v_rd_off<NCB>(D, 1, 1)>(vb); \
        l[S][2] = att::tr_read<att::v_rd_off<NCB>(D, 2, 0)>(vb); h[S][2] = att::tr_read<att::v_rd_off<NCB>(D, 2, 1)>(vb); l[S][3] = att::tr_read<att::v_rd_off<NCB>(D, 3, 0)>(vb); h[S][3] = att::tr_read<att::v_rd_off<NCB>(D, 3, 1)>(vb); } while (0)
#define ATD_PKV(S, K) (bf16x8){l[S][K][0], l[S][K][1], l[S][K][2], l[S][K][3], h[S][K][0], h[S][K][1], h[S][K][2], h[S][K][3]}
#define ATD_MM(D, S) do { o[D] = __builtin_amdgcn_mfma_f32_32x32x16_bf16(pa0, ATD_PKV(S, 0), o[D], 0, 0, 0); o[D] = __builtin_amdgcn_mfma_f32_32x32x16_bf16(pa1, ATD_PKV(S, 1), o[D], 0, 0, 0); \
        o[D] = __builtin_amdgcn_mfma_f32_32x32x16_bf16(pa2, ATD_PKV(S, 2), o[D], 0, 0, 0); o[D] = __builtin_amdgcn_mfma_f32_32x32x16_bf16(pa3, ATD_PKV(S, 3), o[D], 0, 0, 0); } while (0)
    static_assert(NCB == 4, "four column blocks");
    ATD_RD(0, 0); ATD_RD(1, 1); asm volatile("s_waitcnt lgkmcnt(8)" ::: "memory"); ASBAR(); ATD_MM(0, 0); ASBAR();
    ATD_RD(2, 0); asm volatile("s_waitcnt lgkmcnt(8)" ::: "memory"); ASBAR(); ATD_MM(1, 1); ASBAR();
    ATD_RD(3, 1); asm volatile("s_waitcnt lgkmcnt(8)" ::: "memory"); ASBAR(); ATD_MM(2, 0); ASBAR();
    asm volatile("s_waitcnt lgkmcnt(0)" ::: "memory"); ASBAR(); ATD_MM(3, 1); ASBAR();
#undef ATD_RD
#undef ATD_PKV
#undef ATD_MM
}
template <int DQK, int DV, int MODE, int LDQ, int LDK, int LDO>
__device__ __forceinline__ void attn_unit(const bf16* __restrict__ Qb, const bf16* __restrict__ Kh, const bf16* __restrict__ Vh, bf16* __restrict__ Ob, int NT, int q0, LDS3 char* lds) {
    using G = Geo<DQK, DV>;
    constexpr int SHM_K = G::SHM_K, SHM_V = G::SHM_V, NCB = G::NCB, NKP = SHM_K / 8192, NVP = SHM_V / 8192, NI = NKP + NVP;
    constexpr int RPP = 1024 / (DQK * 2), LPR = DQK * 2 / 16;
    static_assert(MODE == 0 || MODE == 2, "modes 0 and 2");
    const int tid = threadIdx.x, wid = __builtin_amdgcn_readfirstlane(tid >> 6), lane = tid & 63, r32 = lane & 31, hi = lane >> 5;
    LDS3 char* V_lds = lds; LDS3 char* K_lds = lds + 3 * SHM_V;
    LDS3 float* ws = (LDS3 float*)(lds + G::WS_OFF) + wid * 64; LDS3 float* li_l = ws; LDS3 float* al_l = ws + 32;
    const LDS3 float* tab = (const LDS3 float*)(lds + G::TAB_OFF);
    const int q0w = q0 + wid * 32, qabs = q0w + r32;
    float b31 = 0.f;
    if constexpr (MODE == 2) b31 = tab[127];
    float m_reg = -1e30f, l_reg = 0; f32x16 o[NCB]; bf16x8 qr[DQK / 16];
    const u32x2 ax = {hi ? 0u : ONES, 0u};
    u32x2 bx = {0u, 0u};
    float refq = 0.f, cad = 0.f;
    const LDS3 char* ext = (const LDS3 char*)lds + G::EXT_OFF;
#pragma unroll
    for (int d = 0; d < NCB; ++d) o[d] = f32x16{};
    const bf16* Qw = Qb + (long)(wid * 32 + r32) * LDQ + hi * 8;
#pragma unroll
    for (int d0 = 0; d0 < DQK / 16; ++d0) qr[d0] = *reinterpret_cast<const bf16x8*>(Qw + d0 * 16);
    unsigned kgo[NKP], vgo[NVP];
#pragma unroll
    for (int i = 0; i < NKP; ++i) { const int p = wid + 8 * i, row = p * RPP + lane / LPR, c = (lane % LPR) ^ (row & 7); kgo[i] = (unsigned)(row * LDK + c * 8) * 2u; }
#pragma unroll
    for (int i = 0; i < NVP; ++i) { const int p = wid + 8 * i, s = 2 * p + (lane >> 5), kk = (s / NCB) * 8 + ((lane & 31) >> 2), k = (kk & ~0xC) | ((kk & 4) << 1) | ((kk & 8) >> 1), c = (s % NCB) * 32 + (lane & 3) * 8;
        vgo[i] = (unsigned)(k * LDK + c) * 2u; }
    const unsigned lds0 = (unsigned)(uintptr_t)lds, kd0 = lds0 + 3 * SHM_V + wid * 1024, vd0 = lds0 + wid * 1024;
    const int vb0 = (int)lds0 + att::v_rd_base(lane);
#define ATD_DMA_K(t, slot) do { _Pragma("unroll") for (int i_ = 0; i_ < NKP; ++i_) dma16(Kh + (long)(t) * 64 * LDK, kgo[i_], (unsigned)__builtin_amdgcn_readfirstlane(kd0 + (slot) * SHM_K + i_ * 8192)); } while (0)
#define ATD_DMA_V(t, slot) do { _Pragma("unroll") for (int i_ = 0; i_ < NVP; ++i_) dma16(Vh + (long)(t) * 64 * LDK, vgo[i_], (unsigned)__builtin_amdgcn_readfirstlane(vd0 + (slot) * SHM_V + i_ * 8192)); } while (0)
#define ATD_WAITBAR(N) asm volatile("s_waitcnt vmcnt(%0) lgkmcnt(0)\n\ts_barrier" :: "n"(N) : "memory")
#define ATD_RESC(a) do { if (__any((a) < 1.f)) { if (hi == 0) al_l[r32] = (a); asm volatile("s_waitcnt lgkmcnt(0)" ::: "memory"); \
    _Pragma("unroll") for (int d = 0; d < NCB; ++d) _Pragma("unroll") for (int r = 0; r < 16; ++r) o[d][r] *= al_l[crow(r, hi)]; } } while (0)
    f32x16 pA0, pA1, pB0, pB1; float alA, alB; bf16x8 pa0, pa1, pa2, pa3;
    int s_prev = 2, s_cur = 0, s_next = 1;
#define ATD_ROT() do { const int t_ = s_prev; s_prev = s_cur; s_cur = s_next; s_next = t_; } while (0)
#define ATD_SETSHIFT(S_) do { unsigned pk_; refq = -quant2(-(S_), pk_); bx.x = hi ? 0u : pk_; asm volatile("" : "+v"(bx)); } while (0)
#define ATD_CADD(kt) do { if constexpr (MODE == 2) { const float c_ = att::t5_far<MODE>((kt), q0w) ? b31 : 0.f; if (c_ != cad) { ATD_SETSHIFT(refq + cad - c_); cad = c_; } } } while (0)
#define ATD_BIAS(P0, P1, kt) do { if constexpr (MODE == 2) { if (!att::t5_far<MODE>((kt), q0w)) bias_t5(P0, P1, ext, qabs - (kt) * 64 - 4 * hi); } } while (0)
#define ATD_PSM(FIRST_, P0, P1, AL) do { if constexpr (MODE == 0) { att::partialSM_abs(P0, P1, m_reg, AL, 0.f); } else { const float pm_ = rowmax32(P0, P1); AL = 1.f; \
        if (FIRST_ || !__builtin_expect(__all(pm_ <= att::THR2), 1)) { const float old_ = refq, dl0_ = FIRST_ ? pm_ : fmaxf(pm_, 0.f); ATD_SETSHIFT(old_ + dl0_); const float dl_ = refq - old_; \
            if (!FIRST_) AL = __builtin_amdgcn_exp2f(-dl_); \
            _Pragma("unroll") for (int r = 0; r < 16; ++r) { P0[r] -= dl_; P1[r] -= dl_; } } \
        _Pragma("unroll") for (int r = 0; r < 16; ++r) P0[r] = __builtin_amdgcn_exp2f(P0[r]); } } while (0)
#define ATD_QKT(C0, C1, KS) do { if constexpr (MODE == 0) att::qkt<DQK, false>(C0, C1, KS, qr, r32, hi, f32x16{}); else qkt_ref<DQK>(C0, C1, KS, qr, r32, hi, ax, bx); } while (0)
#define ATD_STEP(C0, C1, ALC, P0, P1, ALP, j) do { \
        if ((j) + 1 < NT) ATD_WAITBAR(NI); else ATD_WAITBAR(0); \
        if ((j) + 2 < NT) ATD_DMA_K((j) + 2, s_prev); if ((j) + 1 < NT) ATD_DMA_V((j) + 1, s_next); \
        ATD_CADD(j); ASBAR(); ATD_QKT(C0, C1, K_lds + s_cur * SHM_K); \
        att::finishSM(P0, P1, ALP, l_reg, pa0, pa1, pa2, pa3); ASBAR(); \
        pv_pipe<NCB>(o, vb0 + s_prev * SHM_V, pa0, pa1, pa2, pa3); ATD_BIAS(C0, C1, (j)); ATD_PSM(false, C0, C1, ALC); \
        ATD_RESC(ALC); ATD_ROT(); } while (0)
    ATD_DMA_K(0, 0); ATD_DMA_V(0, 0); ATD_DMA_K(1, 1);
    ATD_WAITBAR(NI);
    if (2 < NT) ATD_DMA_K(2, 2); ATD_DMA_V(1, 1);
    ATD_CADD(0); ATD_QKT(pA0, pA1, K_lds); ATD_BIAS(pA0, pA1, 0); ATD_PSM(true, pA0, pA1, alA);
    ATD_ROT();
    int j = 1;
    for (; j + 1 < NT; j += 2) {
        ATD_STEP(pB0, pB1, alB, pA0, pA1, alA, j);
        ATD_STEP(pA0, pA1, alA, pB0, pB1, alB, j + 1);
    }
    ATD_STEP(pB0, pB1, alB, pA0, pA1, alA, j);
    att::finishSM(pB0, pB1, alB, l_reg, pa0, pa1, pa2, pa3); ASBAR();
    pv_pipe<NCB>(o, vb0 + s_prev * SHM_V, pa0, pa1, pa2, pa3);
    if (hi == 0) li_l[r32] = l_reg; asm volatile("s_waitcnt lgkmcnt(0)" ::: "memory");
    float rli[16];
#pragma unroll
    for (int r = 0; r < 16; ++r) rli[r] = __builtin_amdgcn_rcpf(li_l[crow(r, hi)]);
    bf16* Ow = Ob + (long)(wid * 32) * LDO;
#pragma unroll
    for (int r = 0; r < 16; ++r) { const int orow = crow(r, hi);
#pragma unroll
        for (int d0 = 0; d0 < NCB; ++d0) Ow[(long)orow * LDO + d0 * 32 + r32] = att::f2bf(o[d0][r] * rli[r]); }
    asm volatile("s_waitcnt lgkmcnt(0)\n\ts_barrier" ::: "memory");
#undef ATD_DMA_K
#undef ATD_DMA_V
#undef ATD_WAITBAR
#undef ATD_RESC
#undef ATD_ROT
#undef ATD_PSM
#undef ATD_QKT
#undef ATD_SETSHIFT
#undef ATD_CADD
#undef ATD_BIAS
#undef ATD_STEP
}
#undef ATD_MFMA8
#undef ASBAR
#undef LDS3
}

#define GAS __attribute__((address_space(1)))
#define LAS __attribute__((address_space(3)))
typedef unsigned short bf16;
typedef unsigned v4u __attribute__((ext_vector_type(4)));
typedef float f32x4 __attribute__((ext_vector_type(4)));
typedef short bf16x8 __attribute__((ext_vector_type(8)));
typedef GAS unsigned gu32;
typedef GAS unsigned long long gu64;
#define RLX_AGENT __ATOMIC_RELAXED, __HIP_MEMORY_SCOPE_AGENT
#define LDS_WAIT() asm volatile("s_waitcnt lgkmcnt(0)" ::: "memory")
#define VM_WAIT() asm volatile("s_waitcnt vmcnt(0)" ::: "memory")
__device__ __forceinline__ unsigned long long rt() { return __builtin_amdgcn_s_memrealtime(); }
__device__ __forceinline__ unsigned f2bf(float f) { unsigned u = __builtin_bit_cast(unsigned, f); return (u + 0x7fffu + ((u >> 16) & 1u)) >> 16; }
__device__ __forceinline__ unsigned pk2(float lo, float hi) { return f2bf(lo) | (f2bf(hi) << 16); }

#define XB_TMO      128
#define XB_XCNT(j)  (256  + 64 * (j))
#define XB_XSUB(j)  (1280 + 64 * (j))
#define XB_XGEN(j)  (2304 + 64 * (j))
#define XB_TOP      3328
#define XB_TOPGEN   3392
#define XCD_BAR_WORDS 3456
#define XB_SPIN_CAP (1u << 18)

__device__ __forceinline__ unsigned xb_ld(unsigned* p)              { return __hip_atomic_load(p, __ATOMIC_RELAXED, __HIP_MEMORY_SCOPE_AGENT); }
__device__ __forceinline__ unsigned xb_add(unsigned* p, unsigned v) { return __hip_atomic_fetch_add(p, v, __ATOMIC_RELAXED, __HIP_MEMORY_SCOPE_AGENT); }
__device__ __forceinline__ unsigned xb_xcc_id() { return (unsigned)__builtin_amdgcn_s_getreg((3 << 11) | 20) & 0xFu; }
#define XB_SPIN(cond, bar) do { unsigned _sp = 0; while (cond) { __builtin_amdgcn_s_sleep(1); \
    if ((++_sp & 255u) == 0u) { if (xb_ld(&(bar)[XB_TMO])) break; if (_sp > XB_SPIN_CAP) { atomicAdd(&(bar)[XB_TMO], 1u); break; } } } } while (0)

struct XcdBarrier {
    unsigned* bar; unsigned x;
    volatile LAS unsigned* st;
};

__device__ __forceinline__ XcdBarrier xcd_barrier_post(unsigned* bar, volatile LAS unsigned* st) {
    XcdBarrier b; b.bar = bar; b.x = xb_xcc_id(); b.st = st;
    if (threadIdx.x == 0) (void)xb_add(&bar[XB_XCNT(b.x)], 1u);
    return b;
}
__device__ __forceinline__ void xcd_barrier_complete(unsigned* bar, unsigned x, unsigned& nloc, unsigned& nx) {
    const unsigned G = gridDim.x * gridDim.y * gridDim.z;
    unsigned sum, cnt, mine, sp = 0u;
    for (;;) {
        sum = 0u; cnt = 0u; mine = 0u;
#pragma unroll
        for (unsigned j = 0; j < 16; ++j) { const unsigned c = xb_ld(&bar[XB_XCNT(j)]); sum += c; cnt += (c > 0u) ? 1u : 0u; mine = (j == x) ? c : mine; }
        if (sum == G) break;
        __builtin_amdgcn_s_sleep(1);
        if ((++sp & 255u) == 0u) { if (xb_ld(&bar[XB_TMO])) break; if (sp > XB_SPIN_CAP) { atomicAdd(&bar[XB_TMO], 1u); break; } }
    }
    nloc = mine > 0u ? mine : 1u; nx = cnt > 0u ? cnt : 1u;
}

__device__ __forceinline__ void xcd_barrier(const XcdBarrier& b) {
    asm volatile("s_waitcnt vmcnt(0)" ::: "memory");
    __syncthreads();
    if (threadIdx.x == 0) {
        unsigned* bar = b.bar;
        __builtin_amdgcn_s_waitcnt(0);
        unsigned nloc = b.st[0], nx = b.st[1];
        if (nloc == 0u) { xcd_barrier_complete(bar, b.x, nloc, nx); b.st[0] = nloc; b.st[1] = nx; }
        const unsigned old = xb_add(&bar[XB_XSUB(b.x)], 1u);
        const unsigned gen = old / nloc;
        if (old + 1u == (gen + 1u) * nloc) {
            __builtin_amdgcn_fence(__ATOMIC_RELEASE, "agent");
            asm volatile("s_waitcnt vmcnt(0)" ::: "memory");
            const unsigned og = xb_add(&bar[XB_TOP], 1u);
            const unsigned tg = og / nx;
            if (og + 1u == (tg + 1u) * nx) xb_add(&bar[XB_TOPGEN], 1u);
            else XB_SPIN(xb_ld(&bar[XB_TOPGEN]) == tg, bar);
            __builtin_amdgcn_fence(__ATOMIC_ACQUIRE, "agent");
            xb_add(&bar[XB_XGEN(b.x)], 1u);
            asm volatile("s_waitcnt vmcnt(0)" ::: "memory");
        } else {
            XB_SPIN(xb_ld(&bar[XB_XGEN(b.x)]) == gen, bar);
            __builtin_amdgcn_fence(__ATOMIC_ACQUIRE, "agent");
            asm volatile("s_waitcnt vmcnt(0)" ::: "memory");
        }
    }
    __syncthreads();
}

constexpr int NWAVES = 8;
#ifndef FFN_FP8
#define FFN_FP8 2
#endif
#ifndef MK_PER_PHASE
#define MK_PER_PHASE 0
#endif
constexpr int BATCH = 8, SEQ = 2048, D = 1024, M = BATCH * SEQ, MEMLEN = 256, MMEM = BATCH * MEMLEN;
constexpr int EV_SRC_N = 2568, PW = 2560  , OD_SRC_N = 3072;
constexpr int FF = 2816, FE = 3584, NE = 8, XW = 512;
constexpr int PAIR_ROWS = 2 * M + NE * 256;
constexpr float EPS = 1e-6f;
constexpr float LOG2E = 1.4426950408889634f;
constexpr float C2_64 = 0.125f * LOG2E, C2_128 = 0.08838834764831845f * LOG2E;
constexpr float LAM_INIT = 0.35550906759096926f;
constexpr size_t MiB = 1u << 20;
constexpr size_t WS_CTL = 0, CTL_ZERO_BYTES = 1 * MiB;
constexpr size_t WS_W_EVIN = 1 * MiB;
constexpr size_t WS_W_MKV = WS_W_EVIN + 5 * MiB;
constexpr size_t WS_W_EVOUT = WS_W_MKV + 4 * MiB;
constexpr size_t WS_W_XQ = WS_W_EVOUT + 2 * MiB;
constexpr size_t WS_W_XO = WS_W_XQ + 2 * MiB;
constexpr size_t WS_W_F13 = WS_W_XO + 2 * MiB;
constexpr size_t WS_W_F2 = WS_W_F13 + 11 * MiB;
constexpr size_t WS_W_ODIN = WS_W_F2 + 6 * MiB;
constexpr size_t WS_W_ODOUT = WS_W_ODIN + 6 * MiB;
constexpr size_t WS_W_M13 = WS_W_ODOUT + 2 * MiB;
constexpr size_t WS_W_M2 = WS_W_M13 + 112 * MiB;
constexpr size_t WS_XB = WS_W_M2 + 56 * MiB;
constexpr size_t WS_SSQ = WS_XB + 32 * MiB;
constexpr size_t WS_FLOG = WS_SSQ + 1 * MiB;
constexpr size_t WS_C2 = WS_FLOG + 1 * MiB;
constexpr size_t WS_TOK = WS_C2 + 1 * MiB;
constexpr size_t WS_GATE = WS_TOK + 1 * MiB;
constexpr size_t WS_P = WS_GATE + 1 * MiB;
constexpr size_t WS_AG = WS_P + 80 * MiB;
constexpr size_t WS_OD = WS_AG + 32 * MiB;
constexpr size_t WS_MEMN = WS_OD + 32 * MiB;
constexpr size_t WS_KVM = WS_MEMN + 4 * MiB;
constexpr size_t WS_QX = WS_KVM + 8 * MiB;
constexpr size_t WS_OX = WS_QX + 16 * MiB;
constexpr size_t WS_ACT = WS_OX + 16 * MiB;
constexpr size_t WS_Y = WS_ACT + 238 * MiB;
constexpr size_t WS_HG = WS_P;
constexpr size_t WS_XB8 = WS_Y + 68 * MiB;
constexpr size_t WS_END = WS_XB8 + 16 * MiB;
static_assert((size_t)PAIR_ROWS * 1024 * 2 <= 68 * MiB && (size_t)PAIR_ROWS * 3584 * 2 <= 238 * MiB && (size_t)M * PW * 2 <= 80 * MiB, "d_ws map");
constexpr int CW_CNT = 64;
constexpr int CW_NT = 128;
constexpr int CW_TID = 256;
constexpr int CW_TEXP = 1024;
constexpr int CW_BAR = 4096;
constexpr int RING_OFF = 0, RING_BYTES = 131072;
constexpr int TEXP_LDS = RING_BYTES + 2048;
constexpr int LDS_BYTES = 147456;
constexpr int LDSCTL_OFF = LDS_BYTES - 1024, MISC_OFF = LDSCTL_OFF + 320;

struct Args { const float* in[31]; float* out; unsigned char* ws; int ph_lo, ph_hi; };
struct Frame {
    LAS unsigned char* lds;
    volatile LAS unsigned* MISC;
    gu32* ctl;
    int tid, lane, wave;
    int vcu, G;
    const Args* a;
    float* out; unsigned char* ws;
};
#define ROWPIPE(BUF_T, M_, LOAD, PROC) do { BUF_T ra_, rb_; int m_ = gw; if (m_ < (M_)) LOAD(ra_, m_); \
    while (m_ < (M_)) { int n_ = m_ + NGW; if (n_ < (M_)) LOAD(rb_, n_); PROC(ra_, m_); m_ = n_; if (m_ >= (M_)) break; \
        n_ = m_ + NGW; if (n_ < (M_)) LOAD(ra_, n_); PROC(rb_, m_); m_ = n_; } } while (0)
#define ROWPIPE4(BUF_T, M_, LOAD, PROC) do { if (NGW * 8 == (M_)) { BUF_T r0_, r1_, r2_, r3_; const int m_ = gw; \
        LOAD(r0_, m_); LOAD(r1_, m_ + NGW); LOAD(r2_, m_ + 2 * NGW); \
        LOAD(r3_, m_ + 3 * NGW); PROC(r0_, m_); \
        LOAD(r0_, m_ + 4 * NGW); PROC(r1_, m_ + NGW); \
        LOAD(r1_, m_ + 5 * NGW); PROC(r2_, m_ + 2 * NGW); \
        LOAD(r2_, m_ + 6 * NGW); PROC(r3_, m_ + 3 * NGW); \
        LOAD(r3_, m_ + 7 * NGW); PROC(r0_, m_ + 4 * NGW); \
        PROC(r1_, m_ + 5 * NGW); PROC(r2_, m_ + 6 * NGW); PROC(r3_, m_ + 7 * NGW); \
    } else ROWPIPE(BUF_T, M_, LOAD, PROC); } while (0)
struct RowF32 { f32x4 v[4]; };
struct RowBf16 { unsigned long long w[4]; };
__device__ __forceinline__ float wave_sum(float v) {
#pragma unroll
    for (int o = 1; o < 64; o <<= 1) v += __shfl_xor(v, o);
    return v;
}
__device__ __forceinline__ float bf2f(unsigned short b) { return __builtin_bit_cast(float, (unsigned)b << 16); }
__device__ __forceinline__ float bflo(unsigned w) { return __builtin_bit_cast(float, w << 16); }
__device__ __forceinline__ float bfhi(unsigned w) { return __builtin_bit_cast(float, w & 0xffff0000u); }

__device__ __forceinline__ unsigned pk4_fp8(float a, float b, float c, float d) { int w = __builtin_amdgcn_cvt_pk_fp8_f32(a, b, 0, false); w = __builtin_amdgcn_cvt_pk_fp8_f32(c, d, w, true); return (unsigned)w; }
#ifndef MOE_Q
#define MOE_Q 40
#endif
constexpr int M13_Q = MOE_Q;
struct XtDesc { const float* W; int ldw, scol0, k0; unsigned char* WT; int K, drow0; const float* gain; float scale; int fp8; };
struct XtRegs { f32x4 v[8]; f32x4 g0, g1; };
#define XT_BAR() asm volatile("s_waitcnt lgkmcnt(0)\n\ts_barrier" ::: "memory")
__device__ __forceinline__ void xt_load(XtRegs& r, const XtDesc& d, int wave, int lane) {
    const int kk = d.k0 + 16 * wave + 8 * (lane >> 5);
    const float* wp = d.W + (size_t)kk * d.ldw + d.scol0 + 4 * (lane & 31);
#pragma unroll
    for (int i = 0; i < 8; ++i) r.v[i] = __builtin_nontemporal_load((const f32x4*)(wp + (size_t)i * d.ldw));
    const float* gp = d.gain ? d.gain + kk : d.W;
    r.g0 = *(const f32x4*)gp; r.g1 = *(const f32x4*)(gp + 4);
}
__device__ __forceinline__ void xt_store(const XtRegs& r, const XtDesc& d, LAS unsigned char* buf, int wave, int lane) {
    const int q = lane & 31, half = lane >> 5, c = 2 * wave + half;
    float g[8] = {r.g0.x, r.g0.y, r.g0.z, r.g0.w, r.g1.x, r.g1.y, r.g1.z, r.g1.w};
#pragma unroll
    for (int i = 0; i < 8; ++i) g[i] = d.gain ? g[i] * d.scale : d.scale;
    if (!d.fp8) {
#pragma unroll
        for (int e = 0; e < 4; ++e) { const int n = 4 * q + e;
            v4u w; w.x = pk2(r.v[0][e] * g[0], r.v[1][e] * g[1]); w.y = pk2(r.v[2][e] * g[2], r.v[3][e] * g[3]); w.z = pk2(r.v[4][e] * g[4], r.v[5][e] * g[5]); w.w = pk2(r.v[6][e] * g[6], r.v[7][e] * g[7]);
            *(LAS v4u*)(buf + n * 256 + ((c ^ (q & 15)) << 4)) = w; }
    } else {
#pragma unroll
        for (int e = 0; e < 4; ++e) { const int n = 4 * q + e;
            const unsigned lo = pk4_fp8(r.v[0][e] * g[0], r.v[1][e] * g[1], r.v[2][e] * g[2], r.v[3][e] * g[3]), hi = pk4_fp8(r.v[4][e] * g[4], r.v[5][e] * g[5], r.v[6][e] * g[6], r.v[7][e] * g[7]);
            *(LAS unsigned long long*)(buf + n * 128 + ((c ^ (2 * (q & 7))) << 3)) = (unsigned long long)lo | ((unsigned long long)hi << 32); }
    }
    XT_BAR();
    if (!d.fp8) {
#pragma unroll
        for (int j = 0; j < 4; ++j) { const int row = 16 * wave + 4 * j + (lane >> 4), p = lane & 15;
            const v4u w = *(const LAS v4u*)(buf + row * 256 + ((p ^ ((row >> 2) & 15)) << 4));
            *(GAS v4u*)((bf16*)d.WT + (size_t)(d.drow0 + row) * d.K + d.k0 + 8 * p) = w; }
    } else {
#pragma unroll
        for (int j = 0; j < 2; ++j) { const int row = 16 * wave + 8 * j + (lane >> 3), p = lane & 7;
            const v4u w = *(const LAS v4u*)(buf + row * 128 + ((p ^ ((row >> 2) & 7)) << 4));
            *(GAS v4u*)(d.WT + (size_t)(d.drow0 + row) * d.K + d.k0 + 16 * p) = w; }
    }
}
template <class DEC> __device__ __forceinline__ void xt_run(Frame& F, int t0, int step, int n, const DEC& dec) {
    if (t0 >= n) return;
    LAS unsigned char* b0 = F.lds + RING_OFF; LAS unsigned char* b1 = b0 + 32768;
    XT_BAR();
    XtRegs A, B; XtDesc dA = dec(t0), dB; xt_load(A, dA, F.wave, F.lane);
    for (int t = t0; t < n; t += 2 * step) {
        const int t1 = t + step, t2 = t + 2 * step;
        dB = dec(t1 < n ? t1 : t); if (t1 >= n) { dB.ldw = 0; dB.k0 = 0; dB.scol0 = 0; dB.gain = nullptr; }
        xt_load(B, dB, F.wave, F.lane);
        xt_store(A, dA, b0, F.wave, F.lane);
        dA = dec(t2 < n ? t2 : t); if (t2 >= n) { dA.ldw = 0; dA.k0 = 0; dA.scol0 = 0; dA.gain = nullptr; }
        xt_load(A, dA, F.wave, F.lane);
        if (t1 < n) xt_store(B, dB, b1, F.wave, F.lane);
    }
    XT_BAR();
}
enum { MAP_ID = 0, MAP_EVIN = 1, MAP_ODIN = 2, MAP_SWIGLU = 3 };
struct XtJob { const float* W; int ldw, K, N, Fh; unsigned char* WT; const float* gain; float scale; int map, fp8; };
__device__ __forceinline__ int xt_job_tiles(const XtJob& j) { return (j.K >> 7) * (j.N >> 7); }
__device__ __forceinline__ XtDesc xt_job_dec(const XtJob& j, int t) {
    const int nnb = j.N >> 7, kb = t / nnb, nb = t % nnb; int scol = 128 * nb; float sc = j.scale;
    if (j.map == MAP_EVIN) { if (nb < 4) sc *= C2_64; scol = nb < 12 ? 128 * nb : 1544 + 128 * (nb - 12); }
    else if (j.map == MAP_ODIN) { if (nb >= 4 && nb < 12) { const int u = nb - 4; scol = 512 + (u & 1) * 512 + (u >> 1) * 128; } else if (nb >= 12) { scol = 1536 + 128 * (nb - 12); if (nb < 16) sc *= C2_64; } }
    else if (j.map == MAP_SWIGLU) scol = (nb & 1) * j.Fh + (nb >> 1) * 128;
    return XtDesc{j.W, j.ldw, scol, 128 * kb, j.WT, j.K, 128 * nb, j.gain, sc, j.fp8};
}
constexpr int MOE_T13 = NE * 8 * 56, MOE_T2 = NE * 28 * 8, MOE_TILES = MOE_T13 + MOE_T2, MOE_TQ = MOE_Q / 4, MOE_SLOT_TILES = (64 + 3 * 128) * MOE_TQ;
static_assert(MOE_SLOT_TILES <= MOE_TILES && MOE_Q % 4 == 0, "expert weight conversion slots");
__device__ __forceinline__ XtDesc moe_dec(const float* W13, const float* W2, unsigned char* ws, int t) {
    if (t < MOE_T13) { const int e = t / 448, r = t % 448, kb = r / 56, nb = r % 56;
        return XtDesc{W13 + (size_t)e * D * 2 * FE, 2 * FE, (nb & 1) * FE + (nb >> 1) * 128, 128 * kb, ws + WS_W_M13 + (size_t)e * 2 * FE * D, D, 128 * nb, nullptr, 64.f, 1}; }
    t -= MOE_T13; const int e = t / 224, r = t % 224, kb = r / 8, nb = r % 8;
    return XtDesc{W2 + (size_t)e * FE * D, D, 128 * nb, 128 * kb, ws + WS_W_M2 + (size_t)e * D * FE, FE, 128 * nb, nullptr, 128.f, 1};
}
constexpr int P0_DENSE_TILES = 64 + 192 + 352 + 176 + 64 + 64 + 64 + 128 + 160;
__device__ __forceinline__ XtDesc p0_dec(Frame& F, int g) {
    unsigned char* ws = F.ws;
    const int moe_first = (F.G == 256) ? MOE_SLOT_TILES : 0, moe_n = MOE_TILES - moe_first;
    if (g < moe_n) return moe_dec(F.a->in[24], F.a->in[25], ws, moe_first + g);
    g -= moe_n;
#define P0_JOB(...) { const XtJob j_{__VA_ARGS__}; const int n_ = xt_job_tiles(j_); if (g < n_) return xt_job_dec(j_, g); g -= n_; }
    P0_JOB(F.a->in[22], D, D, D, 0, ws + WS_W_ODOUT, nullptr, 1.f, MAP_ID, 0)
    P0_JOB(F.a->in[15], OD_SRC_N, D, 3072, 0, ws + WS_W_ODIN, F.a->in[14], 1.f, MAP_ODIN, 0)
    P0_JOB(F.a->in[12], 2 * FF, D, 2 * FF, FF, ws + WS_W_F13, F.a->in[30], (FFN_FP8 == 1) ? 64.f : 1.f, MAP_SWIGLU, (FFN_FP8 == 1) ? 1 : 0)
    P0_JOB(F.a->in[13], D, FF, D, 0, ws + WS_W_F2, nullptr, (FFN_FP8 >= 1) ? 128.f : 1.f, MAP_ID, (FFN_FP8 >= 1) ? 1 : 0)
    P0_JOB(F.a->in[29], D, XW, D, 0, ws + WS_W_XO, nullptr, 1.f, MAP_ID, 0)
    P0_JOB(F.a->in[29] + (size_t)XW * D, D, XW, D, 0, ws + WS_W_XO + (size_t)D * XW * 2, nullptr, 1.f, MAP_ID, 0)
    P0_JOB(F.a->in[27], XW, D, XW, 0, ws + WS_W_XQ, F.a->in[26], C2_128, MAP_ID, 0)
    P0_JOB(F.a->in[27] + (size_t)D * XW, XW, D, XW, 0, ws + WS_W_XQ + (size_t)XW * D * 2, F.a->in[26] + D, C2_128, MAP_ID, 0)
    P0_JOB(F.a->in[11], D, D, D, 0, ws + WS_W_EVOUT, nullptr, 1.f, MAP_ID, 0)
    P0_JOB(F.a->in[28], 1024, D, 1024, 0, ws + WS_W_MKV, nullptr, 1.f, MAP_ID, 0)
    P0_JOB(F.a->in[28] + (size_t)D * 1024, 1024, D, 1024, 0, ws + WS_W_MKV + (size_t)1024 * D * 2, nullptr, 1.f, MAP_ID, 0)
    { const XtJob j_{F.a->in[6], EV_SRC_N, D, 2560, 0, ws + WS_W_EVIN, F.a->in[5], 1.f, MAP_EVIN, 0}; return xt_job_dec(j_, g); }
#undef P0_JOB
}
__device__ __forceinline__ void p0_prologue(Frame& F) {
    unsigned char* ws = F.ws;
    __syncthreads();
    const int gw = F.vcu * NWAVES + F.wave, NGW = F.G * NWAVES, lane = F.lane;
    {
        const float* Ws = F.a->in[9]; bf16* WSB = (bf16*)(ws + WS_C2 + 512 * 1024);
        for (int u = (F.vcu * NWAVES + F.wave) * 64 + lane; u < 4 * 128 * 128 / 4; u += F.G * NWAVES * 64) { const int t = (u >> 5) & 127, s0 = (u & 31) * 4; f32x4 w = ((const f32x4*)Ws)[u];
            w.x = (s0 + 0 <= t) ? w.x : 0.f; w.y = (s0 + 1 <= t) ? w.y : 0.f; w.z = (s0 + 2 <= t) ? w.z : 0.f; w.w = (s0 + 3 <= t) ? w.w : 0.f;
            *(unsigned long long*)(WSB + (size_t)u * 4) = (unsigned long long)pk2(w.x, w.y) | ((unsigned long long)pk2(w.z, w.w) << 32); }
    }
    { const int moe_n = MOE_TILES - ((F.G == 256) ? MOE_SLOT_TILES : 0);
      xt_run(F, F.vcu, F.G, moe_n + P0_DENSE_TILES, [&](int g) { return p0_dec(F, g); }); }
    __syncthreads();
    {
        LAS float* wfg = (LAS float*)(F.lds);
        const float* Win = F.a->in[6]; const float* gn = F.a->in[5];
        for (int u = F.tid; u < 8 * 1024; u += NWAVES * 64) { const int k = u >> 3, j = u & 7; wfg[j * 1024 + k] = Win[(size_t)k * EV_SRC_N + 1536 + j] * gn[k]; }
        __syncthreads();
        const float* x = F.a->in[0]; const float* bfp = F.a->in[7];
        bf16* XB = (bf16*)(ws + WS_XB); float* SSQ = (float*)(ws + WS_SSQ); float* FLOG = (float*)(ws + WS_FLOG);
        const float bfv = bfp[lane & 7];
        auto xload = [&](RowF32& b, int m) { const GAS f32x4* xr = (const GAS f32x4*)(x + (size_t)m * D) + lane;
#pragma unroll
            for (int j = 0; j < 4; ++j) b.v[j] = __builtin_nontemporal_load((const f32x4*)xr + 64 * j); };
        auto xproc = [&](const RowF32& b, int m) {
            float s = 0.f;
#pragma unroll
            for (int j = 0; j < 4; ++j) s += (b.v[j].x * b.v[j].x + b.v[j].y * b.v[j].y) + (b.v[j].z * b.v[j].z + b.v[j].w * b.v[j].w);
            const float ssq = wave_sum(s), rs = __builtin_amdgcn_rsqf(ssq * (1.0f / D) + EPS);
            GAS unsigned long long* o8 = (GAS unsigned long long*)(XB + (size_t)m * D) + lane;
#pragma unroll
            for (int j = 0; j < 4; ++j) o8[64 * j] = (unsigned long long)pk2(b.v[j].x, b.v[j].y) | ((unsigned long long)pk2(b.v[j].z, b.v[j].w) << 32);
            float f[8];
#pragma unroll
            for (int c = 0; c < 8; ++c) { float a = 0.f;
#pragma unroll
                for (int j = 0; j < 4; ++j) { const f32x4 w = *(const LAS f32x4*)(wfg + c * 1024 + 4 * lane + 256 * j); a += (b.v[j].x * w.x + b.v[j].y * w.y) + (b.v[j].z * w.z + b.v[j].w * w.w); }
                f[c] = wave_sum(a); }
            float fl = f[0];
#pragma unroll
            for (int c = 1; c < 8; ++c) fl = (lane == c) ? f[c] : fl;
            if (lane < 8) { const float z = fl * rs + bfv; FLOG[(size_t)m * 8 + lane] = fminf(z, 0.f) - log1pf(expf(-fabsf(z))); }
            if (lane < 16) SSQ[(size_t)m * 16 + lane] = (lane == 0) ? ssq : 0.f; };
        ROWPIPE4(RowF32, M, xload, xproc);
        const float* mem = F.a->in[1]; const float* mg = F.a->in[3]; bf16* MEMN = (bf16*)(ws + WS_MEMN);
        for (int m = gw; m < MMEM; m += NGW) {
            const GAS f32x4* xr = (const GAS f32x4*)(mem + (size_t)m * D) + lane; const GAS f32x4* gr = (const GAS f32x4*)mg + lane;
            f32x4 v[4]; float s = 0.f;
#pragma unroll
            for (int j = 0; j < 4; ++j) { v[j] = xr[64 * j]; s += (v[j].x * v[j].x + v[j].y * v[j].y) + (v[j].z * v[j].z + v[j].w * v[j].w); }
            const float rs = __builtin_amdgcn_rsqf(wave_sum(s) * (1.0f / D) + EPS);
            GAS unsigned long long* o8 = (GAS unsigned long long*)(MEMN + (size_t)m * D) + lane;
#pragma unroll
            for (int j = 0; j < 4; ++j) { const f32x4 g = gr[64 * j]; o8[64 * j] = (unsigned long long)pk2(v[j].x * rs * g.x, v[j].y * rs * g.y) | ((unsigned long long)pk2(v[j].z * rs * g.z, v[j].w * rs * g.w) << 32); }
        }
        __syncthreads();
    }
}
__device__ __forceinline__ void m13_slot(Frame& F, int item0, int first_block) {
    const int rank = (int)blockIdx.x - first_block; if (rank < 0 || F.G != 256) return;
    const float* W13 = F.a->in[24]; const float* W2 = F.a->in[25]; unsigned char* ws = F.ws; const int base = item0 / 4 + rank * MOE_TQ;
    xt_run(F, 0, 1, MOE_TQ, [&](int k) { return moe_dec(W13, W2, ws, base + k); });
}
__device__ __forceinline__ void cumsum_seq(Frame& F, int sq) {
    const float* FLOG = (const float*)(F.ws + WS_FLOG); float* C2 = (float*)(F.ws + WS_C2);
    const int b = sq >> 3, h = sq & 7, lane = F.lane;
    const float* src = FLOG + ((size_t)b * SEQ + 32 * lane) * 8 + h;
    float v[32]; float run = 0.f;
#pragma unroll
    for (int i = 0; i < 32; ++i) { run += src[i * 8]; v[i] = run; }
    float tot = run;
#pragma unroll
    for (int o = 1; o < 64; o <<= 1) { const float t = __shfl_up(tot, o); if (lane >= o) tot += t; }
    const float base = tot - run;
    float* dst = C2 + (size_t)sq * SEQ + 32 * lane;
#pragma unroll
    for (int i = 0; i < 32; ++i) dst[i] = (base + v[i]) * LOG2E;
}
__device__ __forceinline__ void sgu_unit(Frame& F, int b, int c, int g) {
    typedef att::bf16x8 bf16x8; typedef att::f32x16 f32x16;
    constexpr int LP = 136;
    constexpr int V_OFF = 40960, ST_OFF = 73728;
    LAS unsigned short* Wl = (LAS unsigned short*)(F.lds); LAS char* Vl = (LAS char*)(F.lds + V_OFF); LAS unsigned short* St = (LAS unsigned short*)(F.lds + ST_OFF);
    const int tid = F.tid, lane = F.lane, wid = F.wave, r32 = lane & 31, hi = lane >> 5;
    const bf16* P = (const bf16*)(F.ws + WS_P); bf16* AG = (bf16*)(F.ws + WS_AG); const bf16* WSB = (const bf16*)(F.ws + WS_C2 + 512 * 1024);
    const size_t row0 = (size_t)b * SEQ + (size_t)c * 128;
    {
        const int t = tid >> 2, s0 = (tid & 3) * 32; const v4u* wp = (const v4u*)(WSB + ((size_t)g * 128 + t) * 128 + s0);
#pragma unroll
        for (int i = 0; i < 4; ++i) *(LAS v4u*)(Wl + t * LP + s0 + 8 * i) = wp[i];
    }
    {
        const int s = tid >> 2, d0 = (tid & 3) * 32; const bf16* vp = P + (row0 + s) * PW + 2048 + g * 128 + d0; const float* gn = F.a->in[8] + g * 128 + d0;
        float v[32]; float ss = 0.f;
#pragma unroll
        for (int i = 0; i < 4; ++i) { const v4u w = ((const v4u*)vp)[i];
            v[8 * i + 0] = bflo(w.x); v[8 * i + 1] = bfhi(w.x); v[8 * i + 2] = bflo(w.y); v[8 * i + 3] = bfhi(w.y); v[8 * i + 4] = bflo(w.z); v[8 * i + 5] = bfhi(w.z); v[8 * i + 6] = bflo(w.w); v[8 * i + 7] = bfhi(w.w); }
#pragma unroll
        for (int i = 0; i < 32; ++i) ss += v[i] * v[i];
        ss += __shfl_xor(ss, 1); ss += __shfl_xor(ss, 2);
        const float rs = __builtin_amdgcn_rsqf(ss * (1.0f / 128.0f) + EPS);
#pragma unroll
        for (int i = 0; i < 4; ++i) { const f32x4 ga = *(const f32x4*)(gn + 8 * i), gb = *(const f32x4*)(gn + 8 * i + 4);
            const v4u o = {pk2(v[8 * i] * rs * ga.x, v[8 * i + 1] * rs * ga.y), pk2(v[8 * i + 2] * rs * ga.z, v[8 * i + 3] * rs * ga.w), pk2(v[8 * i + 4] * rs * gb.x, v[8 * i + 5] * rs * gb.y), pk2(v[8 * i + 6] * rs * gb.z, v[8 * i + 7] * rs * gb.w)};
            *(LAS v4u*)(Vl + (s >> 6) * 16384 + att::v_st<4>(s & 63, d0 + 8 * i)) = o; }
    }
    __syncthreads();
    const int wt = wid >> 1, wd = wid & 1;
    f32x16 acc0 = f32x16{}, acc1 = f32x16{};
    const int vb = (int)(unsigned)(uintptr_t)Vl + att::v_rd_base(lane);
    for (int sb = 0; sb <= (wt >> 1); ++sb) {
        const LAS unsigned short* wr_ = Wl + (32 * wt + r32) * LP + 64 * sb + 8 * hi;
        const bf16x8 pa0 = *(const LAS bf16x8*)(wr_), pa1 = *(const LAS bf16x8*)(wr_ + 16), pa2 = *(const LAS bf16x8*)(wr_ + 32), pa3 = *(const LAS bf16x8*)(wr_ + 48);
        if (wd == 0) { att::pv_one<4, 0, false>(acc0, vb + sb * 16384, pa0, pa1, pa2, pa3); att::pv_one<4, 1, false>(acc1, vb + sb * 16384, pa0, pa1, pa2, pa3); }
        else         { att::pv_one<4, 2, false>(acc0, vb + sb * 16384, pa0, pa1, pa2, pa3); att::pv_one<4, 3, false>(acc1, vb + sb * 16384, pa0, pa1, pa2, pa3); }
    }
    const float* bsp = F.a->in[10] + g * 128;
#pragma unroll
    for (int r = 0; r < 16; ++r) { const int t = 32 * wt + att::crow(r, hi); const float bs = bsp[t];
        St[t * LP + 64 * wd + r32] = (unsigned short)f2bf(acc0[r] + bs); St[t * LP + 64 * wd + 32 + r32] = (unsigned short)f2bf(acc1[r] + bs); }
    __syncthreads();
#pragma unroll
    for (int i = 0; i < 4; ++i) { const int ch = tid + 512 * i, t = ch >> 4, dc = (ch & 15) * 8;
        const v4u m = *(const LAS v4u*)(St + t * LP + dc); const v4u u = *(const v4u*)(P + (row0 + t) * PW + 1536 + g * 128 + dc);
        const v4u o = {pk2(bflo(u.x) * bflo(m.x), bfhi(u.x) * bfhi(m.x)), pk2(bflo(u.y) * bflo(m.y), bfhi(u.y) * bfhi(m.y)), pk2(bflo(u.z) * bflo(m.z), bfhi(u.z) * bfhi(m.z)), pk2(bflo(u.w) * bflo(m.w), bfhi(u.w) * bfhi(m.w))};
        *(v4u*)(AG + (row0 + t) * D + 512 + g * 128 + dc) = o; }
    __syncthreads();
}
__device__ __forceinline__ void odd_glue_phase(Frame& F) {
    const int gw = F.vcu * NWAVES + F.wave, NGW = F.G * NWAVES, lane = F.lane;
    const bf16* P = (const bf16*)(F.ws + WS_P); const bf16* OD0 = (const bf16*)(F.ws + WS_OD); const bf16* OD1 = OD0 + (size_t)M * 512; bf16* CD = (bf16*)(F.ws + WS_AG);
    const float lam = expf(wave_sum(F.a->in[17][lane] * F.a->in[18][lane])) - expf(wave_sum(F.a->in[19][lane] * F.a->in[20][lane])) + LAM_INIT;
    const float* cw = F.a->in[16]; const float* sub = F.a->in[21];
    float w0[8], w1[8], w2[8], sg[8];
#pragma unroll
    for (int i = 0; i < 8; ++i) { w0[i] = cw[8 * lane + i]; w1[i] = cw[512 + 8 * lane + i]; w2[i] = cw[1024 + 8 * lane + i]; sg[i] = sub[(8 * lane + i) & 127] * (1.0f - LAM_INIT); }
    struct OBuf { v4u bg, x2, x1, x0, o0, o1; };
    auto oload = [&](OBuf& b, int m) { const int t = m & (SEQ - 1); const bf16* pr = P + (size_t)m * PW + 8 * lane;
        b.bg = *(const v4u*)pr; b.x2 = *(const v4u*)(pr + 512);
        b.x1 = *(const v4u*)(pr + 512 - (t >= 1 ? PW : 0)); b.x0 = *(const v4u*)(pr + 512 - (t >= 2 ? 2 * PW : 0));
        b.o0 = *(const v4u*)(OD0 + (size_t)m * 512 + 8 * lane); b.o1 = *(const v4u*)(OD1 + (size_t)m * 512 + 8 * lane); };
    auto oproc = [&](const OBuf& b, int m) {
        const int t = m & (SEQ - 1); const unsigned k1 = t >= 1 ? 0xffffffffu : 0u, k0 = t >= 2 ? 0xffffffffu : 0u;
        const unsigned bgw[4] = {b.bg.x, b.bg.y, b.bg.z, b.bg.w}, a2[4] = {b.x2.x, b.x2.y, b.x2.z, b.x2.w}, a1[4] = {b.x1.x & k1, b.x1.y & k1, b.x1.z & k1, b.x1.w & k1}, a0[4] = {b.x0.x & k0, b.x0.y & k0, b.x0.z & k0, b.x0.w & k0};
        unsigned oc[4];
#pragma unroll
        for (int i = 0; i < 4; ++i) {
            const float lo = bflo(bgw[i]) * (w0[2 * i] * bflo(a0[i]) + w1[2 * i] * bflo(a1[i]) + w2[2 * i] * bflo(a2[i]));
            const float hi = bfhi(bgw[i]) * (w0[2 * i + 1] * bfhi(a0[i]) + w1[2 * i + 1] * bfhi(a1[i]) + w2[2 * i + 1] * bfhi(a2[i]));
            oc[i] = pk2(lo, hi); }
        *(v4u*)(CD + (size_t)m * D + 8 * lane) = (v4u){oc[0], oc[1], oc[2], oc[3]};
        const unsigned p0[4] = {b.o0.x, b.o0.y, b.o0.z, b.o0.w}, p1[4] = {b.o1.x, b.o1.y, b.o1.z, b.o1.w};
        float dv[8]; float ss = 0.f;
#pragma unroll
        for (int i = 0; i < 4; ++i) { dv[2 * i] = bflo(p0[i]) - lam * bflo(p1[i]); dv[2 * i + 1] = bfhi(p0[i]) - lam * bfhi(p1[i]); ss += dv[2 * i] * dv[2 * i] + dv[2 * i + 1] * dv[2 * i + 1]; }
        ss += __shfl_xor(ss, 1); ss += __shfl_xor(ss, 2); ss += __shfl_xor(ss, 4); ss += __shfl_xor(ss, 8);
        const float rs = __builtin_amdgcn_rsqf(ss * (1.0f / 128.0f) + EPS);
        *(v4u*)(CD + (size_t)m * D + 512 + 8 * lane) = (v4u){pk2(dv[0] * rs * sg[0], dv[1] * rs * sg[1]), pk2(dv[2] * rs * sg[2], dv[3] * rs * sg[3]), pk2(dv[4] * rs * sg[4], dv[5] * rs * sg[5]), pk2(dv[6] * rs * sg[6], dv[7] * rs * sg[7])}; };
    ROWPIPE4(OBuf, M, oload, oproc);
}
__device__ __forceinline__ void load_row_bf16(const bf16* row, int lane, f32x4 (&v)[4]) {
    const GAS unsigned long long* p = (const GAS unsigned long long*)row + lane;
#pragma unroll
    for (int j = 0; j < 4; ++j) { const unsigned long long w = p[64 * j]; v[j] = (f32x4){bflo((unsigned)w), bfhi((unsigned)w), bflo((unsigned)(w >> 32)), bfhi((unsigned)(w >> 32))}; }
}
__device__ __forceinline__ void router_phase(Frame& F) {
    const int gw = F.vcu * NWAVES + F.wave, NGW = F.G * NWAVES, lane = F.lane;
    LAS float* wrl = (LAS float*)(F.lds);
    LAS int* rec_e = (LAS int*)(F.lds + 32768);
    LAS int* rec_r = rec_e + 512;
    LAS float* rec_w = (LAS float*)(rec_r + 512);
    LAS int* lcnt = (LAS int*)(rec_w + 1024); LAS int* lbase = lcnt + 8; LAS int* ltile = lbase + 8;
    { const float* Wr = F.a->in[23]; const float* gn = F.a->in[30] + D;
      for (int u = F.tid; u < 8 * 1024; u += NWAVES * 64) { const int k = u >> 3, e = u & 7; wrl[e * 1024 + k] = Wr[u] * gn[k]; }
      if (F.tid < 8) lcnt[F.tid] = 0; }
    __syncthreads();
    const bf16* X = (const bf16*)(F.ws + WS_XB); unsigned* cnt = (unsigned*)(F.ctl + CW_CNT);
    int* TOKP = (int*)(F.ws + WS_TOK + 512 * 1024); unsigned char* HG = F.ws + WS_HG; float* GATE = (float*)(F.ws + WS_GATE);
    const GAS f32x4* gr = (const GAS f32x4*)(F.a->in[30] + D) + lane;
    auto rload = [&](RowBf16& b, int m) { const GAS unsigned long long* p = (const GAS unsigned long long*)(X + (size_t)m * D) + lane;
#pragma unroll
        for (int j = 0; j < 4; ++j) b.w[j] = p[64 * j]; };
    auto rproc = [&](const RowBf16& b, int m) {
        f32x4 v[4]; float s = 0.f;
#pragma unroll
        for (int j = 0; j < 4; ++j) { v[j] = (f32x4){bflo((unsigned)b.w[j]), bfhi((unsigned)b.w[j]), bflo((unsigned)(b.w[j] >> 32)), bfhi((unsigned)(b.w[j] >> 32))};
            s += (v[j].x * v[j].x + v[j].y * v[j].y) + (v[j].z * v[j].z + v[j].w * v[j].w); }
        const float rs = __builtin_amdgcn_rsqf(wave_sum(s) * (1.0f / D) + EPS);
        float lg[8];
#pragma unroll
        for (int e = 0; e < 8; ++e) { float a = 0.f;
#pragma unroll
            for (int j = 0; j < 4; ++j) { const f32x4 w = *(const LAS f32x4*)(wrl + e * 1024 + 4 * lane + 256 * j); a += (v[j].x * w.x + v[j].y * w.y) + (v[j].z * w.z + v[j].w * w.w); }
            lg[e] = wave_sum(a) * rs; }
        int i1 = 0; float v1 = lg[0];
#pragma unroll
        for (int e = 1; e < 8; ++e) if (lg[e] > v1) { v1 = lg[e]; i1 = e; }
        int i2 = -1; float v2 = -INFINITY;
#pragma unroll
        for (int e = 0; e < 8; ++e) if (e != i1 && lg[e] > v2) { v2 = lg[e]; i2 = e; }
        const float w1 = 1.0f / (1.0f + expf(v2 - v1));
        if (lane == 0) { const int k = (m - gw) / NGW, ri = F.wave * 64 + k;
            const int r1 = __hip_atomic_fetch_add(lcnt + i1, 1, __ATOMIC_RELAXED, __HIP_MEMORY_SCOPE_WORKGROUP), r2 = __hip_atomic_fetch_add(lcnt + i2, 1, __ATOMIC_RELAXED, __HIP_MEMORY_SCOPE_WORKGROUP);
            rec_e[ri] = i1 | (i2 << 8); rec_r[ri] = r1 | (r2 << 16); rec_w[2 * ri] = w1; rec_w[2 * ri + 1] = rs; } };
    const bool keep8 = (NGW * 8 == M);
    RowBf16 r8[8];
    if (keep8) {
#pragma unroll
        for (int k = 0; k < 8; ++k) rload(r8[k], gw + k * NGW);
#pragma unroll
        for (int k = 0; k < 8; ++k) rproc(r8[k], gw + k * NGW);
    } else ROWPIPE(RowBf16, M, rload, rproc);
    __syncthreads();
    if (F.tid < 8) { const int e = F.tid, n = lcnt[e]; unsigned bs = 0u;
        if (n > 0) { bs = __hip_atomic_fetch_add(cnt + e, (unsigned)n, RLX_AGENT);
            for (unsigned sl = (bs + 255u) & ~255u; sl < bs + (unsigned)n; sl += 256u) { const unsigned t = __hip_atomic_fetch_add(F.ctl + CW_NT, 1u, RLX_AGENT);
                __hip_atomic_store(F.ctl + CW_TEXP + t, (unsigned)e, RLX_AGENT); __hip_atomic_store(F.ctl + CW_TID + e * 64 + (int)(sl >> 8), t + 1u, RLX_AGENT); } }
        lbase[e] = (int)bs; }
    __syncthreads();
    if (F.tid < 16) { const int e = F.tid >> 1, n = lcnt[e]; int tv = 0;
        if (n > 0) { const unsigned bs = (unsigned)lbase[e], sl = (F.tid & 1) ? bs + (unsigned)n - 1u : bs; gu32* tp = F.ctl + CW_TID + e * 64 + (int)(sl >> 8); unsigned t, k = 0u;
            while ((t = __hip_atomic_load(tp, RLX_AGENT)) == 0u) { __builtin_amdgcn_s_sleep(1); if (++k > (1u << 16)) { t = 1u; break; } }
            tv = (int)(t - 1u); }
        ltile[F.tid] = tv; }
    __syncthreads();
    f32x4 g4[4];
#pragma unroll
    for (int j = 0; j < 4; ++j) g4[j] = gr[64 * j];
    auto wproc = [&](const RowBf16& b, int m) {
        const int k = (m - gw) / NGW, ri = F.wave * 64 + k;
        const int ee = rec_e[ri], rr = rec_r[ri]; const float w1 = rec_w[2 * ri], rs = rec_w[2 * ri + 1];
        const int e1 = ee & 255, e2 = ee >> 8; const unsigned s1 = (unsigned)(lbase[e1] + (rr & 0xffff)), s2 = (unsigned)(lbase[e2] + (rr >> 16));
        const int t1 = ltile[2 * e1 + (((s1 >> 8) != ((unsigned)lbase[e1] >> 8)) ? 1 : 0)], t2 = ltile[2 * e2 + (((s2 >> 8) != ((unsigned)lbase[e2] >> 8)) ? 1 : 0)];
        const int p1 = __builtin_amdgcn_readfirstlane(t1 * 256 + (int)(s1 & 255u)), p2 = __builtin_amdgcn_readfirstlane(t2 * 256 + (int)(s2 & 255u));
        if (lane == 0) { GATE[p1] = w1; GATE[p2] = 1.0f - w1; *(int2*)(TOKP + (size_t)m * 2) = make_int2(p1, p2); }
        GAS unsigned* o1 = (GAS unsigned*)(HG + (size_t)p1 * D) + lane; GAS unsigned* o2 = (GAS unsigned*)(HG + (size_t)p2 * D) + lane;
#pragma unroll
        for (int j = 0; j < 4; ++j) { const f32x4 g = g4[j];
            const unsigned w = pk4_fp8(bflo((unsigned)b.w[j]) * rs * g.x, bfhi((unsigned)b.w[j]) * rs * g.y, bflo((unsigned)(b.w[j] >> 32)) * rs * g.z, bfhi((unsigned)(b.w[j] >> 32)) * rs * g.w);
            o1[64 * j] = w; o2[64 * j] = w; } };
    if (keep8) {
#pragma unroll
        for (int k = 0; k < 8; ++k) wproc(r8[k], gw + k * NGW);
    } else ROWPIPE(RowBf16, M, rload, wproc);
}
__device__ __forceinline__ int moe_base(const unsigned* cnt, int e) {
    int b = 0;
#pragma unroll
    for (int j = 0; j < 8; ++j) b += (j < e) ? (int)((cnt[j] + 255u) >> 8) : 0;
    return b * 256;
}
__device__ __forceinline__ void final_phase(Frame& F) {
    const int gw = F.vcu * NWAVES + F.wave, NGW = F.G * NWAVES, lane = F.lane;
    const bf16* X = (const bf16*)(F.ws + WS_XB); float* OUT = F.out; const int* TOKP = (const int*)(F.ws + WS_TOK + 512 * 1024); const bf16* Y = (const bf16*)(F.ws + WS_Y); const float* gn = F.a->in[4];
    struct FBuf { unsigned long long x[4], a[4], b[4]; };
    const bf16* YP = (const bf16*)(F.ws + WS_OD);
    auto yfast = [&](unsigned long long (&d)[4], int p) { const GAS unsigned long long* y = (const GAS unsigned long long*)(Y + (size_t)(p & 32767) * D) + lane;
#pragma unroll
        for (int j = 0; j < 4; ++j) d[j] = y[64 * j]; };
    auto yslow = [&](unsigned long long (&d)[4], int p) {
        if (p >= 32768) { unsigned long long w[7][4];
#pragma unroll
            for (int sl = 0; sl < 7; ++sl) { const GAS unsigned long long* y = (const GAS unsigned long long*)(YP + ((size_t)sl * 2048 + (p - 32768)) * D) + lane;
#pragma unroll
                for (int j = 0; j < 4; ++j) w[sl][j] = y[64 * j]; }
#pragma unroll
            for (int j = 0; j < 4; ++j) { float a0 = 0.f, a1 = 0.f, a2 = 0.f, a3 = 0.f;
#pragma unroll
                for (int sl = 0; sl < 7; ++sl) { a0 += bflo((unsigned)w[sl][j]); a1 += bfhi((unsigned)w[sl][j]); a2 += bflo((unsigned)(w[sl][j] >> 32)); a3 += bfhi((unsigned)(w[sl][j] >> 32)); }
                d[j] = (unsigned long long)pk2(a0, a1) | ((unsigned long long)pk2(a2, a3) << 32); } } };
    const GAS f32x4* gr = (const GAS f32x4*)gn + lane;
    int2 ppv = make_int2(0, 0);
    { const int mk = gw + lane * NGW; if (mk < M) ppv = *(const int2*)(TOKP + (size_t)mk * 2); }
    auto fload = [&](FBuf& b, int m) { const int k = (m - gw) / NGW; const int p1 = __builtin_amdgcn_readlane(ppv.x, k), p2 = __builtin_amdgcn_readlane(ppv.y, k);
        const GAS unsigned long long* px = (const GAS unsigned long long*)(X + (size_t)m * D) + lane;
#pragma unroll
        for (int j = 0; j < 4; ++j) b.x[j] = px[64 * j];
        yfast(b.a, p1); yfast(b.b, p2); };
    f32x4 g4[4];
#pragma unroll
    for (int j = 0; j < 4; ++j) g4[j] = gr[64 * j];
    auto fproc = [&](FBuf& b, int m) {
        { const int k = (m - gw) / NGW; yslow(b.a, __builtin_amdgcn_readlane(ppv.x, k)); yslow(b.b, __builtin_amdgcn_readlane(ppv.y, k)); }
        GAS f32x4* xr = (GAS f32x4*)(OUT + (size_t)m * D) + lane;
        f32x4 v[4]; float s = 0.f;
#pragma unroll
        for (int j = 0; j < 4; ++j) { const unsigned long long x = b.x[j], a = b.a[j], c = b.b[j];
            v[j].x = bflo((unsigned)x) + bflo((unsigned)a) + bflo((unsigned)c); v[j].y = bfhi((unsigned)x) + bfhi((unsigned)a) + bfhi((unsigned)c);
            v[j].z = bflo((unsigned)(x >> 32)) + bflo((unsigned)(a >> 32)) + bflo((unsigned)(c >> 32)); v[j].w = bfhi((unsigned)(x >> 32)) + bfhi((unsigned)(a >> 32)) + bfhi((unsigned)(c >> 32));
            s += (v[j].x * v[j].x + v[j].y * v[j].y) + (v[j].z * v[j].z + v[j].w * v[j].w); }
        const float rs = __builtin_amdgcn_rsqf(wave_sum(s) * (1.0f / D) + EPS);
#pragma unroll
        for (int j = 0; j < 4; ++j) { const f32x4 g = g4[j]; __builtin_nontemporal_store((f32x4){v[j].x * rs * g.x, v[j].y * rs * g.y, v[j].z * rs * g.z, v[j].w * rs * g.w}, (f32x4*)xr + 64 * j); } };
    ROWPIPE4(FBuf, M, fload, fproc);
}
__device__ __forceinline__ void fox_sgu_phase(Frame& F) {
    using G = att::Geo<64, 64>;
    LAS char* lds = (LAS char*)F.lds;
    const bf16* P = (const bf16*)(F.ws + WS_P); bf16* AG = (bf16*)(F.ws + WS_AG); const float* C2 = (const float*)(F.ws + WS_C2);
    for (int pr = F.vcu; pr < 256; pr += F.G) {
        const int bh = pr >> 2, s = pr & 3, b = bh >> 3, h = bh & 7;
        LAS v4u* tab = (LAS v4u*)(lds + fx::LDS_TAB);
        int tid_o = F.tid; asm volatile("" : "+v"(tid_o));
        for (int u = tid_o; u < SEQ / 4; u += NWAVES * 64) { const f32x4 c = ((const f32x4*)(C2 + (size_t)bh * SEQ))[u]; v4u e;
            { const unsigned h_ = f2bf(-c.x); e.x = h_ | (f2bf(-c.x - bf2f((unsigned short)h_)) << 16); } { const unsigned h_ = f2bf(-c.y); e.y = h_ | (f2bf(-c.y - bf2f((unsigned short)h_)) << 16); }
            { const unsigned h_ = f2bf(-c.z); e.z = h_ | (f2bf(-c.z - bf2f((unsigned short)h_)) << 16); } { const unsigned h_ = f2bf(-c.w); e.w = h_ | (f2bf(-c.w - bf2f((unsigned short)h_)) << 16); }
            tab[u] = e; }
        __syncthreads();
        for (int k = 0; k < 2; ++k) { const int qb = (k == 0) ? 7 - s : s; const size_t row0 = (size_t)b * SEQ + (size_t)qb * 256, kv0 = (size_t)b * SEQ * PW;
            fx::fox_unit<PW, PW, D, FOX_THR>(P + row0 * PW + h * 64, P + kv0 + 512 + h * 64, P + kv0 + 1024 + h * 64, AG + row0 * D + h * 64, qb * 256, lds); }
    }
    Frame F2 = F; asm volatile("" : "+v"(F2.tid), "+v"(F2.lane));
    for (int u = F.vcu; u < 512; u += F.G) sgu_unit(F2, u >> 6, (u >> 2) & 15, u & 3);
}
__device__ __forceinline__ void diff_phase(Frame& F) {
    using G = attd::Geo<64, 128>;
    LAS char* lds = (LAS char*)F.lds;
    const bf16* P = (const bf16*)(F.ws + WS_P); bf16* OD = (bf16*)(F.ws + WS_OD); const float* RB = F.a->in[2];
    for (int pr = F.vcu; pr < 256; pr += F.G) {
        const int bhi = pr >> 2, s = pr & 3, b = bhi >> 3, h = (bhi >> 1) & 3, i = bhi & 1;
        LAS float* tab = (LAS float*)(lds + G::TAB_OFF);
        if (F.tid < 128) { const int d = F.tid; int bk = d;
            if (d >= 16) { bk = 16 + (int)(logf((float)d * (1.0f / 16.0f)) / logf(8.0f) * 16.0f); bk = bk > 31 ? 31 : bk; }
            tab[d] = RB[bk * 4 + h] * LOG2E; }
        __syncthreads();
        for (int u = F.tid; u < 4 * 520; u += NWAVES * 64) { const int c = u / 520, j = u - c * 520, d = j + c - 256;
            ((LAS float*)(lds + G::EXT_OFF))[c * 520 + j] = d < 0 ? -INFINITY : tab[d > 127 ? 127 : d]; }
        __syncthreads();
        for (int k = 0; k < 2; ++k) { const int qb = (k == 0) ? 7 - s : s; const size_t row0 = (size_t)b * SEQ + (size_t)qb * 256, kv0 = (size_t)b * SEQ * PW;
            attd::attn_unit<64, 128, 2, PW, PW, 512>(P + row0 * PW + 1024 + h * 128 + i * 64, P + kv0 + 1536 + h * 128 + i * 64, P + kv0 + 2048 + h * 128, OD + (size_t)i * M * 512 + row0 * 512 + h * 128, 4 * (qb + 1), qb * 256, lds); }
    }
}
__device__ __forceinline__ void xattn_phase(Frame& F, int layer) {
    LAS char* lds = (LAS char*)F.lds;
    const bf16* QX = (const bf16*)(F.ws + WS_QX); const bf16* KVM = (const bf16*)(F.ws + WS_KVM); bf16* OX = (bf16*)(F.ws + WS_OX);
    for (int u = F.vcu; u < 256; u += F.G) { const int b = u >> 5, h = (u >> 3) & 3, qb = u & 7; const size_t row0 = (size_t)b * SEQ + (size_t)qb * 256;
        const bf16* kp = KVM + (size_t)b * MEMLEN * 2048 + layer * 1024 + h * 128;
        attd::attn_unit<128, 128, 0, 512, 2048, 512>(QX + row0 * 512 + h * 128, kp, kp + 512, OX + row0 * 512 + h * 128, 4, 0, lds); }
}

constexpr int N_PHASES = 21;
__global__ void __launch_bounds__(NWAVES * 64, 2) hyb_fwd(Args args) {
    extern __shared__ __attribute__((aligned(16))) unsigned char lds[];
    Frame F;
    F.lds = (LAS unsigned char*)lds;
    F.MISC = (volatile LAS unsigned*)(F.lds + MISC_OFF);
    F.tid = threadIdx.x; F.lane = F.tid & 63; F.wave = __builtin_amdgcn_readfirstlane(F.tid >> 6);
    F.G = gridDim.x; { const int bx = blockIdx.x; F.vcu = (F.G % 8 == 0) ? (bx % 8) * (F.G / 8) + bx / 8 : bx; }
    F.a = &args;
    F.out = args.out; F.ws = args.ws; F.ctl = (gu32*)(args.ws + WS_CTL);
    unsigned char* ws = args.ws;
    for (int u = F.tid; u < (LDS_BYTES - LDSCTL_OFF) / 4; u += NWAVES * 64) ((LAS unsigned*)(F.lds + LDSCTL_OFF))[u] = 0u;
    __syncthreads();
    XcdBarrier bar; bar.bar = (unsigned*)(F.ctl + CW_BAR); bar.x = 0; bar.st = nullptr;
    if (!MK_PER_PHASE) bar = xcd_barrier_post((unsigned*)(F.ctl + CW_BAR), F.MISC + 8);
#define GRID_BAR() do { if (!MK_PER_PHASE) xcd_barrier(bar); } while (0)
    const int lo = args.ph_lo, hi = args.ph_hi;
#ifndef PH_MASK
#define PH_MASK 0x1fffff
#endif
#define IN(k) (((PH_MASK >> (k)) & 1) && lo <= (k) && (k) < hi)
#ifndef DUP_MASK
#define DUP_MASK 0
#endif
#define DUP(k) (((DUP_MASK >> (k)) & 1) ? 2 : 1)
#define SEAM(k) do { if (IN(k) && IN((k) + 1)) GRID_BAR(); } while (0)
    const int bx = (int)blockIdx.x, G = F.G;
    bf16* XB = (bf16*)(ws + WS_XB); float* SSQ = (float*)(ws + WS_SSQ); bf16* P = (bf16*)(ws + WS_P); bf16* AG = (bf16*)(ws + WS_AG);
    bf16* QX = (bf16*)(ws + WS_QX); bf16* OX = (bf16*)(ws + WS_OX); bf16* ACT = (bf16*)(ws + WS_ACT);

    if (IN(0)) p0_prologue(F);
    SEAM(0);
    if (IN(1)) {
        if (F.wave == 0) for (int sq = G - 1 - bx; sq < 64; sq += G) cumsum_seq(F, sq);
        { pg8::Gemm g{XB, (const bf16*)(ws + WS_W_EVIN), M, 2560, D}; pg8::StaticOrder S; S.init(M, 2560, G, bx);
          pg8::EpiIn<0> E{P, SSQ}; pg8::gemm_phase<pg8::EpiIn<0>, pg8::StaticOrder, true, true>(F.lds + RING_OFF, g, S, E); }
        { pg8::Gemm g{(const bf16*)(ws + WS_MEMN), (const bf16*)(ws + WS_W_MKV), MMEM, 2048, D}; pg8::StaticOrder S; S.init(MMEM, 2048, G, (bx + G / 2) % G);
          pg8::EpiPlain<false> E{(bf16*)(ws + WS_KVM), 2048, nullptr}; pg8::gemm_phase<pg8::EpiPlain<false>, pg8::StaticOrder, true, true>(F.lds + RING_OFF, g, S, E); }
    }
    if (IN(1)) m13_slot(F, 0, 192);
    SEAM(1);
    if (IN(2)) fox_sgu_phase(F);
    SEAM(2);
    if (IN(3)) { pg8::Gemm g{AG, (const bf16*)(ws + WS_W_EVOUT), M, D, D}; pg8::StaticOrder S; S.init(M, D, G, bx);
        pg8::EpiResid<false> E{XB, SSQ, nullptr, 1.0f}; pg8::gemm_phase<pg8::EpiResid<false>, pg8::StaticOrder, true, true>(F.lds + RING_OFF, g, S, E); }
    SEAM(3);
    if (IN(4)) { pg8::Gemm g{XB, (const bf16*)(ws + WS_W_XQ), M, XW, D}; pg8::StaticOrder S; S.init(M, XW, G, bx);
        pg8::EpiPlain<true> E{QX, XW, SSQ}; pg8::gemm_phase<pg8::EpiPlain<true>, pg8::StaticOrder, true, true>(F.lds + RING_OFF, g, S, E); }
    if (IN(4)) m13_slot(F, 64 * M13_Q, 128);
    SEAM(4);
    if (IN(5)) xattn_phase(F, 0);
    SEAM(5);
#if FFN_FP8 == 1
    if (IN(6)) { pg8::Gemm g{OX, (const bf16*)(ws + WS_W_XO), M, D, XW}; pg8::StaticOrder S; S.init(M, D, G, bx);
        pg8::EpiResid<true> E{XB, SSQ, ws + WS_XB8, 1.0f}; pg8::gemm_phase<pg8::EpiResid<true>, pg8::StaticOrder, true, true>(F.lds + RING_OFF, g, S, E); }
#else
    if (IN(6)) { pg8::Gemm g{OX, (const bf16*)(ws + WS_W_XO), M, D, XW}; pg8::StaticOrder S; S.init(M, D, G, bx);
        pg8::EpiResid<false> E{XB, SSQ, nullptr, 1.0f}; pg8::gemm_phase<pg8::EpiResid<false>, pg8::StaticOrder, true, true>(F.lds + RING_OFF, g, S, E); }
#endif
    SEAM(6);
#if FFN_FP8 == 2
    if (IN(7)) { pg8::Gemm g{XB, (const bf16*)(ws + WS_W_F13), M, 2 * FF, D}; pg8::StaticOrder S; S.init(M, 2 * FF, G, bx);
        pg8::EpiSwigluF8<22, true> E{ws + WS_ACT, FF, 1.0f, SSQ}; pg8::gemm_phase<pg8::EpiSwigluF8<22, true>, pg8::StaticOrder, true, true>(F.lds + RING_OFF, g, S, E); }
#elif FFN_FP8 == 1
    if (IN(7)) { pg8::Gemm g{(const bf16*)(ws + WS_XB8), (const bf16*)(ws + WS_W_F13), M, 2 * FF, D}; pg8::StaticOrder S; S.init(M, 2 * FF, G, bx);
        pg8::EpiSwigluF8<22, true> E{ws + WS_ACT, FF, 1.0f / 64.0f, SSQ}; pg8::gemm_phase<pg8::EpiSwigluF8<22, true>, pg8::StaticOrder, true, true, true>(F.lds + RING_OFF, g, S, E); }
#else
    if (IN(7)) { pg8::Gemm g{XB, (const bf16*)(ws + WS_W_F13), M, 2 * FF, D}; pg8::StaticOrder S; S.init(M, 2 * FF, G, bx);
        pg8::EpiSwiglu<22> E{ACT, FF, SSQ}; pg8::gemm_phase<pg8::EpiSwiglu<22>, pg8::StaticOrder, true, true>(F.lds + RING_OFF, g, S, E); }
#endif
    if (IN(7)) m13_slot(F, (64 + 128) * M13_Q, 128);
    SEAM(7);
#if FFN_FP8 >= 1
    if (IN(8)) { pg8::Gemm g{(const bf16*)(ws + WS_ACT), (const bf16*)(ws + WS_W_F2), M, D, FF}; pg8::StaticOrder S; S.init(M, D, G, bx);
        pg8::EpiResid<false> E{XB, SSQ, nullptr, 1.0f / 128.0f}; pg8::gemm_phase<pg8::EpiResid<false>, pg8::StaticOrder, true, true, true>(F.lds + RING_OFF, g, S, E); }
#else
    if (IN(8)) { pg8::Gemm g{ACT, (const bf16*)(ws + WS_W_F2), M, D, FF}; pg8::StaticOrder S; S.init(M, D, G, bx);
        pg8::EpiResid<false> E{XB, SSQ, nullptr, 1.0f}; pg8::gemm_phase<pg8::EpiResid<false>, pg8::StaticOrder, true, true>(F.lds + RING_OFF, g, S, E); }
#endif
    SEAM(8);
    if (IN(9)) { pg8::Gemm g{XB, (const bf16*)(ws + WS_W_ODIN), M, 3072, D}; pg8::StaticOrder S; S.init(M, 3072, G, bx);
        pg8::EpiIn<1> E{P, SSQ}; pg8::gemm_phase<pg8::EpiIn<1>, pg8::StaticOrder, true, true>(F.lds + RING_OFF, g, S, E); }
    SEAM(9);
    if (IN(10)) diff_phase(F);
    SEAM(10);
    if (IN(11)) odd_glue_phase(F);
    SEAM(11);
    if (IN(12)) { pg8::Gemm g{AG, (const bf16*)(ws + WS_W_ODOUT), M, D, D}; pg8::StaticOrder S; S.init(M, D, G, bx);
        pg8::EpiResid<false> E{XB, SSQ, nullptr, 1.0f}; pg8::gemm_phase<pg8::EpiResid<false>, pg8::StaticOrder, true, true>(F.lds + RING_OFF, g, S, E); }
    SEAM(12);
    if (IN(13)) { pg8::Gemm g{XB, (const bf16*)(ws + WS_W_XQ) + (size_t)XW * D, M, XW, D}; pg8::StaticOrder S; S.init(M, XW, G, bx);
        pg8::EpiPlain<true> E{QX, XW, SSQ}; pg8::gemm_phase<pg8::EpiPlain<true>, pg8::StaticOrder, true, true>(F.lds + RING_OFF, g, S, E); }
    if (IN(13)) m13_slot(F, (64 + 256) * M13_Q, 128);
    SEAM(13);
    if (IN(14)) xattn_phase(F, 1);
    SEAM(14);
    if (IN(15)) { pg8::Gemm g{OX, (const bf16*)(ws + WS_W_XO) + (size_t)D * XW, M, D, XW}; pg8::StaticOrder S; S.init(M, D, G, bx);
        pg8::EpiResid<false> E{XB, SSQ, nullptr, 1.0f}; pg8::gemm_phase<pg8::EpiResid<false>, pg8::StaticOrder, true, true>(F.lds + RING_OFF, g, S, E); }
    SEAM(15);
    if (IN(16)) router_phase(F);
    SEAM(16);
    if (IN(18)) { const int T = __builtin_amdgcn_readfirstlane((int)F.ctl[CW_NT]); LAS int* texp = (LAS int*)(F.lds + TEXP_LDS);
        if (F.tid < 160) texp[F.tid] = (F.tid < T) ? (int)F.ctl[CW_TEXP + F.tid] : 0;
        __syncthreads();
        pg8::Gemm g{(const bf16*)(ws + WS_HG), (const bf16*)(ws + WS_W_M13), PAIR_ROWS, NE * 2 * FE, D}; pg8::MoeOrder S; S.init(T, texp, 28, G, bx);
        pg8::EpiSwigluF8<28, false> E{ws + WS_ACT, FE, 1.0f / 64.0f, nullptr}; pg8::gemm_phase<pg8::EpiSwigluF8<28, false>, pg8::MoeOrder, true, true, true>(F.lds + RING_OFF, g, S, E); }
    SEAM(18);
    if (IN(19)) { const int T = __builtin_amdgcn_readfirstlane((int)F.ctl[CW_NT]); LAS int* texp = (LAS int*)(F.lds + TEXP_LDS);
        if (F.tid < 160) texp[F.tid] = (F.tid < T) ? (int)F.ctl[CW_TEXP + F.tid] : 0;
        __syncthreads();
        pg8::Gemm g{(const bf16*)(ws + WS_ACT), (const bf16*)(ws + WS_W_M2), PAIR_ROWS, NE * D, FE}; pg8::MoeSplitOrder S; S.init(T, texp, G, bx, FE / 128);
        pg8::EpiY E{(bf16*)(ws + WS_Y), (const float*)(ws + WS_GATE), 1.0f / 128.0f, (bf16*)(ws + WS_OD)}; pg8::gemm_phase<pg8::EpiY, pg8::MoeSplitOrder, true, true, true>(F.lds + RING_OFF, g, S, E); }
    SEAM(19);
    if (IN(20)) final_phase(F);
#undef IN
#undef SEAM
#undef GRID_BAR
}

extern "C" void kernel_launch(void* const* d_in, const int* in_sizes, int n_in, void* d_out, int out_size, void* d_ws, size_t ws_size, hipStream_t stream) {
    static int grid = 0;
    if (grid == 0) {
        if (n_in != 31 || in_sizes[0] != M * D || out_size != M * D || ws_size < WS_END) { fprintf(stderr, "kernel_launch: built for 31 inputs, x/out of %d floats, >= %zu bytes of workspace; got n_in %d, in0 %d, out %d, ws %zu; nothing launched\n", M * D, (size_t)WS_END, n_in, n_in > 0 ? in_sizes[0] : -1, out_size, ws_size); grid = -1; return; }
        int dev = 0, cus = 0, per_cu = 0;
        if (hipGetDevice(&dev) != hipSuccess || hipDeviceGetAttribute(&cus, hipDeviceAttributeMultiprocessorCount, dev) != hipSuccess) { fprintf(stderr, "kernel_launch: hipGetDevice / hipDeviceGetAttribute failed\n"); grid = -1; return; }
        if (hipFuncSetAttribute((const void*)hyb_fwd, hipFuncAttributeMaxDynamicSharedMemorySize, LDS_BYTES) != hipSuccess) { fprintf(stderr, "kernel_launch: hipFuncSetAttribute failed\n"); grid = -1; return; }
        if (hipOccupancyMaxActiveBlocksPerMultiprocessor(&per_cu, (const void*)hyb_fwd, NWAVES * 64, LDS_BYTES) != hipSuccess || per_cu < 1)
            fprintf(stderr, "kernel_launch: note: occupancy query reports %d workgroups per CU\n", per_cu);
        (void)hipGetLastError();
        grid = cus;
    }
    if (grid < 0) return;
    if (hipMemsetAsync((char*)d_ws + WS_CTL, 0, CTL_ZERO_BYTES, stream) != hipSuccess) { fprintf(stderr, "kernel_launch: hipMemsetAsync failed\n"); return; }
    Args a{};
    for (int i = 0; i < 31; ++i) a.in[i] = (const float*)d_in[i];
    a.out = (float*)d_out; a.ws = (unsigned char*)d_ws;
#if MK_PER_PHASE
    for (int p = 0; p < N_PHASES; ++p) { a.ph_lo = p; a.ph_hi = p + 1; hipLaunchKernelGGL(hyb_fwd, dim3(grid), dim3(NWAVES * 64), LDS_BYTES, stream, a); }
#else
    a.ph_lo = 0; a.ph_hi = N_PHASES;
    hipLaunchKernelGGL(hyb_fwd, dim3(grid), dim3(NWAVES * 64), LDS_BYTES, stream, a);
#endif
    const hipError_t le = hipPeekAtLastError();
    if (le != hipSuccess) fprintf(stderr, "kernel_launch: launch failed: %s (grid %d)\n", hipGetErrorName(le), grid);
}
```

```cpp
#include <hip/hip_runtime.h>
#include <cstdio>
#include <cstdint>
namespace pg8 {
#define PG8_LAS __attribute__((address_space(3)))
typedef unsigned short bf16_t;
typedef short bf16x8 __attribute__((ext_vector_type(8)));
typedef float f32x4 __attribute__((ext_vector_type(4)));
typedef unsigned u32x4 __attribute__((ext_vector_type(4)));
constexpr int BM = 256, BK = 64, HALF = 128, HTB = HALF * BK * 2  , STAGE_BYTES = 8 * HTB, NXCD = 8, WGM = 8;

__host__ __device__ __forceinline__ int lds_byte(int r, int c) { const int st = (r >> 4) * 2 + (c >> 5), rr = r & 15, cc = c & 31, ob = rr * 64 + cc * 2; return st * 1024 + (ob ^ (((ob >> 9) & 1) << 5)); }
__host__ __device__ __forceinline__ void stage_rc(int b, int& R, int& C) { const int st = b / 1024, sb = b % 1024, swz = sb ^ (((sb >> 9) & 1) << 5); R = (st >> 1) * 16 + swz / 64; C = (st & 1) * 32 + (swz % 64) / 2; }
__host__ __device__ __forceinline__ int perm32(int rho) { const int n = rho >> 4, i = rho & 15; return 8 * (i >> 2) + 4 * n + (i & 3); }

struct Unit { int pm, pn; int kofs = 0, nt = 0; };
struct Gemm { const bf16_t* A; const bf16_t* Bt; int M, N, K; };

struct StaticOrder {
    static constexpr bool VARK = false;
    int nM, nN, nwg, G, c;
    __host__ __device__ void init(int M, int N, int G_, int c_) { nM = M / BM; nN = N / BM; nwg = nM * nN; G = G_; c = c_; }
    __host__ __device__ bool next(int i, Unit& u) const {
        const long L = (long)i * G + c; if (L >= nwg) return false;
        int wgid = (int)L; { const int q = nwg / NXCD, r = nwg % NXCD, xcd = wgid % NXCD, off = wgid / NXCD; wgid = (xcd < r ? xcd * (q + 1) : r * (q + 1) + (xcd - r) * q) + off; }
        const int nig = WGM * nN, gid = wgid / nig, fm = gid * WGM, gsz = (nM - fm) < WGM ? (nM - fm) : WGM;
        u.pm = fm + ((wgid % nig) % gsz); u.pn = (wgid % nig) / gsz; return true;
    }
    __device__ __forceinline__ void a_ready(const Unit&) const {}
    __device__ __forceinline__ void done(const Unit&) const {}
};


__device__ __forceinline__ unsigned cvt_pk_bf16(float lo, float hi) { unsigned r; asm volatile("v_cvt_pk_bf16_f32 %0, %1, %2" : "=v"(r) : "v"(lo), "v"(hi)); return r; }
typedef float f32x2 __attribute__((ext_vector_type(2)));

__device__ __forceinline__ float gelu_tanh(float x) {
    const float z = x * (0.7978845608f + 0.0356774081f * x * x);
    return x * __builtin_amdgcn_rcpf(1.0f + __builtin_amdgcn_exp2f(-2.8853900818f * z));
}
__device__ __forceinline__ float silu_f(float x) { return x * __builtin_amdgcn_rcpf(1.0f + __builtin_amdgcn_exp2f(-1.4426950409f * x)); }
__device__ __forceinline__ u32x4 pack8(const f32x4 v0, const f32x4 v1) { u32x4 w; w.x = cvt_pk_bf16(v0[0], v0[1]); w.y = cvt_pk_bf16(v0[2], v0[3]); w.z = cvt_pk_bf16(v1[0], v1[1]); w.w = cvt_pk_bf16(v1[2], v1[3]); return w; }
#ifndef EPI_WT
#define EPI_WT 1
#endif
__device__ __forceinline__ float sum_rows4(float v) {
    { const auto r = __builtin_amdgcn_permlane16_swap(__float_as_uint(v), __float_as_uint(v), false, false); v = __uint_as_float(r[0]) + __uint_as_float(r[1]); }
    { const auto r = __builtin_amdgcn_permlane32_swap(__float_as_uint(v), __float_as_uint(v), false, false); v = __uint_as_float(r[0]) + __uint_as_float(r[1]); }
    return v;
}
__device__ __forceinline__ unsigned dpp_x1(unsigned v) { return (unsigned)__builtin_amdgcn_mov_dpp((int)v, 0xB1, 0xF, 0xF, true); }
__device__ __forceinline__ void st_rows2(bf16_t* tp  , size_t ld, int fr, int fq, const u32x4 w0, const u32x4 w1) {
    const bool odd = fr & 1;
    const u32x4 send = {odd ? w0.x : w1.x, odd ? w0.y : w1.y, odd ? w0.z : w1.z, odd ? w0.w : w1.w};
    const u32x4 recv = {dpp_x1(send.x), dpp_x1(send.y), dpp_x1(send.z), dpp_x1(send.w)};
    const u32x4 a = {odd ? recv.x : w0.x, odd ? recv.y : w0.y, odd ? recv.z : w0.z, odd ? recv.w : w0.w}, b = {odd ? w1.x : recv.x, odd ? w1.y : recv.y, odd ? w1.z : recv.z, odd ? w1.w : recv.w};
    bf16_t* p = tp + (size_t)(fr & ~1) * ld + (odd ? 32 : 0) + 8 * fq;
#if EPI_WT
    asm volatile("global_store_dwordx4 %0, %1, off sc1\n\tglobal_store_dwordx4 %2, %3, off sc1\n\ts_nop 1" :: "v"(p), "v"(a), "v"(p + ld), "v"(b) : "memory");
#else
    *(u32x4*)p = a; *(u32x4*)(p + ld) = b;
#endif
}
__device__ __forceinline__ float rs_row(const float* ssq16, int row) {
    const f32x4* p = (const f32x4*)(ssq16 + (size_t)row * 16);
    const f32x4 a = p[0], b = p[1], c = p[2], d = p[3];
    const float s = (((a[0] + a[1]) + (a[2] + a[3])) + ((b[0] + b[1]) + (b[2] + b[3]))) + (((c[0] + c[1]) + (c[2] + c[3])) + ((d[0] + d[1]) + (d[2] + d[3])));
    return __builtin_amdgcn_rsqf(s * (1.0f / 1024.0f) + 1e-6f);
}
struct RsPre { f32x4 a, b; };
__device__ __forceinline__ void rs_issue(RsPre& r, const float* ssq16, int pm, int tid) { const f32x4* p = (const f32x4*)(ssq16 + (size_t)(pm * BM + (tid >> 1)) * 16 + (tid & 1) * 8); r.a = p[0]; r.b = p[1]; }
__device__ __forceinline__ void rs_finish(const RsPre& r, PG8_LAS float* tab, int tid) {
    float s = ((r.a[0] + r.a[1]) + (r.a[2] + r.a[3])) + ((r.b[0] + r.b[1]) + (r.b[2] + r.b[3]));
    s += __builtin_bit_cast(float, __builtin_amdgcn_mov_dpp(__builtin_bit_cast(int, s), 0xB1, 0xF, 0xF, true));
    if (!(tid & 1)) tab[tid >> 1] = __builtin_amdgcn_rsqf(s * (1.0f / 1024.0f) + 1e-6f);
}
template <int ODD> struct EpiIn {
    static constexpr bool PERM = true, AFTER_DRAIN = false, RS = true;
    static constexpr int PERMK = ODD ? 1 : 2;
    bf16_t* O; const float* ssq16;
    __device__ __forceinline__ void operator()(const f32x4 (&acc)[2][2][4][2], const Unit& u, int wr, int wc, int fr, int fq, const PG8_LAS float* rst) const {
        const int row0 = u.pm * BM + wr * 64 + fr, cw = wc * 32 + 8 * fq;
        int kind, colbase;
        if (!ODD) { kind = (u.pn >= 6) ? 1 : 0; colbase = u.pn * 256; }
        else { if (u.pn < 2) { kind = 0; colbase = u.pn * 256; } else if (u.pn < 6) { kind = 2; colbase = 512 + (u.pn - 2) * 128; } else { kind = 0; colbase = 1024 + (u.pn - 6) * 256; } }
#pragma unroll
        for (int ai = 0; ai < 2; ++ai)
#pragma unroll
            for (int m = 0; m < 4; ++m) {
                const int row = row0 + ai * HALF + m * 16; const float rs = rst[ai * HALF + wr * 64 + m * 16 + fr]; bf16_t* rowp = O + (size_t)row * 2560 + colbase + cw;
                if constexpr (PERMK == 2) { u32x4 w[2];
#pragma unroll
                    for (int bj = 0; bj < 2; ++bj) { f32x4 v0 = acc[ai][bj][m][0] * rs, v1 = acc[ai][bj][m][1] * rs;
                        if (kind == 1) {
#pragma unroll
                            for (int j = 0; j < 4; ++j) { v0[j] = gelu_tanh(v0[j]); v1[j] = gelu_tanh(v1[j]); } }
                        w[bj] = pack8(v0, v1); }
                    st_rows2(O + (size_t)(row - fr) * 2560 + colbase + 64 * wc, 2560, fr, fq, w[0], w[1]); }
                else if (kind == 2) { const f32x4 v0 = (acc[ai][0][m][0] * rs) * (acc[ai][1][m][0] * rs), v1 = (acc[ai][0][m][1] * rs) * (acc[ai][1][m][1] * rs); *(u32x4*)rowp = pack8(v0, v1); }
                else {
#pragma unroll
                    for (int bj = 0; bj < 2; ++bj) { f32x4 v0 = acc[ai][bj][m][0] * rs, v1 = acc[ai][bj][m][1] * rs;
                        if (kind == 1) {
#pragma unroll
                            for (int j = 0; j < 4; ++j) { v0[j] = gelu_tanh(v0[j]); v1[j] = gelu_tanh(v1[j]); } }
                        *(u32x4*)(rowp + bj * HALF) = pack8(v0, v1); } }
            }
    }
};
template <bool RS_> struct EpiPlain {
    static constexpr bool PERM = true, AFTER_DRAIN = false, RS = RS_;
    static constexpr int PERMK = 2;
    bf16_t* O; int ldc; const float* ssq16;
    __device__ __forceinline__ void operator()(const f32x4 (&acc)[2][2][4][2], const Unit& u, int wr, int wc, int fr, int fq, const PG8_LAS float* rst = nullptr) const {
        const int row0 = u.pm * BM + wr * 64 + fr, cw = u.pn * BM + wc * 32 + 8 * fq;
#pragma unroll
        for (int ai = 0; ai < 2; ++ai)
#pragma unroll
            for (int m = 0; m < 4; ++m) {
                const int row = row0 + ai * HALF + m * 16; float rs = 1.0f; if constexpr (RS_) rs = rst[ai * HALF + wr * 64 + m * 16 + fr]; bf16_t* rowp = O + (size_t)row * ldc + cw;
                (void)rowp; st_rows2(O + (size_t)(row - fr) * ldc + u.pn * BM + 64 * wc, (size_t)ldc, fr, fq, pack8(acc[ai][0][m][0] * rs, acc[ai][0][m][1] * rs), pack8(acc[ai][1][m][0] * rs, acc[ai][1][m][1] * rs));
            }
    }
};
template <int NPN> struct EpiSwiglu {
    static constexpr bool PERM = true, AFTER_DRAIN = false, RS = true;
    static constexpr int PERMK = 1;
    bf16_t* O; int ldc; const float* ssq16;
    __device__ __forceinline__ void operator()(const f32x4 (&acc)[2][2][4][2], const Unit& u, int wr, int wc, int fr, int fq, const PG8_LAS float* rst) const {
        const int row0 = u.pm * BM + wr * 64 + fr, cw = (u.pn % NPN) * HALF + wc * 32 + 8 * fq;
#pragma unroll
        for (int ai = 0; ai < 2; ++ai)
#pragma unroll
            for (int m = 0; m < 4; ++m) {
                const int row = row0 + ai * HALF + m * 16; const float rs = rst[ai * HALF + wr * 64 + m * 16 + fr];
                f32x4 v0, v1;
#pragma unroll
                for (int j = 0; j < 4; ++j) { v0[j] = silu_f(acc[ai][0][m][0][j] * rs) * (acc[ai][1][m][0][j] * rs); v1[j] = silu_f(acc[ai][0][m][1][j] * rs) * (acc[ai][1][m][1][j] * rs); }
                *(u32x4*)(O + (size_t)row * ldc + cw) = pack8(v0, v1);
            }
    }
};
template <int NPN, bool RS_> struct EpiSwigluF8 {
    static constexpr bool PERM = true, AFTER_DRAIN = false, RS = RS_;
    static constexpr int PERMK = 1;
    unsigned char* O; int ldc; float sc; const float* ssq16;
    __device__ __forceinline__ void operator()(const f32x4 (&acc)[2][2][4][2], const Unit& u, int wr, int wc, int fr, int fq, const PG8_LAS float* rst = nullptr) const {
        const int row0 = u.pm * BM + wr * 64 + fr, cw = (u.pn % NPN) * HALF + wc * 32 + 8 * fq;
#pragma unroll
        for (int ai = 0; ai < 2; ++ai)
#pragma unroll
            for (int m = 0; m < 4; ++m) {
                const int row = row0 + ai * HALF + m * 16; float s_ = sc; if constexpr (RS_) s_ *= rst[ai * HALF + wr * 64 + m * 16 + fr];
                float v[8];
                const float c1_ = -1.4426950409f * s_, is2_ = __builtin_amdgcn_rcpf(s_ * s_);
#pragma unroll
                for (int j = 0; j < 4; ++j) { const float g0 = acc[ai][0][m][0][j], g1 = acc[ai][0][m][1][j];
                    v[j] = (g0 * acc[ai][1][m][0][j]) * __builtin_amdgcn_rcpf(__builtin_fmaf(__builtin_amdgcn_exp2f(g0 * c1_), is2_, is2_));
                    v[4 + j] = (g1 * acc[ai][1][m][1][j]) * __builtin_amdgcn_rcpf(__builtin_fmaf(__builtin_amdgcn_exp2f(g1 * c1_), is2_, is2_)); }
                int w0 = __builtin_amdgcn_cvt_pk_fp8_f32(v[0], v[1], 0, false); w0 = __builtin_amdgcn_cvt_pk_fp8_f32(v[2], v[3], w0, true);
                int w1 = __builtin_amdgcn_cvt_pk_fp8_f32(v[4], v[5], 0, false); w1 = __builtin_amdgcn_cvt_pk_fp8_f32(v[6], v[7], w1, true);
                typedef int i32x2_t __attribute__((ext_vector_type(2)));
                *(i32x2_t*)(O + (size_t)row * ldc + cw) = (i32x2_t){w0, w1};
            }
    }
};
template <bool X8> struct EpiResid {
    static constexpr bool PERM = true, AFTER_DRAIN = false, RS = false;
    static constexpr int PERMK = 2;
    bf16_t* xb; float* ssq16; unsigned char* x8; float sc;
    __device__ __forceinline__ void operator()(const f32x4 (&acc)[2][2][4][2], const Unit& u, int wr, int wc, int fr, int fq) const {
        const int row0 = u.pm * BM + wr * 64 + fr, cw = u.pn * BM + wc * 64 + 8 * fq;
        u32x4 xin[2][4][2];
#pragma unroll
        for (int ai = 0; ai < 2; ++ai)
#pragma unroll
            for (int m = 0; m < 4; ++m)
#pragma unroll
                for (int bj = 0; bj < 2; ++bj) xin[ai][m][bj] = *(const u32x4*)(xb + (size_t)(row0 + ai * HALF + m * 16) * 1024 + cw + bj * 32);
#pragma unroll
        for (int ai = 0; ai < 2; ++ai)
#pragma unroll
            for (int m = 0; m < 4; ++m) {
                const int row = row0 + ai * HALF + m * 16; const size_t off = (size_t)row * 1024 + cw; float s = 0.f; u32x4 wn[2];
#pragma unroll
                for (int bj = 0; bj < 2; ++bj) {
                    const u32x4 xo = xin[ai][m][bj];
                    const f32x4 b0 = {__builtin_bit_cast(float, xo.x << 16), __builtin_bit_cast(float, xo.x & 0xffff0000u), __builtin_bit_cast(float, xo.y << 16), __builtin_bit_cast(float, xo.y & 0xffff0000u)};
                    const f32x4 b1 = {__builtin_bit_cast(float, xo.z << 16), __builtin_bit_cast(float, xo.z & 0xffff0000u), __builtin_bit_cast(float, xo.w << 16), __builtin_bit_cast(float, xo.w & 0xffff0000u)};
                    const f32x4 v0 = acc[ai][bj][m][0] * sc + b0, v1 = acc[ai][bj][m][1] * sc + b1;
                    wn[bj] = pack8(v0, v1);
                    if constexpr (X8) { int w0 = __builtin_amdgcn_cvt_pk_fp8_f32(v0[0], v0[1], 0, false); w0 = __builtin_amdgcn_cvt_pk_fp8_f32(v0[2], v0[3], w0, true);
                        int w1 = __builtin_amdgcn_cvt_pk_fp8_f32(v1[0], v1[1], 0, false); w1 = __builtin_amdgcn_cvt_pk_fp8_f32(v1[2], v1[3], w1, true);
                        typedef int i32x2_t __attribute__((ext_vector_type(2))); *(i32x2_t*)(x8 + off + bj * 32) = (i32x2_t){w0, w1}; }
                    s += ((v0[0] * v0[0] + v0[1] * v0[1]) + (v0[2] * v0[2] + v0[3] * v0[3])) + ((v1[0] * v1[0] + v1[1] * v1[1]) + (v1[2] * v1[2] + v1[3] * v1[3]));
                }
                st_rows2(xb + (size_t)(row - fr) * 1024 + u.pn * BM + 64 * wc, 1024, fr, fq, wn[0], wn[1]);
                s = sum_rows4(s);
                if (fq == 0) ssq16[(size_t)row * 16 + u.pn * 4 + wc] = s;
            }
    }
};
struct EpiY {
    static constexpr bool PERM = true, AFTER_DRAIN = false, RS = false;
    static constexpr int PERMK = 2;
    bf16_t* Y; const float* gate; float sc; bf16_t* YP;
    __device__ __forceinline__ void operator()(const f32x4 (&acc)[2][2][4][2], const Unit& u, int wr, int wc, int fr, int fq) const {
        const int row0 = u.pm * BM + wr * 64 + fr, cw = (u.pn & 3) * BM + wc * 32 + 8 * fq;
        bf16_t* base = Y; size_t rofs = 0;
        if (u.pm >= 128) { base = YP + (size_t)(u.kofs >> 9) * (2048 * 1024); rofs = (size_t)128 * BM; }
        float gv[2][4];
#pragma unroll
        for (int ai = 0; ai < 2; ++ai)
#pragma unroll
            for (int m = 0; m < 4; ++m) gv[ai][m] = gate[row0 + ai * HALF + m * 16];
#pragma unroll
        for (int ai = 0; ai < 2; ++ai)
#pragma unroll
            for (int m = 0; m < 4; ++m) {
                const int row = row0 + ai * HALF + m * 16; const float g = gv[ai][m] * sc; bf16_t* rowp = base + ((size_t)row - rofs) * 1024 + cw;
                (void)rowp; st_rows2(base + ((size_t)(row - fr) - rofs) * 1024 + (u.pn & 3) * BM + 64 * wc, 1024, fr, fq, pack8(acc[ai][0][m][0] * g, acc[ai][0][m][1] * g), pack8(acc[ai][1][m][0] * g, acc[ai][1][m][1] * g));
            }
    }
};
struct MoeOrder {
    static constexpr bool VARK = false;
    StaticOrder so; int NPN; const PG8_LAS int* texp;
    __device__ __forceinline__ void init(int T, const PG8_LAS int* texp_, int NPN_, int G, int c) { NPN = NPN_; texp = texp_; so.nM = T; so.nN = NPN_; so.nwg = T * NPN_; so.G = G; so.c = c; }
    __device__ __forceinline__ bool next(int i, Unit& u) const {
        if (!so.next(i, u)) return false;
        u.pn += __builtin_amdgcn_readfirstlane(texp[u.pm]) * NPN; return true;
    }
    __device__ __forceinline__ void a_ready(const Unit&) const {}
    __device__ __forceinline__ void done(const Unit&) const {}
};
struct MoeSplitOrder {
    static constexpr bool VARK = true;
    StaticOrder so; int T, G, c, ntf; const PG8_LAS int* texp;
    __device__ __forceinline__ void init(int T_, const PG8_LAS int* texp_, int G_, int c_, int ntf_) { T = T_; texp = texp_; G = G_; c = c_; ntf = ntf_; so.nM = 128; so.nN = 4; so.nwg = 512; so.G = G_; so.c = c_; }
    __device__ __forceinline__ bool next(int i, Unit& u) const {
        const int L = i * G + c; int pnl;
        if (L < 512) { so.next(i, u); pnl = u.pn; u.kofs = 0; u.nt = ntf; }
        else { const int Ls = L - 512; if (Ls >= (T - 128) * 28) return false;
            const int su = Ls / 7, sl = Ls - su * 7; u.pm = 128 + (su >> 2); pnl = su & 3; u.kofs = sl * 512; u.nt = 4; }
        u.pn = __builtin_amdgcn_readfirstlane(texp[u.pm]) * 4 + pnl; return true;
    }
    __device__ __forceinline__ void a_ready(const Unit&) const {}
    __device__ __forceinline__ void done(const Unit&) const {}
};
template <class Epi, class Sched, bool ALIGN_EPI = false, bool SP2 = false, bool FP8 = false>
__device__ __forceinline__ void gemm_phase(PG8_LAS unsigned char* lds, const Gemm g, const Sched& S, const Epi& E) {
    const int tid = threadIdx.x, wid = __builtin_amdgcn_readfirstlane(tid >> 6), lane = tid & 63, wr = wid >> 2, wc = wid & 3, fr = lane & 15, fq = lane >> 4;
    const int K = FP8 ? g.K / 2 : g.K  , nt = K / BK;
    typedef int v8i32_t __attribute__((ext_vector_type(8))); typedef short s16x16_t __attribute__((ext_vector_type(16)));
    unsigned voffA[2], voffB[2], voffB1[2];
#pragma unroll
    for (int i = 0; i < 2; ++i) { int R, C; stage_rc(tid * 16 + i * 8192, R, C); const int Rb = Epi::PERM ? ((R & ~31) + perm32(R & 31)) : R;
        voffA[i] = (unsigned)(R * K + C) * 2u; voffB[i] = (unsigned)(Rb * K + C) * 2u; voffB1[i] = voffB[i];
        if constexpr (Epi::PERMK == 2) { const int r0_ = 64 * (R >> 5) + perm32(R & 31); voffB[i] = (unsigned)(r0_ * K + C) * 2u; voffB1[i] = (unsigned)((r0_ + 32) * K + C) * 2u; } }
    const size_t kstep = (size_t)(BK * 2);
    const size_t hstep = (size_t)HALF * K * 2;
    const size_t tstep = 2 * hstep;
    const size_t hstepB = (Epi::PERMK == 2) ? (size_t)0 : hstep;
    const unsigned ldsw = (unsigned)wid * 1024u;
    const int aoff = lds_byte(wr * 64 + fr, fq * 8), boff = lds_byte(wc * 32 + fr, fq * 8);
#define PG8_SA(b, h) (((b) * 2 + (h)) * HTB)
#define PG8_SB(b, h) ((4 + (b) * 2 + (h)) * HTB)
#define PG8_STAGE(bufoff, gbase, voff) do { _Pragma("unroll") for (int _i = 0; _i < 2; ++_i) \
        __builtin_amdgcn_global_load_lds((const unsigned*)((const char*)(gbase) + (voff)[_i]), (PG8_LAS unsigned*)(lds + (bufoff) + ldsw + _i * 8192), 16, 0, 0); } while (0)
#define PG8_LDA(dst, b, h) do { _Pragma("unroll") for (int m = 0; m < 4; ++m) _Pragma("unroll") for (int k = 0; k < 2; ++k) dst[m][k] = *(const PG8_LAS bf16x8*)(lds + PG8_SA(b, h) + aoff + m * 2048 + k * 1024); } while (0)
#define PG8_LDB(dst, b, h) do { _Pragma("unroll") for (int n = 0; n < 2; ++n) _Pragma("unroll") for (int k = 0; k < 2; ++k) dst[n][k] = *(const PG8_LAS bf16x8*)(lds + PG8_SB(b, h) + boff + n * 2048 + k * 1024); } while (0)
#define PG8_CAT(x, y) __builtin_bit_cast(v8i32_t, __builtin_shufflevector((x), (y), 0, 1, 2, 3, 4, 5, 6, 7, 8, 9, 10, 11, 12, 13, 14, 15))
#define PG8_MMA(ai, bj, At, Bt) do { __builtin_amdgcn_s_setprio(1); _Pragma("unroll") for (int m = 0; m < 4; ++m) _Pragma("unroll") for (int n = 0; n < 2; ++n) { \
        if constexpr (FP8) { const v8i32_t b8_ = PG8_CAT(Bt[n][0], Bt[n][1]), a8_ = PG8_CAT(At[m][0], At[m][1]); asm volatile("v_mfma_f32_16x16x128_f8f6f4 %0, %1, %2, %0" : "+v"(acc[ai][bj][m][n]) : "v"(b8_), "v"(a8_)); } \
        else { _Pragma("unroll") for (int k = 0; k < 2; ++k) acc[ai][bj][m][n] = __builtin_amdgcn_mfma_f32_16x16x32_bf16(Bt[n][k], At[m][k], acc[ai][bj][m][n], 0, 0, 0); } } \
        __builtin_amdgcn_s_setprio(0); } while (0)
#define PG8_WAIT_V(n) asm volatile("s_waitcnt vmcnt(" #n ")" ::: "memory")
#define PG8_WAIT_L(n) asm volatile("s_waitcnt lgkmcnt(" #n ")" ::: "memory")
#define PG8_BAR __builtin_amdgcn_s_barrier()
#define PG8_SCHED __builtin_amdgcn_sched_barrier(0)
    Unit cur, nxt; int ui = 0;
    if (!S.next(0, cur)) return;
    f32x4 acc[2][2][4][2];
#pragma unroll
    for (int a = 0; a < 2; ++a)
#pragma unroll
        for (int b = 0; b < 2; ++b)
#pragma unroll
            for (int m = 0; m < 4; ++m)
#pragma unroll
                for (int n = 0; n < 2; ++n) acc[a][b][m][n] = (f32x4){0.f, 0.f, 0.f, 0.f};
    bf16x8 At[4][2], B0[2][2], B1[2][2];
    const char* cA = (const char*)g.A + (size_t)cur.pm * tstep + (Sched::VARK ? cur.kofs : 0); const char* cB = (const char*)g.Bt + (size_t)cur.pn * tstep + (Sched::VARK ? cur.kofs : 0);
    S.a_ready(cur);
    PG8_LAS float* const rstab = (PG8_LAS float*)(lds + STAGE_BYTES);
    if constexpr (Epi::RS) { RsPre r0_; rs_issue(r0_, E.ssq16, cur.pm, tid); rs_finish(r0_, rstab, tid); }
    if constexpr (SP2) {
        PG8_STAGE(PG8_SB(0, 0), cB, voffB); PG8_STAGE(PG8_SB(0, 1), cB + hstepB, voffB1); PG8_STAGE(PG8_SA(0, 0), cA, voffA); PG8_STAGE(PG8_SA(0, 1), cA + hstep, voffA);
        if (wr == 1) PG8_BAR;
        PG8_WAIT_V(2); PG8_BAR;
        PG8_STAGE(PG8_SB(1, 0), cB + kstep, voffB); PG8_STAGE(PG8_SA(1, 0), cA + kstep, voffA); PG8_STAGE(PG8_SB(1, 1), cB + hstepB + kstep, voffB1);
        PG8_WAIT_V(6); PG8_BAR;
    } else {
        PG8_STAGE(PG8_SB(0, 0), cB, voffB); PG8_STAGE(PG8_SA(0, 0), cA, voffA); PG8_STAGE(PG8_SB(0, 1), cB + hstepB, voffB1); PG8_STAGE(PG8_SA(0, 1), cA + hstep, voffA);
        if (wr == 1) PG8_BAR;
        PG8_WAIT_V(4); PG8_BAR;
        PG8_STAGE(PG8_SB(1, 0), cB + kstep, voffB); PG8_STAGE(PG8_SA(1, 0), cA + kstep, voffA); PG8_STAGE(PG8_SB(1, 1), cB + hstepB + kstep, voffB1);
        PG8_WAIT_V(6); PG8_BAR;
    }
    for (;;) {
        const bool has_next = S.next(ui + 1, nxt);
        const char* nA = has_next ? (const char*)g.A + (size_t)nxt.pm * tstep + (Sched::VARK ? nxt.kofs : 0) : cA; const char* nB = has_next ? (const char*)g.Bt + (size_t)nxt.pn * tstep + (Sched::VARK ? nxt.kofs : 0) : cB;
        const int ntu = Sched::VARK ? cur.nt : nt;
#pragma nounroll
        for (int t = 0; t < ntu; t += 2) {
            const bool last = (t == ntu - 2);
            const char* a1 = cA + (size_t)(t + 1) * kstep;
            const char* a2 = last ? nA : cA + (size_t)(t + 2) * kstep; const char* b2 = last ? nB : cB + (size_t)(t + 2) * kstep;
            const char* a3 = a2 + kstep; const char* b3 = b2 + kstep;
            if (last && has_next) S.a_ready(nxt);
            if constexpr (SP2) {
            PG8_LDB(B0, 0, 0); PG8_LDB(B1, 0, 1); PG8_SCHED; PG8_LDA(At, 0, 0); PG8_STAGE(PG8_SA(1, 1), a1 + hstep, voffA);
            PG8_WAIT_V(8); PG8_WAIT_L(0); PG8_BAR; PG8_MMA(0, 0, At, B0); PG8_MMA(0, 1, At, B1); PG8_BAR; PG8_SCHED;
            PG8_LDA(At, 0, 1); PG8_STAGE(PG8_SB(0, 0), b2, voffB); PG8_STAGE(PG8_SB(0, 1), b2 + hstepB, voffB1); PG8_STAGE(PG8_SA(0, 0), a2, voffA);
            PG8_WAIT_V(8); PG8_WAIT_L(0); PG8_BAR; PG8_MMA(1, 0, At, B0); PG8_MMA(1, 1, At, B1); PG8_BAR; PG8_SCHED;
            PG8_LDB(B0, 1, 0); PG8_LDB(B1, 1, 1); PG8_SCHED; PG8_LDA(At, 1, 0); PG8_STAGE(PG8_SA(0, 1), a2 + hstep, voffA);
            PG8_WAIT_V(8); PG8_WAIT_L(0); PG8_BAR; PG8_MMA(0, 0, At, B0); PG8_MMA(0, 1, At, B1); PG8_BAR; PG8_SCHED;
            PG8_LDA(At, 1, 1); PG8_STAGE(PG8_SB(1, 0), b3, voffB); PG8_STAGE(PG8_SB(1, 1), b3 + hstepB, voffB1); PG8_STAGE(PG8_SA(1, 0), a3, voffA);
            PG8_WAIT_V(8); PG8_WAIT_L(0); PG8_BAR; PG8_MMA(1, 0, At, B0); PG8_MMA(1, 1, At, B1); PG8_BAR; PG8_SCHED;
            } else {
            PG8_LDB(B0, 0, 0); PG8_SCHED; PG8_LDA(At, 0, 0); PG8_STAGE(PG8_SA(1, 1), a1 + hstep, voffA);
            PG8_WAIT_L(8); PG8_BAR; PG8_WAIT_L(0); PG8_MMA(0, 0, At, B0); PG8_BAR; PG8_SCHED;
            PG8_LDB(B1, 0, 1); PG8_STAGE(PG8_SB(0, 0), b2, voffB);
            PG8_BAR; PG8_WAIT_L(0); PG8_MMA(0, 1, At, B1); PG8_BAR;
            PG8_LDA(At, 0, 1); PG8_STAGE(PG8_SA(0, 0), a2, voffA);
            PG8_BAR; PG8_WAIT_L(0); PG8_MMA(1, 0, At, B0); PG8_BAR; PG8_SCHED;
            PG8_STAGE(PG8_SB(0, 1), b2 + hstepB, voffB1);
            PG8_WAIT_V(6); PG8_BAR; PG8_MMA(1, 1, At, B1); PG8_BAR;
            PG8_LDB(B0, 1, 0); PG8_SCHED; PG8_LDA(At, 1, 0); PG8_STAGE(PG8_SA(0, 1), a2 + hstep, voffA);
            PG8_WAIT_L(8); PG8_BAR; PG8_WAIT_L(0); PG8_MMA(0, 0, At, B0); PG8_BAR; PG8_SCHED;
            PG8_LDB(B1, 1, 1); PG8_STAGE(PG8_SB(1, 0), b3, voffB);
            PG8_BAR; PG8_WAIT_L(0); PG8_MMA(0, 1, At, B1); PG8_BAR;
            PG8_LDA(At, 1, 1); PG8_STAGE(PG8_SA(1, 0), a3, voffA);
            PG8_BAR; PG8_WAIT_L(0); PG8_MMA(1, 0, At, B0); PG8_BAR; PG8_SCHED;
            PG8_STAGE(PG8_SB(1, 1), b3 + hstepB, voffB1);
            PG8_WAIT_V(6); PG8_BAR; PG8_MMA(1, 1, At, B1); PG8_BAR;
            }
        }
        if constexpr (FP8) asm volatile("s_nop 15\n\ts_nop 15" ::: "memory");
        if constexpr (ALIGN_EPI) { if (wr == 0) PG8_BAR; }
        if constexpr (!Epi::AFTER_DRAIN) {
            if constexpr (Epi::RS) { RsPre rn_; if (has_next) rs_issue(rn_, E.ssq16, nxt.pm, tid);
                E(acc, cur, wr, wc, fr, fq, rstab + (ui & 1) * 256);
                if (has_next) rs_finish(rn_, rstab + ((ui + 1) & 1) * 256, tid); }
            else E(acc, cur, wr, wc, fr, fq);
            S.done(cur); }
        if (!has_next) break;
#pragma unroll
        for (int a = 0; a < 2; ++a)
#pragma unroll
            for (int b = 0; b < 2; ++b)
#pragma unroll
                for (int m = 0; m < 4; ++m)
#pragma unroll
                    for (int n = 0; n < 2; ++n) acc[a][b][m][n] = (f32x4){0.f, 0.f, 0.f, 0.f};
        cur = nxt; cA = nA; cB = nB; ++ui;
        if constexpr (ALIGN_EPI) { if (wr == 1) PG8_BAR; }
    }
    PG8_WAIT_V(0);
    if constexpr (!ALIGN_EPI) { if (wr == 0) PG8_BAR; }
    PG8_BAR;
    if constexpr (Epi::AFTER_DRAIN) { E.fused(acc, cur, wr, wc, fr, fq, lds, wid, lane); S.done(cur); }
#undef PG8_SA
#undef PG8_SB
#undef PG8_STAGE
#undef PG8_LDA
#undef PG8_LDB
#undef PG8_MMA
#undef PG8_CAT
#undef PG8_WAIT_V
#undef PG8_WAIT_L
#undef PG8_BAR
#undef PG8_SCHED
}
}

namespace att {
typedef unsigned short bf16;
using bf16x8 = __attribute__((ext_vector_type(8))) short;
using s16x4  = __attribute__((ext_vector_type(4))) short;
using f32x16 = __attribute__((ext_vector_type(16))) float;
using f32x4  = __attribute__((ext_vector_type(4))) float;
using u32x4  = __attribute__((ext_vector_type(4))) unsigned;
#define ASBAR() __builtin_amdgcn_sched_barrier(0)
#define LDS3 __attribute__((address_space(3)))
constexpr float THR2 = 40.0f;
__device__ __forceinline__ int crow(int r, int hi) { return (r & 3) + 8 * (r >> 2) + 4 * hi; }
__device__ __forceinline__ unsigned cvtpk(float lo, float hi) { unsigned r; asm volatile("v_cvt_pk_bf16_f32 %0, %1, %2" : "=v"(r) : "v"(lo), "v"(hi)); return r; }
__device__ __forceinline__ unsigned short f2bf(float f) { unsigned u = __builtin_bit_cast(unsigned, f); return (unsigned short)((u + 0x7fffu + ((u >> 16) & 1u)) >> 16); }
template <int DQK> __device__ __forceinline__ int kswz(int row, int colB) { return row * (DQK * 2) + (colB ^ ((row & 7) << 4)); }
template <int DQK, int DV> struct Geo {
    static constexpr int SHM_K = 64 * DQK * 2, SHM_V = 64 * DV * 2, NCB = DV / 32;
    static constexpr int WS_OFF = 2 * SHM_V + 2 * SHM_K, TAB_OFF = WS_OFF + 2048, BYTES = TAB_OFF + 8192;
};
__device__ __forceinline__ void partialSM_abs(f32x16& p0, f32x16& p1, float& m_reg, float& alpha, float cadd) {
    float pmax = p0[0];
#pragma unroll
    for (int r = 1; r < 16; ++r) pmax = fmaxf(pmax, p0[r]);
#pragma unroll
    for (int r = 0; r < 16; ++r) pmax = fmaxf(pmax, p1[r]);
    { auto rr = __builtin_amdgcn_permlane32_swap(__float_as_uint(pmax), __float_as_uint(pmax), false, false); pmax = fmaxf(__uint_as_float(rr[0]), __uint_as_float(rr[1])); }
    pmax += cadd;
    float mn;
    if (__builtin_expect(__all(pmax - m_reg <= THR2), 1)) { mn = m_reg; alpha = 1.f; }
    else { mn = fmaxf(m_reg, pmax); alpha = __builtin_amdgcn_exp2f(m_reg - mn); m_reg = mn; }
    const float sh = cadd - mn;
#pragma unroll
    for (int r = 0; r < 16; ++r) { p0[r] += sh; p1[r] += sh; }
#pragma unroll
    for (int r = 0; r < 16; ++r) p0[r] = __builtin_amdgcn_exp2f(p0[r]);
}
template <bool FIRST> __device__ __forceinline__ void partialSM_rel(f32x16& p0, f32x16& p1, float& m_reg, float& alpha, f32x16& cini, float cq) {
    float pmax = p0[0];
#pragma unroll
    for (int r = 1; r < 16; ++r) pmax = fmaxf(pmax, p0[r]);
#pragma unroll
    for (int r = 0; r < 16; ++r) pmax = fmaxf(pmax, p1[r]);
    { auto rr = __builtin_amdgcn_permlane32_swap(__float_as_uint(pmax), __float_as_uint(pmax), false, false); pmax = fmaxf(__uint_as_float(rr[0]), __uint_as_float(rr[1])); }
    alpha = 1.f;
    if (FIRST || !__builtin_expect(__all(pmax <= THR2), 1)) {
        const float dl = FIRST ? pmax : fmaxf(pmax, 0.f);
        if (!FIRST) alpha = __builtin_amdgcn_exp2f(-dl);
        m_reg += dl;
#pragma unroll
        for (int r = 0; r < 16; ++r) { p0[r] -= dl; p1[r] -= dl; cini[r] = cq - m_reg; }
    }
#pragma unroll
    for (int r = 0; r < 16; ++r) p0[r] = __builtin_amdgcn_exp2f(p0[r]);
}
__device__ __forceinline__ void finishSM(f32x16& p0, f32x16& p1, float alpha, float& l_reg, bf16x8& pa0, bf16x8& pa1, bf16x8& pa2, bf16x8& pa3) {
#pragma unroll
    for (int r = 0; r < 16; ++r) p1[r] = __builtin_amdgcn_exp2f(p1[r]);
    float ps = 0;
#pragma unroll
    for (int r = 0; r < 16; ++r) ps += p0[r];
#pragma unroll
    for (int r = 0; r < 16; ++r) ps += p1[r];
    { auto rr = __builtin_amdgcn_permlane32_swap(__float_as_uint(ps), __float_as_uint(ps), false, false); ps = __uint_as_float(rr[0]) + __uint_as_float(rr[1]); }
    l_reg = l_reg * alpha + ps;
#define ATT_PK4(P, BASE, OUT) do { unsigned a0 = cvtpk(P[BASE + 0], P[BASE + 1]), a1 = cvtpk(P[BASE + 2], P[BASE + 3]);   \
    unsigned b0 = cvtpk(P[BASE + 4], P[BASE + 5]), b1 = cvtpk(P[BASE + 6], P[BASE + 7]);                              \
    auto r0 = __builtin_amdgcn_permlane32_swap(a0, b0, false, false); auto r1 = __builtin_amdgcn_permlane32_swap(a1, b1, false, false); \
    u32x4 w = {r0[0], r1[0], r0[1], r1[1]}; OUT = *reinterpret_cast<bf16x8*>(&w); } while (0)
    ATT_PK4(p0, 0, pa0); ATT_PK4(p0, 8, pa1); ATT_PK4(p1, 0, pa2); ATT_PK4(p1, 8, pa3);
#undef ATT_PK4
}
template <int DQK, bool REL> __device__ __forceinline__ void qkt(f32x16& p0, f32x16& p1, const LDS3 char* Ks, const bf16x8* qr, int r32, int hi, const f32x16& cini, unsigned e0 = 0u, unsigned e1 = 0u) {
    const f32x16 z = f32x16{};
#pragma unroll
    for (int d0 = 0; d0 < DQK / 16; ++d0) { const int cb = (d0 * 16 + hi * 8) * 2;
        const bf16x8 b0 = *(const LDS3 bf16x8*)(Ks + kswz<DQK>(r32, cb));
        const bf16x8 b1 = *(const LDS3 bf16x8*)(Ks + kswz<DQK>(32 + r32, cb));
        p0 = __builtin_amdgcn_mfma_f32_32x32x16_bf16(b0, qr[d0], d0 == 0 ? (REL ? cini : z) : p0, 0, 0, 0);
        p1 = __builtin_amdgcn_mfma_f32_32x32x16_bf16(b1, qr[d0], d0 == 0 ? (REL ? cini : z) : p1, 0, 0, 0); }
    if constexpr (REL) {
        const u32x4 a0 = {hi ? 0u : e0, 0u, 0u, 0u}, a1 = {hi ? 0u : e1, 0u, 0u, 0u}, on = {hi ? 0u : 0x3F803F80u, 0u, 0u, 0u};
        p0 = __builtin_amdgcn_mfma_f32_32x32x16_bf16(__builtin_bit_cast(bf16x8, a0), __builtin_bit_cast(bf16x8, on), p0, 0, 0, 0);
        p1 = __builtin_amdgcn_mfma_f32_32x32x16_bf16(__builtin_bit_cast(bf16x8, a1), __builtin_bit_cast(bf16x8, on), p1, 0, 0, 0);
    }
}
template <int NCB> __device__ __forceinline__ int v_st(int k, int c) { const int kk = (k & ~0xC) | ((k & 4) << 1) | ((k & 8) >> 1); return ((kk >> 3) * NCB + (c >> 5)) * 512 + ((kk & 7) * 32 + (c & 31)) * 2; }
__device__ __forceinline__ int v_rd_base(int lane) { return ((lane & 3) << 3) | (((lane >> 2) & 3) << 6) | (((lane >> 4) & 1) << 5) | (((lane >> 5) & 1) << 8); }
template <int NCB> constexpr int v_rd_off(int d0, int ks, int half) { return d0 * 512 + ks * (2 * NCB * 512) + half * (NCB * 512); }
template <int OFF> __device__ __forceinline__ s16x4 tr_read(int vb) { s16x4 r; asm volatile("ds_read_b64_tr_b16 %0, %1 offset:%2" : "=&v"(r) : "v"(vb), "i"(OFF) : "memory"); return r; }
template <int NCB, int D0, bool SPLIT> __device__ __forceinline__ void pv_one(f32x16& od, int vb, bf16x8 pa0, bf16x8 pa1, bf16x8 pa2, bf16x8 pa3) {
#define ATT_PK(L, H) (bf16x8){L[0], L[1], L[2], L[3], H[0], H[1], H[2], H[3]}
    if constexpr (!SPLIT) {
        const s16x4 l0 = tr_read<v_rd_off<NCB>(D0, 0, 0)>(vb), h0 = tr_read<v_rd_off<NCB>(D0, 0, 1)>(vb), l1 = tr_read<v_rd_off<NCB>(D0, 1, 0)>(vb), h1 = tr_read<v_rd_off<NCB>(D0, 1, 1)>(vb);
        const s16x4 l2 = tr_read<v_rd_off<NCB>(D0, 2, 0)>(vb), h2 = tr_read<v_rd_off<NCB>(D0, 2, 1)>(vb), l3 = tr_read<v_rd_off<NCB>(D0, 3, 0)>(vb), h3 = tr_read<v_rd_off<NCB>(D0, 3, 1)>(vb);
        asm volatile("s_waitcnt lgkmcnt(0)" ::: "memory"); ASBAR();
        od = __builtin_amdgcn_mfma_f32_32x32x16_bf16(pa0, ATT_PK(l0, h0), od, 0, 0, 0);
        od = __builtin_amdgcn_mfma_f32_32x32x16_bf16(pa1, ATT_PK(l1, h1), od, 0, 0, 0);
        od = __builtin_amdgcn_mfma_f32_32x32x16_bf16(pa2, ATT_PK(l2, h2), od, 0, 0, 0);
        od = __builtin_amdgcn_mfma_f32_32x32x16_bf16(pa3, ATT_PK(l3, h3), od, 0, 0, 0);
    } else {
        { const s16x4 l0 = tr_read<v_rd_off<NCB>(D0, 0, 0)>(vb), h0 = tr_read<v_rd_off<NCB>(D0, 0, 1)>(vb), l1 = tr_read<v_rd_off<NCB>(D0, 1, 0)>(vb), h1 = tr_read<v_rd_off<NCB>(D0, 1, 1)>(vb);
          asm volatile("s_waitcnt lgkmcnt(0)" ::: "memory"); ASBAR();
          od = __builtin_amdgcn_mfma_f32_32x32x16_bf16(pa0, ATT_PK(l0, h0), od, 0, 0, 0);
          od = __builtin_amdgcn_mfma_f32_32x32x16_bf16(pa1, ATT_PK(l1, h1), od, 0, 0, 0); ASBAR(); }
        { const s16x4 l2 = tr_read<v_rd_off<NCB>(D0, 2, 0)>(vb), h2 = tr_read<v_rd_off<NCB>(D0, 2, 1)>(vb), l3 = tr_read<v_rd_off<NCB>(D0, 3, 0)>(vb), h3 = tr_read<v_rd_off<NCB>(D0, 3, 1)>(vb);
          asm volatile("s_waitcnt lgkmcnt(0)" ::: "memory"); ASBAR();
          od = __builtin_amdgcn_mfma_f32_32x32x16_bf16(pa2, ATT_PK(l2, h2), od, 0, 0, 0);
          od = __builtin_amdgcn_mfma_f32_32x32x16_bf16(pa3, ATT_PK(l3, h3), od, 0, 0, 0); ASBAR(); }
    }
#undef ATT_PK
}
template <int NCB, bool SPLIT> __device__ __forceinline__ void pv_all(f32x16* o, int vb, bf16x8 pa0, bf16x8 pa1, bf16x8 pa2, bf16x8 pa3) {
    pv_one<NCB, 0, SPLIT>(o[0], vb, pa0, pa1, pa2, pa3); pv_one<NCB, 1, SPLIT>(o[1], vb, pa0, pa1, pa2, pa3);
    if constexpr (NCB == 4) { pv_one<NCB, 2, SPLIT>(o[2], vb, pa0, pa1, pa2, pa3); pv_one<NCB, 3, SPLIT>(o[3], vb, pa0, pa1, pa2, pa3); }
}
template <int MODE> __device__ __forceinline__ bool t5_far(int kt, int q0w) { return MODE == 2 && q0w - (kt * 64 + 63) >= 113; }
template <int MODE> __device__ __forceinline__ void apply_bias(f32x16& p0, f32x16& p1, int kt, const LDS3 float* tab, int qabs, int q0w, int hi) {
    const int k0 = kt * 64;
    if constexpr (MODE == 1) {
        if (k0 + 63 > q0w) {
#pragma unroll
            for (int r = 0; r < 16; ++r) { const int kv = k0 + crow(r, hi); if (kv > qabs) p0[r] = -INFINITY; if (kv + 32 > qabs) p1[r] = -INFINITY; } }
    } else if constexpr (MODE == 2) {
        if (!t5_far<MODE>(kt, q0w)) {
            const int dq = qabs - k0 - 4 * hi;
#pragma unroll
            for (int g4 = 0; g4 < 4; ++g4) {
#pragma unroll
                for (int i = 0; i < 4; ++i) { const int r = 4 * g4 + i, d = dq - 8 * g4 - i, d1 = d - 32;
                    const int dc = d < 0 ? 0 : (d > 127 ? 127 : d), dc1 = d1 < 0 ? 0 : (d1 > 127 ? 127 : d1);
                    const float t0 = tab[dc], t1 = tab[dc1];
                    p0[r] = d < 0 ? -INFINITY : p0[r] + t0; p1[r] = d1 < 0 ? -INFINITY : p1[r] + t1; }
                asm volatile("" ::: "memory");
            } }
    }
}
template <int DQK, int DV, int MODE, int LDQ, int LDK, int LDO>
__device__ __forceinline__ void attn_unit(const bf16* __restrict__ Qb, const bf16* __restrict__ Kh, const bf16* __restrict__ Vh, bf16* __restrict__ Ob, int NT, int q0, LDS3 char* lds) {
    using G = Geo<DQK, DV>;
    constexpr int SHM_K = G::SHM_K, SHM_V = G::SHM_V, NCB = G::NCB, NKC = DQK / 64, NVC = DV / 64, KCPR = DQK / 8, VCPR = DV / 8;
    const int tid = threadIdx.x, wid = __builtin_amdgcn_readfirstlane(tid >> 6), lane = tid & 63, r32 = lane & 31, hi = lane >> 5;
    LDS3 char* V_lds = lds; LDS3 char* K_lds = lds + 2 * SHM_V;
    LDS3 float* ws = (LDS3 float*)(lds + G::WS_OFF) + wid * 64; LDS3 float* li_l = ws; LDS3 float* al_l = ws + 32;
    const LDS3 float* tab = (const LDS3 float*)(lds + G::TAB_OFF); const LDS3 unsigned* etab = (const LDS3 unsigned*)(lds + G::TAB_OFF);
    const int q0w = q0 + wid * 32, qabs = q0w + r32;
    float cq = 0.f; float b31 = 0.f;
    if constexpr (MODE == 1) { const unsigned e = etab[qabs]; cq = -(__builtin_bit_cast(float, e << 16) + __builtin_bit_cast(float, e & 0xffff0000u)); }
    if constexpr (MODE == 2) b31 = tab[127];
    float m_reg = (MODE == 1) ? 0.f : -1e30f, l_reg = 0; f32x16 cini;
#pragma unroll
    for (int r = 0; r < 16; ++r) cini[r] = cq; f32x16 o[NCB]; bf16x8 qr[DQK / 16];
#pragma unroll
    for (int d = 0; d < NCB; ++d) o[d] = f32x16{};
    const bf16* Qw = Qb + (long)(wid * 32 + r32) * LDQ + hi * 8;
#pragma unroll
    for (int d0 = 0; d0 < DQK / 16; ++d0) qr[d0] = *reinterpret_cast<const bf16x8*>(Qw + d0 * 16);
    int kgo[NKC], klo[NKC], vgo[NVC], vlo[NVC];
#pragma unroll
    for (int j = 0; j < NKC; ++j) { const int ci = tid + 512 * j, row = ci / KCPR, col = (ci % KCPR) * 8; kgo[j] = row * LDK + col; klo[j] = kswz<DQK>(row, col * 2); }
#pragma unroll
    for (int j = 0; j < NVC; ++j) { const int ci = tid + 512 * j, row = ci / VCPR, col = (ci % VCPR) * 8; vgo[j] = row * LDK + col; vlo[j] = v_st<NCB>(row, col); }
    const int vb0 = (int)(unsigned)(uintptr_t)V_lds + v_rd_base(lane);
    constexpr int SD = (MODE == 0) ? 2 : 1;
    struct { bf16x8 vs[NVC], ks[NKC]; } sr_[SD];
#define ATT_SLOAD(i, k0) do { _Pragma("unroll") for (int j_ = 0; j_ < NVC; ++j_) sr_[i].vs[j_] = *reinterpret_cast<const bf16x8*>(&Vh[(long)(k0) * LDK + vgo[j_]]); \
    _Pragma("unroll") for (int j_ = 0; j_ < NKC; ++j_) sr_[i].ks[j_] = *reinterpret_cast<const bf16x8*>(&Kh[(long)(k0) * LDK + kgo[j_]]); } while (0)
#define ATT_SWRITE(b, i) do { _Pragma("unroll") for (int j_ = 0; j_ < NVC; ++j_) *(LDS3 bf16x8*)(V_lds + (b) * SHM_V + vlo[j_]) = sr_[i].vs[j_]; \
    _Pragma("unroll") for (int j_ = 0; j_ < NKC; ++j_) *(LDS3 bf16x8*)(K_lds + (b) * SHM_K + klo[j_]) = sr_[i].ks[j_]; } while (0)
#define ATT_SWAIT() asm volatile("s_waitcnt vmcnt(%0)" :: "n"(SD == 2 ? NKC + NVC : 0) : "memory")
#define ATT_RESC(a) do { if (__any((a) < 1.f)) { if (hi == 0) al_l[r32] = (a); asm volatile("s_waitcnt lgkmcnt(0)" ::: "memory"); \
    _Pragma("unroll") for (int d = 0; d < NCB; ++d) _Pragma("unroll") for (int r = 0; r < 16; ++r) o[d][r] *= al_l[crow(r, hi)]; } } while (0)
#define ATT_BAR() asm volatile("s_waitcnt lgkmcnt(0)\n\ts_barrier" ::: "memory")
    f32x16 pA0, pA1, pB0, pB1; float alA, alB; bf16x8 pa0, pa1, pa2, pa3;
#define ATT_QKT(P0, P1, KB, kt) do { if constexpr (MODE == 1) qkt<DQK, true>(P0, P1, KB, qr, r32, hi, cini, etab[(kt) * 64 + r32], etab[(kt) * 64 + 32 + r32]); else qkt<DQK, false>(P0, P1, KB, qr, r32, hi, cini); } while (0)
#define ATT_PSM(FIRST_, P0, P1, AL, kt) do { if constexpr (MODE == 1) partialSM_rel<FIRST_>(P0, P1, m_reg, AL, cini, cq); else partialSM_abs(P0, P1, m_reg, AL, t5_far<MODE>((kt), q0w) ? b31 : 0.f); } while (0)
    constexpr int SE = 0, SO = SD - 1;
    ATT_SLOAD(SE, 0); asm volatile("s_waitcnt vmcnt(0)" ::: "memory"); ATT_SWRITE(0, SE); ATT_BAR();
    ATT_QKT(pA0, pA1, K_lds, 0); apply_bias<MODE>(pA0, pA1, 0, tab, qabs, q0w, hi); ATT_PSM(true, pA0, pA1, alA, 0);
    ATT_SLOAD(SO, 64); if (SD == 2 && 2 < NT) ATT_SLOAD(SE, 128);
    ATT_SWAIT(); ATT_SWRITE(1, SO); ATT_BAR();
    for (int j = 1; j + 1 < NT; j += 2) {
        ASBAR(); ATT_QKT(pB0, pB1, K_lds + SHM_K, j);
        finishSM(pA0, pA1, alA, l_reg, pa0, pa1, pa2, pa3); ASBAR();
        ATT_SLOAD(SO, (j + SD) * 64); ASBAR();
        pv_all<NCB, MODE == 2>(o, vb0, pa0, pa1, pa2, pa3); apply_bias<MODE>(pB0, pB1, j, tab, qabs, q0w, hi); ATT_PSM(false, pB0, pB1, alB, j);
        ATT_BAR(); ATT_SWAIT(); ATT_SWRITE(0, SE);
        ATT_RESC(alB); ATT_BAR();
        ASBAR(); ATT_QKT(pA0, pA1, K_lds, j + 1);
        finishSM(pB0, pB1, alB, l_reg, pa0, pa1, pa2, pa3); ASBAR();
        if (SD == 1 || j + 3 < NT) ATT_SLOAD(SE, (j + 1 + SD) * 64); ASBAR();
        pv_all<NCB, MODE == 2>(o, vb0 + SHM_V, pa0, pa1, pa2, pa3); apply_bias<MODE>(pA0, pA1, j + 1, tab, qabs, q0w, hi); ATT_PSM(false, pA0, pA1, alA, j + 1);
        ATT_BAR(); ATT_SWAIT(); ATT_SWRITE(1, SO);
        ATT_RESC(alA); ATT_BAR();
    }
    ASBAR(); ATT_QKT(pB0, pB1, K_lds + SHM_K, NT - 1);
    finishSM(pA0, pA1, alA, l_reg, pa0, pa1, pa2, pa3); ASBAR();
    pv_all<NCB, MODE == 2>(o, vb0, pa0, pa1, pa2, pa3); apply_bias<MODE>(pB0, pB1, NT - 1, tab, qabs, q0w, hi); ATT_PSM(false, pB0, pB1, alB, NT - 1);
    ATT_BAR(); ATT_RESC(alB);
    finishSM(pB0, pB1, alB, l_reg, pa0, pa1, pa2, pa3); ASBAR();
    pv_all<NCB, MODE == 2>(o, vb0 + SHM_V, pa0, pa1, pa2, pa3);
    if (hi == 0) li_l[r32] = l_reg; asm volatile("s_waitcnt lgkmcnt(0)" ::: "memory");
    float rli[16];
#pragma unroll
    for (int r = 0; r < 16; ++r) rli[r] = __builtin_amdgcn_rcpf(li_l[crow(r, hi)]);
    bf16* Ow = Ob + (long)(wid * 32) * LDO;
#pragma unroll
    for (int r = 0; r < 16; ++r) { const int orow = crow(r, hi);
#pragma unroll
        for (int d0 = 0; d0 < NCB; ++d0) Ow[(long)orow * LDO + d0 * 32 + r32] = f2bf(o[d0][r] * rli[r]); }
    __syncthreads();
#undef ATT_SLOAD
#undef ATT_SWRITE
#undef ATT_SWAIT
#undef ATT_RESC
#undef ATT_QKT
#undef ATT_BAR
#undef ATT_PSM
}
#undef ASBAR
#undef LDS3
}
#ifndef FOX_THR
#define FOX_THR 40
#endif
namespace fx {
using att::bf16; using att::bf16x8; using att::s16x4; using att::f32x16; using att::u32x4; using att::crow;
typedef unsigned u32x2 __attribute__((ext_vector_type(2)));
typedef __attribute__((address_space(3))) const char* lds_cptr;
typedef short v4i16_t __attribute__((ext_vector_type(4)));
#define FXL __attribute__((address_space(3)))
#define SBAR() __builtin_amdgcn_sched_barrier(0)
constexpr int NW = 8, QBLK = 32, QB = QBLK * NW, KVBLK = 64;
constexpr int NSLOT = 3, SLOTB = 8192;
constexpr int LDS_K = 0, LDS_V = NSLOT * SLOTB, LDS_WS = 2 * NSLOT * SLOTB, LDS_OST = LDS_WS + NW * 64 * 4, LDS_TAB = LDS_OST + NW * 4096, LDS_BYTES = LDS_TAB + 8192;
constexpr unsigned ONES = 0x3F803F80u;
__device__ __forceinline__ void cmask(f32x16& p0, f32x16& p1, int jb, int qrel, int hi) {
  const float NEG = -INFINITY; int kb = 64 * jb + 4 * hi;
  #pragma unroll
  for (int r = 0; r < 16; ++r) { int kv = kb + (r & 3) + 8 * (r >> 2); if (kv > qrel) p0[r] = NEG; if (kv + 32 > qrel) p1[r] = NEG; }
}
__device__ __forceinline__ void glds16(const void* sbase, unsigned voff, unsigned lds_dst) { unsigned keep;
  asm volatile("s_mov_b32 %0, m0\n\ts_mov_b32 m0, %2\n\ts_nop 0\n\tglobal_load_lds_dwordx4 %1, %3\n\ts_mov_b32 m0, %0" : "=&s"(keep) : "v"(voff), "s"(lds_dst), "s"(sbase) : "memory"); }
__device__ __forceinline__ float max3f(float a, float b, float c) { float r; asm("v_max3_f32 %0, %1, %2, %3" : "=v"(r) : "v"(a), "v"(b), "v"(c)); return r; }
__device__ __forceinline__ float max2f(float a, float b) { float r; asm("v_max_f32_e32 %0, %1, %2" : "=v"(r) : "v"(a), "v"(b)); return r; }
__device__ __forceinline__ float fsub_s(float a, float b) { float r; asm("v_sub_f32_e32 %0, %1, %2" : "=v"(r) : "v"(a), "v"(b)); return r; }
typedef float f32x2_t __attribute__((ext_vector_type(2))); typedef __bf16 bf16x2_t __attribute__((ext_vector_type(2)));
__device__ __forceinline__ unsigned cvtpk_s(float lo, float hi) { f32x2_t v = {lo, hi}; bf16x2_t b = __builtin_convertvector(v, bf16x2_t); return __builtin_bit_cast(unsigned, b); }
#define WAIT_BAR(N) asm volatile("s_waitcnt vmcnt(" #N ") lgkmcnt(0)\n\ts_barrier" ::: "memory")
#define MFMA8(a, b, c) __builtin_amdgcn_mfma_f32_32x32x8bf16_1k(__builtin_bit_cast(v4i16_t, a), __builtin_bit_cast(v4i16_t, b), c, 0, 0, 0)
__device__ __forceinline__ float quant2(float v, unsigned& pk) { const unsigned h = att::f2bf(v); const float hf = __builtin_bit_cast(float, h << 16); const unsigned l = att::f2bf(v - hf);
  pk = h | (l << 16); return hf + __builtin_bit_cast(float, l << 16); }

__device__ __forceinline__ void qkt(f32x16& p0, f32x16& p1, lds_cptr Kslot, const bf16x8* qr, u32x2 ax0, u32x2 ax1, u32x2 bx, int r32, int hi) {
  const lds_cptr kb = Kslot + hi * 1024 + r32 * 16;
  p0 = MFMA8(ax0, bx, f32x16{}); p1 = MFMA8(ax1, bx, f32x16{});
  #pragma unroll
  for (int d0 = 0; d0 < 4; ++d0) {
    const bf16x8 b0 = *(const FXL bf16x8*)(kb + d0 * 2048);
    const bf16x8 b1 = *(const FXL bf16x8*)(kb + d0 * 2048 + 512);
    p0 = __builtin_amdgcn_mfma_f32_32x32x16_bf16(b0, qr[d0], p0, 0, 0, 0); p1 = __builtin_amdgcn_mfma_f32_32x32x16_bf16(b1, qr[d0], p1, 0, 0, 0); }
}
__device__ __forceinline__ void kload8(bf16x8* kf, lds_cptr kp) {
  kf[0] = *(const FXL bf16x8*)(kp);        kf[1] = *(const FXL bf16x8*)(kp + 512);
  kf[2] = *(const FXL bf16x8*)(kp + 2048); kf[3] = *(const FXL bf16x8*)(kp + 2560);
  kf[4] = *(const FXL bf16x8*)(kp + 4096); kf[5] = *(const FXL bf16x8*)(kp + 4608);
  kf[6] = *(const FXL bf16x8*)(kp + 6144); kf[7] = *(const FXL bf16x8*)(kp + 6656);
}
__device__ __forceinline__ void kload2(bf16x8* kf, lds_cptr kp, int j) { kf[2 * j] = *(const FXL bf16x8*)(kp + j * 2048); kf[2 * j + 1] = *(const FXL bf16x8*)(kp + j * 2048 + 512); }
__device__ __forceinline__ s16x4 vtr(lds_cptr p) { return __builtin_bit_cast(s16x4, __builtin_amdgcn_ds_read_tr16_b64_v4i16((FXL v4i16_t*)p)); }
__device__ __forceinline__ float rowmax(const f32x16& p0, const f32x16& p1) {
  float a = max3f(p0[0], p0[1], p1[0]), b = max3f(p0[2], p0[3], p1[1]); a = max3f(a, p1[2], p1[3]);
  #pragma unroll
  for (int r = 4; r < 16; r += 4) { a = max3f(a, p0[r], p0[r + 1]); b = max3f(b, p0[r + 2], p0[r + 3]); a = max3f(a, p1[r], p1[r + 1]); b = max3f(b, p1[r + 2], p1[r + 3]); }
  const float m = max2f(a, b);
  auto rr = __builtin_amdgcn_permlane32_swap(__float_as_uint(m), __float_as_uint(m), false, false);
  return max2f(__uint_as_float(rr[0]), __uint_as_float(rr[1]));
}
__device__ __forceinline__ void pv(f32x16* o, int vb, bf16x8 pa0, bf16x8 pa1, bf16x8 pa2, bf16x8 pa3) {
  #pragma unroll
  for (int d0 = 0; d0 < 2; ++d0) { s16x4 lo[4], hi[4];
    #pragma unroll
    for (int ks = 0; ks < 4; ++ks) {
      asm volatile("ds_read_b64_tr_b16 %0,%1 offset:%c2" : "=&v"(lo[ks]) : "v"(vb), "i"(d0 * 4096 + ks * 1024) : "memory");
      asm volatile("ds_read_b64_tr_b16 %0,%1 offset:%c2" : "=&v"(hi[ks]) : "v"(vb), "i"(d0 * 4096 + ks * 1024 + 512) : "memory"); }
    asm volatile("s_waitcnt lgkmcnt(0)" ::: "memory"); SBAR();
    #define PK(k) (bf16x8){lo[k][0], lo[k][1], lo[k][2], lo[k][3], hi[k][0], hi[k][1], hi[k][2], hi[k][3]}
    o[d0] = __builtin_amdgcn_mfma_f32_32x32x16_bf16(pa0, PK(0), o[d0], 0, 0, 0);
    o[d0] = __builtin_amdgcn_mfma_f32_32x32x16_bf16(pa1, PK(1), o[d0], 0, 0, 0);
    o[d0] = __builtin_amdgcn_mfma_f32_32x32x16_bf16(pa2, PK(2), o[d0], 0, 0, 0);
    o[d0] = __builtin_amdgcn_mfma_f32_32x32x16_bf16(pa3, PK(3), o[d0], 0, 0, 0);
    #undef PK
  }
}

template <int LDQ, int LDK, int LDO, int THRL> __device__ __forceinline__ void fox_unit(const bf16* Qb, const bf16* __restrict__ Kh, const bf16* __restrict__ Vh, bf16* Ob, int q0, FXL char* shm) {
  const int tid = threadIdx.x, lane = tid & 63, r32 = lane & 31, hi = lane >> 5; const int wid = __builtin_amdgcn_readfirstlane(tid >> 6);
  const bf16* Qw = Qb + (long)(wid * QBLK) * LDQ;
  const unsigned lds0 = (unsigned)(uintptr_t)shm;
  FXL float* wsf = (FXL float*)(shm + LDS_WS) + wid * 64;
  const FXL unsigned* etab = (const FXL unsigned*)(shm + LDS_TAB);
  const unsigned koff = (unsigned)(lane * LDK + wid * 8) * 2u;
  const unsigned voff = (unsigned)((16 * (wid & 3) + (lane >> 2)) * LDK + (wid >> 2) * 32 + (lane & 3) * 8) * 2u;
  const unsigned kdst = lds0 + LDS_K + wid * 1024, vdst = lds0 + LDS_V + wid * 1024;
  #define DMA_K(t, slot) glds16(Kh + (long)(t) * KVBLK * LDK, koff, (unsigned)__builtin_amdgcn_readfirstlane(kdst + (slot)))
  #define DMA_V(t, slot) glds16(Vh + (long)(t) * KVBLK * LDK, voff, (unsigned)__builtin_amdgcn_readfirstlane(vdst + (slot)))
  bf16x8 kf[8];
  const lds_cptr shm3 = (lds_cptr)shm; const lds_cptr kp0 = shm3 + LDS_K + hi * 1024 + r32 * 16; const lds_cptr vp0 = shm3 + LDS_V + ((lane >> 4) & 1) * 32 + (lane & 3) * 8 + (4 * hi + ((lane & 15) >> 2)) * 64;
  const int NT = (q0 + QB) / KVBLK;
  DMA_K(0, 0); DMA_V(0, 0); DMA_K(1, SLOTB);
  bf16x8 qr[4];
  #pragma unroll
  for (int d0 = 0; d0 < 4; ++d0) qr[d0] = *reinterpret_cast<const bf16x8*>(&Qw[(long)r32 * LDQ + d0 * 16 + hi * 8]);
  u32x2 ax0 = {etab[r32], hi ? 0u : ONES}, ax1 = {etab[32 + r32], hi ? 0u : ONES}, bx = {hi ? 0u : ONES, 0u};
  float l_reg = 0.f; f32x16 o[2]; o[0] = f32x16{}; o[1] = f32x16{};
  #define CMASK(P0, P1, t) do { int jb_ = (t) - (NT - 4); if (jb_ >= 0) { int l_ = lane; asm volatile("" : "+v"(l_)); cmask(P0, P1, jb_, wid * QBLK + (l_ & 31), l_ >> 5); } } while (0)
  #define SETREF(NEWREF) do { unsigned pk_; (void)quant2(-(NEWREF), pk_); bx.y = pk_; asm volatile("" : "+v"(bx)); } while (0)
  #define CURREF() (-(__builtin_bit_cast(float, bx.y << 16) + __builtin_bit_cast(float, bx.y & 0xffff0000u)))
  bool resc = false;
  #define START(P0, P1) do { const float rm = rowmax(P0, P1); resc = false; \
    { SETREF(rm); const float dl = CURREF(); \
      _Pragma("unroll") for (int r = 0; r < 16; ++r) { P0[r] = fsub_s(P0[r], dl); P1[r] = fsub_s(P1[r], dl); } } \
    _Pragma("unroll") for (int r = 0; r < 16; ++r) P0[r] = __builtin_amdgcn_exp2f(P0[r]); } while (0)
  #define RESC() do { if (resc) { asm volatile("s_waitcnt lgkmcnt(0)" ::: "memory"); \
      _Pragma("unroll") for (int d_ = 0; d_ < 2; ++d_) _Pragma("unroll") for (int r = 0; r < 16; ++r) o[d_][r] *= wsf[crow(r, hi)]; } } while (0)
  f32x16 pA0, pA1, pB0, pB1;
  int sl_prev = 0, sl_cur = 0, sl_next = SLOTB;
  #define ROT() do { sl_prev = sl_cur; sl_cur = sl_next; sl_next = (sl_next == (NSLOT - 1) * SLOTB) ? 0 : sl_next + SLOTB; } while (0)
  DMA_K(2, 2 * SLOTB);
  WAIT_BAR(3);
  qkt(pA0, pA1, shm3 + LDS_K, qr, ax0, ax1, bx, r32, hi); asm volatile("s_nop 15\n\ts_nop 7" : "+v"(pA0), "+v"(pA1)); CMASK(pA0, pA1, 0);
  START(pA0, pA1);
  _Pragma("unroll") for (int r = 0; r < 16; ++r) pA1[r] = __builtin_amdgcn_exp2f(pA1[r]);
  WAIT_BAR(0);
  DMA_K(3, 0); DMA_V(1, SLOTB);
  ROT();
  kload8(kf, kp0 + sl_cur); ax0.x = etab[64 + r32]; ax1.x = etab[96 + r32];
  WAIT_BAR(2);
  s16x4 vlo[8], vhi[8]; u32x4 pw0, pw1, pw2, pw3;
  #define PKW(P, B) cvtpk_s(P[B], P[B + 1])
  #define PAF(k) __builtin_bit_cast(bf16x8, pw##k)
  #define VFR(i) (bf16x8){vlo[i][0], vlo[i][1], vlo[i][2], vlo[i][3], vhi[i][0], vhi[i][1], vhi[i][2], vhi[i][3]}
  #define PIN(x) asm volatile("" : "+v"(x))
  #define MX3(a, b, c) __builtin_fmaxf(__builtin_fmaxf((a), (b)), (c))
  #define GAPA(MF, A0, A1, A2, A3, W0, W1, PW) do { MF; sacc += A0; sacc += A1; sacc += A2; sacc += A3; PIN(sacc); W0; W1; PIN(PW); SBAR(); } while (0)
  #define EX(v) __builtin_amdgcn_exp2f(v)
  #define GAPB(MF, X, B) do { MF; X[B] = EX(X[B]); X[B + 1] = EX(X[B + 1]); X[B + 2] = EX(X[B + 2]); X[B + 3] = EX(X[B + 3]); PIN(X); SBAR(); } while (0)
  #define VRD(i) do { vlo[i] = vtr(vp_ + (((i) >> 2) * 4096 + ((i) & 3) * 1024)); vhi[i] = vtr(vp_ + (((i) >> 2) * 4096 + ((i) & 3) * 1024 + 512)); } while (0)
  #define KRD(G, j) do { if (G) { kload2(kf, kp0 + sl_next, j); SBAR(); } } while (0)
  #define ERD(G, t) do { if (G) { ax0.x = etab[((t) + 1) * 64 + r32]; ax1.x = etab[((t) + 1) * 64 + 32 + r32]; SBAR(); } } while (0)
  #define STEP(C0, C1, P0, P1, t, GK, GV, GL) do { SBAR(); \
    const lds_cptr vp_ = vp0 + sl_prev; \
    VRD(0); SBAR(); float sacc = (P0[0] + P0[1]); \
    C0 = MFMA8(ax0, bx, f32x16{}); C1 = MFMA8(ax1, bx, f32x16{}); SBAR(); \
    GAPA(C0 = __builtin_amdgcn_mfma_f32_32x32x16_bf16(kf[0], qr[0], C0, 0, 0, 0), P0[2], P0[3], P0[4], P0[5],     pw0[0] = PKW(P0, 0), pw0[1] = PKW(P0, 2), pw0); \
    VRD(4); SBAR(); GAPA(C1 = __builtin_amdgcn_mfma_f32_32x32x16_bf16(kf[1], qr[0], C1, 0, 0, 0), P0[6], P0[7], P0[8], P0[9],     pw0[2] = PKW(P0, 4), pw0[3] = PKW(P0, 6), pw0); \
    VRD(1); SBAR(); GAPA(C0 = __builtin_amdgcn_mfma_f32_32x32x16_bf16(kf[2], qr[1], C0, 0, 0, 0),   P0[10], P0[11], P0[12], P0[13], pw1[0] = PKW(P0, 8), pw1[1] = PKW(P0, 10), pw1); \
    VRD(5); SBAR(); GAPA(C1 = __builtin_amdgcn_mfma_f32_32x32x16_bf16(kf[3], qr[1], C1, 0, 0, 0),   P0[14], P0[15], P1[0], P1[1],   pw1[2] = PKW(P0, 12), pw1[3] = PKW(P0, 14), pw1); \
    VRD(2); SBAR(); GAPA(C0 = __builtin_amdgcn_mfma_f32_32x32x16_bf16(kf[4], qr[2], C0, 0, 0, 0),   P1[2], P1[3], P1[4], P1[5],     pw2[0] = PKW(P1, 0), pw2[1] = PKW(P1, 2), pw2); \
    VRD(6); SBAR(); GAPA(C1 = __builtin_amdgcn_mfma_f32_32x32x16_bf16(kf[5], qr[2], C1, 0, 0, 0),   P1[6], P1[7], P1[8], P1[9],     pw2[2] = PKW(P1, 4), pw2[3] = PKW(P1, 6), pw2); \
    VRD(3); SBAR(); GAPA(C0 = __builtin_amdgcn_mfma_f32_32x32x16_bf16(kf[6], qr[3], C0, 0, 0, 0),   P1[10], P1[11], P1[12], P1[13], pw3[0] = PKW(P1, 8), pw3[1] = PKW(P1, 10), pw3); \
    VRD(7); SBAR(); GAPA(C1 = __builtin_amdgcn_mfma_f32_32x32x16_bf16(kf[7], qr[3], C1, 0, 0, 0),   P1[14], P1[15], 0.f, 0.f,       pw3[2] = PKW(P1, 12), pw3[3] = PKW(P1, 14), pw3); \
    l_reg += sacc; \
    if (GK) { DMA_K((t) + 3, sl_cur); } if (GV) { DMA_V((t) + 1, sl_next); } \
    CMASK(C0, C1, t); \
    { float a = MX3(C0[0], C0[1], C1[0]), b = MX3(C0[2], C0[3], C1[1]); a = MX3(a, C1[2], C1[3]); \
      _Pragma("unroll") for (int r = 4; r < 16; r += 4) { a = MX3(a, C0[r], C0[r + 1]); b = MX3(b, C0[r + 2], C0[r + 3]); a = MX3(a, C1[r], C1[r + 1]); b = MX3(b, C1[r + 2], C1[r + 3]); } \
      float rm = __builtin_fmaxf(a, b); { auto rr = __builtin_amdgcn_permlane32_swap(__float_as_uint(rm), __float_as_uint(rm), false, false); rm = __builtin_fmaxf(__uint_as_float(rr[0]), __uint_as_float(rr[1])); } \
      resc = false; \
      if (__builtin_expect(__any(rm > (float)THRL), 0)) { const float old_ = CURREF(); SETREF(old_ + __builtin_fmaxf(rm, 0.f)); const float dl = CURREF() - old_; \
        _Pragma("unroll") for (int r = 0; r < 16; ++r) { C0[r] -= dl; C1[r] -= dl; } \
        const float f = __builtin_amdgcn_exp2f(-dl); l_reg *= f; if (hi == 0) wsf[r32] = f; resc = true; } } \
    SBAR(); \
    GAPB(o[0] = __builtin_amdgcn_mfma_f32_32x32x16_bf16(PAF(0), VFR(0), o[0], 0, 0, 0), C0, 0); \
    GAPB(o[1] = __builtin_amdgcn_mfma_f32_32x32x16_bf16(PAF(0), VFR(4), o[1], 0, 0, 0), C0, 4); \
    KRD(GL, 0); GAPB(o[0] = __builtin_amdgcn_mfma_f32_32x32x16_bf16(PAF(1), VFR(1), o[0], 0, 0, 0), C0, 8); \
    KRD(GL, 1); GAPB(o[1] = __builtin_amdgcn_mfma_f32_32x32x16_bf16(PAF(1), VFR(5), o[1], 0, 0, 0), C0, 12); \
    KRD(GL, 2); GAPB(o[0] = __builtin_amdgcn_mfma_f32_32x32x16_bf16(PAF(2), VFR(2), o[0], 0, 0, 0), C1, 0); \
    KRD(GL, 3); GAPB(o[1] = __builtin_amdgcn_mfma_f32_32x32x16_bf16(PAF(2), VFR(6), o[1], 0, 0, 0), C1, 4); \
    ERD(GL, t); GAPB(o[0] = __builtin_amdgcn_mfma_f32_32x32x16_bf16(PAF(3), VFR(3), o[0], 0, 0, 0), C1, 8); \
    GAPB(o[1] = __builtin_amdgcn_mfma_f32_32x32x16_bf16(PAF(3), VFR(7), o[1], 0, 0, 0), C1, 12); \
    } while (0)
  int t = 1;
  #undef CMASK
  #define CMASK(P0, P1, t) do {} while (0)
  for (; t + 5 < NT; t += 2) {
    STEP(pB0, pB1, pA0, pA1, t, true, true, true);     WAIT_BAR(2); RESC(); ROT();
    STEP(pA0, pA1, pB0, pB1, t + 1, true, true, true); WAIT_BAR(2); RESC(); ROT();
  }
  #undef CMASK
  #define CMASK(P0, P1, t) do { int jb_ = (t) - (NT - 4); if (jb_ >= 0) { int l_ = lane; asm volatile("" : "+v"(l_)); cmask(P0, P1, jb_, wid * QBLK + (l_ & 31), l_ >> 5); } } while (0)
  #define ENDW(tt) do { if ((tt) + 3 < NT) { WAIT_BAR(2); } else if ((tt) + 2 < NT) { WAIT_BAR(1); } else { WAIT_BAR(0); } } while (0)
  for (; t + 1 < NT; t += 2) {
    STEP(pB0, pB1, pA0, pA1, t, (t + 3 < NT), (t + 1 < NT), (t + 1 < NT));         ENDW(t);     RESC(); ROT();
    STEP(pA0, pA1, pB0, pB1, t + 1, (t + 4 < NT), (t + 2 < NT), (t + 2 < NT));     ENDW(t + 1); RESC(); ROT();
  }
  STEP(pB0, pB1, pA0, pA1, NT - 1, false, false, false); RESC();
  { float sacc = pB0[0] + pB0[1]; _Pragma("unroll") for (int r = 2; r < 16; ++r) sacc += pB0[r]; _Pragma("unroll") for (int r = 0; r < 16; ++r) sacc += pB1[r]; l_reg += sacc;
    pw0 = (u32x4){PKW(pB0, 0), PKW(pB0, 2), PKW(pB0, 4), PKW(pB0, 6)}; pw1 = (u32x4){PKW(pB0, 8), PKW(pB0, 10), PKW(pB0, 12), PKW(pB0, 14)}; pw2 = (u32x4){PKW(pB1, 0), PKW(pB1, 2), PKW(pB1, 4), PKW(pB1, 6)}; pw3 = (u32x4){PKW(pB1, 8), PKW(pB1, 10), PKW(pB1, 12), PKW(pB1, 14)};
    int lane_d = lane; asm volatile("" : "+v"(lane_d));
    const int vb0 = (int)(lds0 + LDS_V) + ((lane_d >> 4) & 1) * 32 + (lane_d & 3) * 8 + (4 * (lane_d >> 5) + ((lane_d & 15) >> 2)) * 64;
    SBAR(); pv(o, vb0 + sl_cur, PAF(0), PAF(1), PAF(2), PAF(3)); }
  #undef PKW
  #undef PAF
  #undef VFR
  #undef PIN
  #undef MX3
  #undef GAPA
  #undef GAPB
  #undef EX
  #undef VRD
  #undef KRD
  #undef ERD
  #undef STEP
  #undef ENDW
  { auto rr = __builtin_amdgcn_permlane32_swap(__float_as_uint(l_reg), __float_as_uint(l_reg), false, false); l_reg = __uint_as_float(rr[0]) + __uint_as_float(rr[1]); }
  if (hi == 0) wsf[32 + r32] = l_reg; asm volatile("s_waitcnt lgkmcnt(0)" ::: "memory");
  float rli[16];
  #pragma unroll
  for (int r = 0; r < 16; ++r) rli[r] = __builtin_amdgcn_rcpf(wsf[32 + crow(r, hi)]);
  bf16* Ow = Ob + (long)(wid * QBLK) * LDO;
  int lane_e = lane; asm volatile("" : "+v"(lane_e));
  { FXL bf16* stg = (FXL bf16*)(shm + LDS_OST) + wid * 2048;
    #pragma unroll
    for (int r = 0; r < 16; ++r) { const int orow = crow(r, hi);
      #pragma unroll
      for (int d0 = 0; d0 < 2; ++d0) stg[orow * 64 + d0 * 32 + r32] = att::f2bf(o[d0][r] * rli[r]); }
    asm volatile("s_waitcnt lgkmcnt(0)" ::: "memory");
    #pragma unroll
    for (int i = 0; i < 4; ++i) { const int row = i * 8 + (lane_e >> 3), ch = lane_e & 7; const u32x4 v = *(const FXL u32x4*)(stg + row * 64 + ch * 8); *(u32x4*)(Ow + (long)row * LDO + ch * 8) = v; } }
  asm volatile("s_waitcnt lgkmcnt(0)\n\ts_barrier" ::: "memory");
  #undef DMA_K
  #undef DMA_V
  #undef CMASK
  #undef SETREF
  #undef CURREF
  #undef START
  #undef RESC
  #undef ROT
}
#undef SBAR
#undef WAIT_BAR
#undef MFMA8
#undef FXL
}
namespace attd {
using att::bf16; using att::bf16x8; using att::f32x16; using att::crow;
#define LDS3 __attribute__((address_space(3)))
#define ASBAR() __builtin_amdgcn_sched_barrier(0)
template <int DQK, int DV> struct Geo {
    static constexpr int SHM_K = 64 * DQK * 2, SHM_V = 64 * DV * 2, NCB = DV / 32;
    static constexpr int WS_OFF = 3 * SHM_V + 3 * SHM_K, TAB_OFF = WS_OFF + 2048, EXT_OFF = TAB_OFF + 512, EXT_PITCH = 2080, BYTES = TAB_OFF + 12288;
};
__device__ __forceinline__ void dma16(const void* sbase, unsigned voff, unsigned lds_dst) { unsigned keep;
    asm volatile("s_mov_b32 %0, m0\n\ts_mov_b32 m0, %2\n\ts_nop 0\n\tglobal_load_lds_dwordx4 %1, %3\n\ts_mov_b32 m0, %0" : "=&s"(keep) : "v"(voff), "s"(lds_dst), "s"(sbase) : "memory"); }
typedef unsigned u32x2 __attribute__((ext_vector_type(2)));
typedef short v4i16_t __attribute__((ext_vector_type(4)));
constexpr unsigned ONES = 0x3F803F80u;
#define ATD_MFMA8(a, b, c) __builtin_amdgcn_mfma_f32_32x32x8bf16_1k(__builtin_bit_cast(v4i16_t, a), __builtin_bit_cast(v4i16_t, b), c, 0, 0, 0)
__device__ __forceinline__ float quant2(float v, unsigned& pk) { const unsigned h = att::f2bf(v); const float hf = __builtin_bit_cast(float, h << 16); const unsigned l = att::f2bf(v - hf);
    pk = h | (l << 16); return hf + __builtin_bit_cast(float, l << 16); }
template <int DQK> __device__ __forceinline__ void qkt_ref(f32x16& p0, f32x16& p1, const LDS3 char* Ks, const bf16x8* qr, int r32, int hi, u32x2 ax, u32x2 bx) {
    p0 = ATD_MFMA8(ax, bx, f32x16{}); p1 = ATD_MFMA8(ax, bx, f32x16{});
#pragma unroll
    for (int d0 = 0; d0 < DQK / 16; ++d0) { const int cb = (d0 * 16 + hi * 8) * 2;
        const bf16x8 b0 = *(const LDS3 bf16x8*)(Ks + att::kswz<DQK>(r32, cb));
        const bf16x8 b1 = *(const LDS3 bf16x8*)(Ks + att::kswz<DQK>(32 + r32, cb));
        p0 = __builtin_amdgcn_mfma_f32_32x32x16_bf16(b0, qr[d0], p0, 0, 0, 0);
        p1 = __builtin_amdgcn_mfma_f32_32x32x16_bf16(b1, qr[d0], p1, 0, 0, 0); }
}
__device__ __forceinline__ float rowmax32(const f32x16& p0, const f32x16& p1) {
    float a = __builtin_fmaxf(__builtin_fmaxf(p0[0], p0[1]), p1[0]), b = __builtin_fmaxf(__builtin_fmaxf(p0[2], p0[3]), p1[1]); a = __builtin_fmaxf(__builtin_fmaxf(a, p1[2]), p1[3]);
#pragma unroll
    for (int r = 4; r < 16; r += 4) { a = __builtin_fmaxf(__builtin_fmaxf(a, p0[r]), p0[r + 1]); b = __builtin_fmaxf(__builtin_fmaxf(b, p0[r + 2]), p0[r + 3]); a = __builtin_fmaxf(__builtin_fmaxf(a, p1[r]), p1[r + 1]); b = __builtin_fmaxf(__builtin_fmaxf(b, p1[r + 2]), p1[r + 3]); }
    float m = __builtin_fmaxf(a, b);
    auto rr = __builtin_amdgcn_permlane32_swap(__float_as_uint(m), __float_as_uint(m), false, false);
    return __builtin_fmaxf(__uint_as_float(rr[0]), __uint_as_float(rr[1]));
}
__device__ __forceinline__ void bias_t5(f32x16& p0, f32x16& p1, const LDS3 char* ext, int dq) {
    const int B = dq - 3 + 256, sft = B & 3; const LDS3 char* e0 = ext + sft * 2080 + (B - sft) * 4;
#pragma unroll
    for (int g4 = 0; g4 < 4; ++g4) { const att::f32x4 v0 = *(const LDS3 att::f32x4*)(e0 - 32 * g4), v1 = *(const LDS3 att::f32x4*)(e0 - 32 * g4 - 128);
#pragma unroll
        for (int i = 0; i < 4; ++i) { p0[4 * g4 + i] += v0[3 - i]; p1[4 * g4 + i] += v1[3 - i]; } }
}
template <int NCB> __device__ __forceinline__ void pv_pipe(f32x16* o, int vb, bf16x8 pa0, bf16x8 pa1, bf16x8 pa2, bf16x8 pa3) {
    att::s16x4 l[2][4], h[2][4];
#define ATD_RD(D, S) do { l[S][0] = att::tr_read<att::v_rd_off<NCB>(D, 0, 0)>(vb); h[S][0] = att::tr_read<att::v_rd_off<NCB>(D, 0, 1)>(vb); l[S][1] = att::tr_read<att::v_rd_off<NCB>(D, 1, 0)>(vb); h[S][1] = att::tr_read<att::v_rd_off<NCB>(D, 1, 1)>(vb); \
        l[S][2] = att::tr_read<att::v_rd_off<NCB>(D, 2, 0)>(vb); h[S][2] = att::tr_read<att::v_rd_off<NCB>(D, 2, 1)>(vb); l[S][3] = att::tr_read<att::v_rd_off<NCB>(D, 3, 0)>(vb); h[S][3] = att::tr_read<att::v_rd_off<NCB>(D, 3, 1)>(vb); } while (0)
#define ATD_PKV(S, K) (bf16x8){l[S][K][0], l[S][K][1], l[S][K][2], l[S][K][3], h[S][K][0], h[S][K][1], h[S][K][2], h[S][K][3]}
#define ATD_MM(D, S) do { o[D] = __builtin_amdgcn_mfma_f32_32x32x16_bf16(pa0, ATD_PKV(S, 0), o[D], 0, 0, 0); o[D] = __builtin_amdgcn_mfma_f32_32x32x16_bf16(pa1, ATD_PKV(S, 1), o[D], 0, 0, 0); \
        o[D] = __builtin_amdgcn_mfma_f32_32x32x16_bf16(pa2, ATD_PKV(S, 2), o[D], 0, 0, 0); o[D] = __builtin_amdgcn_mfma_f32_32x32x16_bf16(pa3, ATD_PKV(S, 3), o[D], 0, 0, 0); } while (0)
    static_assert(NCB == 4, "four column blocks");
    ATD_RD(0, 0); ATD_RD(1, 1); asm volatile("s_waitcnt lgkmcnt(8)" ::: "memory"); ASBAR(); ATD_MM(0, 0); ASBAR();
    ATD_RD(2, 0); asm volatile("s_waitcnt lgkmcnt(8)" ::: "memory"); ASBAR(); ATD_MM(1, 1); ASBAR();
    ATD_RD(3, 1); asm volatile("s_waitcnt lgkmcnt(8)" ::: "memory"); ASBAR(); ATD_MM(2, 0); ASBAR();
    asm volatile("s_waitcnt lgkmcnt(0)" ::: "memory"); ASBAR(); ATD_MM(3, 1); ASBAR();
#undef ATD_RD
#undef ATD_PKV
#undef ATD_MM
}
template <int DQK, int DV, int MODE, int LDQ, int LDK, int LDO>
__device__ __forceinline__ void attn_unit(const bf16* __restrict__ Qb, const bf16* __restrict__ Kh, const bf16* __restrict__ Vh, bf16* __restrict__ Ob, int NT, int q0, LDS3 char* lds) {
    using G = Geo<DQK, DV>;
    constexpr int SHM_K = G::SHM_K, SHM_V = G::SHM_V, NCB = G::NCB, NKP = SHM_K / 8192, NVP = SHM_V / 8192, NI = NKP + NVP;
    constexpr int RPP = 1024 / (DQK * 2), LPR = DQK * 2 / 16;
    static_assert(MODE == 0 || MODE == 2, "modes 0 and 2");
    const int tid = threadIdx.x, wid = __builtin_amdgcn_readfirstlane(tid >> 6), lane = tid & 63, r32 = lane & 31, hi = lane >> 5;
    LDS3 char* V_lds = lds; LDS3 char* K_lds = lds + 3 * SHM_V;
    LDS3 float* ws = (LDS3 float*)(lds + G::WS_OFF) + wid * 64; LDS3 float* li_l = ws; LDS3 float* al_l = ws + 32;
    const LDS3 float* tab = (const LDS3 float*)(lds + G::TAB_OFF);
    const int q0w = q0 + wid * 32, qabs = q0w + r32;
    float b31 = 0.f;
    if constexpr (MODE == 2) b31 = tab[127];
    float m_reg = -1e30f, l_reg = 0; f32x16 o[NCB]; bf16x8 qr[DQK / 16];
    const u32x2 ax = {hi ? 0u : ONES, 0u};
    u32x2 bx = {0u, 0u};
    float refq = 0.f, cad = 0.f;
    const LDS3 char* ext = (const LDS3 char*)lds + G::EXT_OFF;
#pragma unroll
    for (int d = 0; d < NCB; ++d) o[d] = f32x16{};
    const bf16* Qw = Qb + (long)(wid * 32 + r32) * LDQ + hi * 8;
#pragma unroll
    for (int d0 = 0; d0 < DQK / 16; ++d0) qr[d0] = *reinterpret_cast<const bf16x8*>(Qw + d0 * 16);
    unsigned kgo[NKP], vgo[NVP];
#pragma unroll
    for (int i = 0; i < NKP; ++i) { const int p = wid + 8 * i, row = p * RPP + lane / LPR, c = (lane % LPR) ^ (row & 7); kgo[i] = (unsigned)(row * LDK + c * 8) * 2u; }
#pragma unroll
    for (int i = 0; i < NVP; ++i) { const int p = wid + 8 * i, s = 2 * p + (lane >> 5), kk = (s / NCB) * 8 + ((lane & 31) >> 2), k = (kk & ~0xC) | ((kk & 4) << 1) | ((kk & 8) >> 1), c = (s % NCB) * 32 + (lane & 3) * 8;
        vgo[i] = (unsigned)(k * LDK + c) * 2u; }
    const unsigned lds0 = (unsigned)(uintptr_t)lds, kd0 = lds0 + 3 * SHM_V + wid * 1024, vd0 = lds0 + wid * 1024;
    const int vb0 = (int)lds0 + att::v_rd_base(lane);
#define ATD_DMA_K(t, slot) do { _Pragma("unroll") for (int i_ = 0; i_ < NKP; ++i_) dma16(Kh + (long)(t) * 64 * LDK, kgo[i_], (unsigned)__builtin_amdgcn_readfirstlane(kd0 + (slot) * SHM_K + i_ * 8192)); } while (0)
#define ATD_DMA_V(t, slot) do { _Pragma("unroll") for (int i_ = 0; i_ < NVP; ++i_) dma16(Vh + (long)(t) * 64 * LDK, vgo[i_], (unsigned)__builtin_amdgcn_readfirstlane(vd0 + (slot) * SHM_V + i_ * 8192)); } while (0)
#define ATD_WAITBAR(N) asm volatile("s_waitcnt vmcnt(%0) lgkmcnt(0)\n\ts_barrier" :: "n"(N) : "memory")
#define ATD_RESC(a) do { if (__any((a) < 1.f)) { if (hi == 0) al_l[r32] = (a); asm volatile("s_waitcnt lgkmcnt(0)" ::: "memory"); \
    _Pragma("unroll") for (int d = 0; d < NCB; ++d) _Pragma("unroll") for (int r = 0; r < 16; ++r) o[d][r] *= al_l[crow(r, hi)]; } } while (0)
    f32x16 pA0, pA1, pB0, pB1; float alA, alB; bf16x8 pa0, pa1, pa2, pa3;
    int s_prev = 2, s_cur = 0, s_next = 1;
#define ATD_ROT() do { const int t_ = s_prev; s_prev = s_cur; s_cur = s_next; s_next = t_; } while (0)
#define ATD_SETSHIFT(S_) do { unsigned pk_; refq = -quant2(-(S_), pk_); bx.x = hi ? 0u : pk_; asm volatile("" : "+v"(bx)); } while (0)
#define ATD_CADD(kt) do { if constexpr (MODE == 2) { const float c_ = att::t5_far<MODE>((kt), q0w) ? b31 : 0.f; if (c_ != cad) { ATD_SETSHIFT(refq + cad - c_); cad = c_; } } } while (0)
#define ATD_BIAS(P0, P1, kt) do { if constexpr (MODE == 2) { if (!att::t5_far<MODE>((kt), q0w)) bias_t5(P0, P1, ext, qabs - (kt) * 64 - 4 * hi); } } while (0)
#define ATD_PSM(FIRST_, P0, P1, AL) do { if constexpr (MODE == 0) { att::partialSM_abs(P0, P1, m_reg, AL, 0.f); } else { const float pm_ = rowmax32(P0, P1); AL = 1.f; \
        if (FIRST_ || !__builtin_expect(__all(pm_ <= att::THR2), 1)) { const float old_ = refq, dl0_ = FIRST_ ? pm_ : fmaxf(pm_, 0.f); ATD_SETSHIFT(old_ + dl0_); const float dl_ = refq - old_; \
            if (!FIRST_) AL = __builtin_amdgcn_exp2f(-dl_); \
            _Pragma("unroll") for (int r = 0; r < 16; ++r) { P0[r] -= dl_; P1[r] -= dl_; } } \
        _Pragma("unroll") for (int r = 0; r < 16; ++r) P0[r] = __builtin_amdgcn_exp2f(P0[r]); } } while (0)
#define ATD_QKT(C0, C1, KS) do { if constexpr (MODE == 0) att::qkt<DQK, false>(C0, C1, KS, qr, r32, hi, f32x16{}); else qkt_ref<DQK>(C0, C1, KS, qr, r32, hi, ax, bx); } while (0)
#define ATD_STEP(C0, C1, ALC, P0, P1, ALP, j) do { \
        if ((j) + 1 < NT) ATD_WAITBAR(NI); else ATD_WAITBAR(0); \
        if ((j) + 2 < NT) ATD_DMA_K((j) + 2, s_prev); if ((j) + 1 < NT) ATD_DMA_V((j) + 1, s_next); \
        ATD_CADD(j); ASBAR(); ATD_QKT(C0, C1, K_lds + s_cur * SHM_K); \
        att::finishSM(P0, P1, ALP, l_reg, pa0, pa1, pa2, pa3); ASBAR(); \
        pv_pipe<NCB>(o, vb0 + s_prev * SHM_V, pa0, pa1, pa2, pa3); ATD_BIAS(C0, C1, (j)); ATD_PSM(false, C0, C1, ALC); \
        ATD_RESC(ALC); ATD_ROT(); } while (0)
    ATD_DMA_K(0, 0); ATD_DMA_V(0, 0); ATD_DMA_K(1, 1);
    ATD_WAITBAR(NI);
    if (2 < NT) ATD_DMA_K(2, 2); ATD_DMA_V(1, 1);
    ATD_CADD(0); ATD_QKT(pA0, pA1, K_lds); ATD_BIAS(pA0, pA1, 0); ATD_PSM(true, pA0, pA1, alA);
    ATD_ROT();
    int j = 1;
    for (; j + 1 < NT; j += 2) {
        ATD_STEP(pB0, pB1, alB, pA0, pA1, alA, j);
        ATD_STEP(pA0, pA1, alA, pB0, pB1, alB, j + 1);
    }
    ATD_STEP(pB0, pB1, alB, pA0, pA1, alA, j);
    att::finishSM(pB0, pB1, alB, l_reg, pa0, pa1, pa2, pa3); ASBAR();
    pv_pipe<NCB>(o, vb0 + s_prev * SHM_V, pa0, pa1, pa2, pa3);
    if (hi == 0) li_l[r32] = l_reg; asm volatile("s_waitcnt lgkmcnt(0)" ::: "memory");
    float rli[16];
#pragma unroll
    for (int r = 0; r < 16; ++r) rli[r] = __builtin_amdgcn_rcpf(li_l[crow(r, hi)]);
    bf16* Ow = Ob + (long)(wid * 32) * LDO;
#pragma unroll
    for (int r = 0; r < 16; ++r) { const int orow = crow(r, hi);
#pragma unroll
        for (int d0 = 0; d0 < NCB; ++d0) Ow[(long)orow * LDO + d0 * 32 + r32] = att::f2bf(o[d0][r] * rli[r]); }
    asm volatile("s_waitcnt lgkmcnt(0)\n\ts_barrier" ::: "memory");
#undef ATD_DMA_K
#undef ATD_DMA_V
#undef ATD_WAITBAR
#undef ATD_RESC
#undef ATD_ROT
#undef ATD_PSM
#undef ATD_QKT
#undef ATD_SETSHIFT
#undef ATD_CADD
#undef ATD_BIAS
#undef ATD_STEP
}
#undef ATD_MFMA8
#undef ASBAR
#undef LDS3
}

#define GAS __attribute__((address_space(1)))
#define LAS __attribute__((address_space(3)))
typedef unsigned short bf16;
typedef unsigned v4u __attribute__((ext_vector_type(4)));
typedef float f32x4 __attribute__((ext_vector_type(4)));
typedef short bf16x8 __attribute__((ext_vector_type(8)));
typedef GAS unsigned gu32;
typedef GAS unsigned long long gu64;
#define RLX_AGENT __ATOMIC_RELAXED, __HIP_MEMORY_SCOPE_AGENT
#define LDS_WAIT() asm volatile("s_waitcnt lgkmcnt(0)" ::: "memory")
#define VM_WAIT() asm volatile("s_waitcnt vmcnt(0)" ::: "memory")
__device__ __forceinline__ unsigned long long rt() { return __builtin_amdgcn_s_memrealtime(); }
__device__ __forceinline__ unsigned f2bf(float f) { unsigned u = __builtin_bit_cast(unsigned, f); return (u + 0x7fffu + ((u >> 16) & 1u)) >> 16; }
__device__ __forceinline__ unsigned pk2(float lo, float hi) { return f2bf(lo) | (f2bf(hi) << 16); }

#define XB_TMO      128
#define XB_XCNT(j)  (256  + 64 * (j))
#define XB_XSUB(j)  (1280 + 64 * (j))
#define XB_XGEN(j)  (2304 + 64 * (j))
#define XB_TOP      3328
#define XB_TOPGEN   3392
#define XCD_BAR_WORDS 3456
#define XB_SPIN_CAP (1u << 18)

__device__ __forceinline__ unsigned xb_ld(unsigned* p)              { return __hip_atomic_load(p, __ATOMIC_RELAXED, __HIP_MEMORY_SCOPE_AGENT); }
__device__ __forceinline__ unsigned xb_add(unsigned* p, unsigned v) { return __hip_atomic_fetch_add(p, v, __ATOMIC_RELAXED, __HIP_MEMORY_SCOPE_AGENT); }
__device__ __forceinline__ unsigned xb_xcc_id() { return (unsigned)__builtin_amdgcn_s_getreg((3 << 11) | 20) & 0xFu; }
#define XB_SPIN(cond, bar) do { unsigned _sp = 0; while (cond) { __builtin_amdgcn_s_sleep(1); \
    if ((++_sp & 255u) == 0u) { if (xb_ld(&(bar)[XB_TMO])) break; if (_sp > XB_SPIN_CAP) { atomicAdd(&(bar)[XB_TMO], 1u); break; } } } } while (0)

struct XcdBarrier {
    unsigned* bar; unsigned x;
    volatile LAS unsigned* st;
};

__device__ __forceinline__ XcdBarrier xcd_barrier_post(unsigned* bar, volatile LAS unsigned* st) {
    XcdBarrier b; b.bar = bar; b.x = xb_xcc_id(); b.st = st;
    if (threadIdx.x == 0) (void)xb_add(&bar[XB_XCNT(b.x)], 1u);
    return b;
}
__device__ __forceinline__ void xcd_barrier_complete(unsigned* bar, unsigned x, unsigned& nloc, unsigned& nx) {
    const unsigned G = gridDim.x * gridDim.y * gridDim.z;
    unsigned sum, cnt, mine, sp = 0u;
    for (;;) {
        sum = 0u; cnt = 0u; mine = 0u;
#pragma unroll
        for (unsigned j = 0; j < 16; ++j) { const unsigned c = xb_ld(&bar[XB_XCNT(j)]); sum += c; cnt += (c > 0u) ? 1u : 0u; mine = (j == x) ? c : mine; }
        if (sum == G) break;
        __builtin_amdgcn_s_sleep(1);
        if ((++sp & 255u) == 0u) { if (xb_ld(&bar[XB_TMO])) break; if (sp > XB_SPIN_CAP) { atomicAdd(&bar[XB_TMO], 1u); break; } }
    }
    nloc = mine > 0u ? mine : 1u; nx = cnt > 0u ? cnt : 1u;
}

__device__ __forceinline__ void xcd_barrier(const XcdBarrier& b) {
    asm volatile("s_waitcnt vmcnt(0)" ::: "memory");
    __syncthreads();
    if (threadIdx.x == 0) {
        unsigned* bar = b.bar;
        __builtin_amdgcn_s_waitcnt(0);
        unsigned nloc = b.st[0], nx = b.st[1];
        if (nloc == 0u) { xcd_barrier_complete(bar, b.x, nloc, nx); b.st[0] = nloc; b.st[1] = nx; }
        const unsigned old = xb_add(&bar[XB_XSUB(b.x)], 1u);
        asm volatile("buffer_inv sc1" ::: "memory");
        const unsigned gen = old / nloc;
        if (old + 1u == (gen + 1u) * nloc) {
            __builtin_amdgcn_fence(__ATOMIC_RELEASE, "agent");
            asm volatile("s_waitcnt vmcnt(0)" ::: "memory");
            const unsigned og = xb_add(&bar[XB_TOP], 1u);
            const unsigned tg = og / nx;
            if (og + 1u == (tg + 1u) * nx) xb_add(&bar[XB_TOPGEN], 1u);
            else XB_SPIN(xb_ld(&bar[XB_TOPGEN]) == tg, bar);
            asm volatile("" ::: "memory");
            xb_add(&bar[XB_XGEN(b.x)], 1u);
            asm volatile("s_waitcnt vmcnt(0)" ::: "memory");
        } else {
            XB_SPIN(xb_ld(&bar[XB_XGEN(b.x)]) == gen, bar);
            asm volatile("" ::: "memory");
            asm volatile("s_waitcnt vmcnt(0)" ::: "memory");
        }
    }
    __syncthreads();
}

constexpr int NWAVES = 8;
#ifndef FFN_FP8
#define FFN_FP8 2
#endif
#ifndef MK_PER_PHASE
#define MK_PER_PHASE 0
#endif
constexpr int BATCH = 8, SEQ = 2048, D = 1024, M = BATCH * SEQ, MEMLEN = 256, MMEM = BATCH * MEMLEN;
constexpr int EV_SRC_N = 2568, PW = 2560  , OD_SRC_N = 3072;
constexpr int FF = 2816, FE = 3584, NE = 8, XW = 512;
constexpr int PAIR_ROWS = 2 * M + NE * 256;
constexpr float EPS = 1e-6f;
constexpr float LOG2E = 1.4426950408889634f;
constexpr float C2_64 = 0.125f * LOG2E, C2_128 = 0.08838834764831845f * LOG2E;
constexpr float LAM_INIT = 0.35550906759096926f;
constexpr size_t MiB = 1u << 20;
constexpr size_t WS_CTL = 0, CTL_ZERO_BYTES = 32 * 1024;
constexpr size_t WS_W_EVIN = 1 * MiB;
constexpr size_t WS_W_MKV = WS_W_EVIN + 5 * MiB;
constexpr size_t WS_W_EVOUT = WS_W_MKV + 4 * MiB;
constexpr size_t WS_W_XQ = WS_W_EVOUT + 2 * MiB;
constexpr size_t WS_W_XO = WS_W_XQ + 2 * MiB;
constexpr size_t WS_W_F13 = WS_W_XO + 2 * MiB;
constexpr size_t WS_W_F2 = WS_W_F13 + 11 * MiB;
constexpr size_t WS_W_ODIN = WS_W_F2 + 6 * MiB;
constexpr size_t WS_W_ODOUT = WS_W_ODIN + 6 * MiB;
constexpr size_t WS_W_M13 = WS_W_ODOUT + 2 * MiB;
constexpr size_t WS_W_M2 = WS_W_M13 + 112 * MiB;
constexpr size_t WS_XB = WS_W_M2 + 56 * MiB;
constexpr size_t WS_SSQ = WS_XB + 32 * MiB;
constexpr size_t WS_FLOG = WS_SSQ + 1 * MiB;
constexpr size_t WS_C2 = WS_FLOG + 1 * MiB;
constexpr size_t WS_TOK = WS_C2 + 1 * MiB;
constexpr size_t WS_GATE = WS_TOK + 1 * MiB;
constexpr size_t WS_P = WS_GATE + 1 * MiB;
constexpr size_t WS_AG = WS_P + 80 * MiB;
constexpr size_t WS_OD = WS_AG + 32 * MiB;
constexpr size_t WS_MEMN = WS_OD + 32 * MiB;
constexpr size_t WS_KVM = WS_MEMN + 4 * MiB;
constexpr size_t WS_QX = WS_KVM + 8 * MiB;
constexpr size_t WS_OX = WS_QX + 16 * MiB;
constexpr size_t WS_ACT = WS_OX + 16 * MiB;
constexpr size_t WS_Y = WS_ACT + 238 * MiB;
constexpr size_t WS_HG = WS_P;
constexpr size_t WS_XB8 = WS_Y + 68 * MiB;
constexpr size_t WS_END = WS_XB8 + 16 * MiB;
static_assert((size_t)PAIR_ROWS * 1024 * 2 <= 68 * MiB && (size_t)PAIR_ROWS * 3584 * 2 <= 238 * MiB && (size_t)M * PW * 2 <= 80 * MiB, "d_ws map");
constexpr int CW_CNT = 64;
constexpr int CW_NT = 128;
constexpr int CW_TID = 256;
constexpr int CW_TEXP = 1024;
constexpr int CW_BAR = 4096;
static_assert((size_t)(CW_BAR + 3456) * 4 <= CTL_ZERO_BYTES, "control words inside the zeroed range");
constexpr int RING_OFF = 0, RING_BYTES = 131072;
constexpr int TEXP_LDS = RING_BYTES + 2048;
constexpr int LDS_BYTES = 147456;
constexpr int LDSCTL_OFF = LDS_BYTES - 1024, MISC_OFF = LDSCTL_OFF + 320;

struct Args { const float* in[31]; float* out; unsigned char* ws; int ph_lo, ph_hi; };
struct Frame {
    LAS unsigned char* lds;
    volatile LAS unsigned* MISC;
    gu32* ctl;
    int tid, lane, wave;
    int vcu, G;
    const Args* a;
    float* out; unsigned char* ws;
};
#define ROWPIPE(BUF_T, M_, LOAD, PROC) do { BUF_T ra_, rb_; int m_ = gw; if (m_ < (M_)) LOAD(ra_, m_); \
    while (m_ < (M_)) { int n_ = m_ + NGW; if (n_ < (M_)) LOAD(rb_, n_); PROC(ra_, m_); m_ = n_; if (m_ >= (M_)) break; \
        n_ = m_ + NGW; if (n_ < (M_)) LOAD(ra_, n_); PROC(rb_, m_); m_ = n_; } } while (0)
#define ROWPIPE4(BUF_T, M_, LOAD, PROC) do { if (NGW * 8 == (M_)) { BUF_T r0_, r1_, r2_, r3_; const int m_ = gw; \
        LOAD(r0_, m_); LOAD(r1_, m_ + NGW); LOAD(r2_, m_ + 2 * NGW); \
        LOAD(r3_, m_ + 3 * NGW); PROC(r0_, m_); \
        LOAD(r0_, m_ + 4 * NGW); PROC(r1_, m_ + NGW); \
        LOAD(r1_, m_ + 5 * NGW); PROC(r2_, m_ + 2 * NGW); \
        LOAD(r2_, m_ + 6 * NGW); PROC(r3_, m_ + 3 * NGW); \
        LOAD(r3_, m_ + 7 * NGW); PROC(r0_, m_ + 4 * NGW); \
        PROC(r1_, m_ + 5 * NGW); PROC(r2_, m_ + 6 * NGW); PROC(r3_, m_ + 7 * NGW); \
    } else ROWPIPE(BUF_T, M_, LOAD, PROC); } while (0)
struct RowF32 { f32x4 v[4]; };
struct RowBf16 { unsigned long long w[4]; };
#define WS_DPP(v, ctrl) __builtin_bit_cast(float, __builtin_amdgcn_mov_dpp(__builtin_bit_cast(int, (v)), (ctrl), 0xF, 0xF, true))
__device__ __forceinline__ float wave_sum(float v) {
    v += WS_DPP(v, 0xB1);
    v += WS_DPP(v, 0x4E);
    v += WS_DPP(v, 0x141);
    v += WS_DPP(v, 0x140);
    { const auto r = __builtin_amdgcn_permlane16_swap(__float_as_uint(v), __float_as_uint(v), false, false); v = __uint_as_float(r[0]) + __uint_as_float(r[1]); }
    { const auto r = __builtin_amdgcn_permlane32_swap(__float_as_uint(v), __float_as_uint(v), false, false); v = __uint_as_float(r[0]) + __uint_as_float(r[1]); }
    return v;
}
__device__ __forceinline__ float bf2f(unsigned short b) { return __builtin_bit_cast(float, (unsigned)b << 16); }
__device__ __forceinline__ float bflo(unsigned w) { return __builtin_bit_cast(float, w << 16); }
__device__ __forceinline__ float bfhi(unsigned w) { return __builtin_bit_cast(float, w & 0xffff0000u); }

__device__ __forceinline__ unsigned pk4_fp8(float a, float b, float c, float d) { int w = __builtin_amdgcn_cvt_pk_fp8_f32(a, b, 0, false); w = __builtin_amdgcn_cvt_pk_fp8_f32(c, d, w, true); return (unsigned)w; }
#ifndef MOE_Q
#define MOE_Q 40
#endif
constexpr int M13_Q = MOE_Q;
struct XtDesc { const float* W; int ldw, scol0, k0; unsigned char* WT; int K, drow0; const float* gain; float scale; int fp8; };
struct XtRegs { f32x4 v[8]; f32x4 g0, g1; };
#define XT_BAR() asm volatile("s_waitcnt lgkmcnt(0)\n\ts_barrier" ::: "memory")
__device__ __forceinline__ void xt_load(XtRegs& r, const XtDesc& d, int wave, int lane) {
    const int kk = d.k0 + 16 * wave + 8 * (lane >> 5);
    const float* wp = d.W + (size_t)kk * d.ldw + d.scol0 + 4 * (lane & 31);
#pragma unroll
    for (int i = 0; i < 8; ++i) r.v[i] = __builtin_nontemporal_load((const f32x4*)(wp + (size_t)i * d.ldw));
    const float* gp = d.gain ? d.gain + kk : d.W;
    r.g0 = *(const f32x4*)gp; r.g1 = *(const f32x4*)(gp + 4);
}
__device__ __forceinline__ void xt_store(const XtRegs& r, const XtDesc& d, LAS unsigned char* buf, int wave, int lane) {
    const int q = lane & 31, half = lane >> 5, c = 2 * wave + half;
    float g[8] = {r.g0.x, r.g0.y, r.g0.z, r.g0.w, r.g1.x, r.g1.y, r.g1.z, r.g1.w};
#pragma unroll
    for (int i = 0; i < 8; ++i) g[i] = d.gain ? g[i] * d.scale : d.scale;
    if (!d.fp8) {
#pragma unroll
        for (int e = 0; e < 4; ++e) { const int n = 4 * q + e;
            v4u w; w.x = pk2(r.v[0][e] * g[0], r.v[1][e] * g[1]); w.y = pk2(r.v[2][e] * g[2], r.v[3][e] * g[3]); w.z = pk2(r.v[4][e] * g[4], r.v[5][e] * g[5]); w.w = pk2(r.v[6][e] * g[6], r.v[7][e] * g[7]);
            *(LAS v4u*)(buf + n * 256 + ((c ^ (q & 15)) << 4)) = w; }
    } else {
#pragma unroll
        for (int e = 0; e < 4; ++e) { const int n = 4 * q + e;
            const unsigned lo = pk4_fp8(r.v[0][e] * g[0], r.v[1][e] * g[1], r.v[2][e] * g[2], r.v[3][e] * g[3]), hi = pk4_fp8(r.v[4][e] * g[4], r.v[5][e] * g[5], r.v[6][e] * g[6], r.v[7][e] * g[7]);
            *(LAS unsigned long long*)(buf + n * 128 + ((c ^ (2 * (q & 7))) << 3)) = (unsigned long long)lo | ((unsigned long long)hi << 32); }
    }
    XT_BAR();
    if (!d.fp8) {
#pragma unroll
        for (int j = 0; j < 4; ++j) { const int row = 16 * wave + 4 * j + (lane >> 4), p = lane & 15;
            const v4u w = *(const LAS v4u*)(buf + row * 256 + ((p ^ ((row >> 2) & 15)) << 4));
            *(GAS v4u*)((bf16*)d.WT + (size_t)(d.drow0 + row) * d.K + d.k0 + 8 * p) = w; }
    } else {
#pragma unroll
        for (int j = 0; j < 2; ++j) { const int row = 16 * wave + 8 * j + (lane >> 3), p = lane & 7;
            const v4u w = *(const LAS v4u*)(buf + row * 128 + ((p ^ ((row >> 2) & 7)) << 4));
            *(GAS v4u*)(d.WT + (size_t)(d.drow0 + row) * d.K + d.k0 + 16 * p) = w; }
    }
}
template <class DEC> __device__ __forceinline__ void xt_run(Frame& F, int t0, int step, int n, const DEC& dec) {
    if (t0 >= n) return;
    LAS unsigned char* b0 = F.lds + RING_OFF; LAS unsigned char* b1 = b0 + 32768;
    XT_BAR();
    XtRegs A, B; XtDesc dA = dec(t0), dB; xt_load(A, dA, F.wave, F.lane);
    for (int t = t0; t < n; t += 2 * step) {
        const int t1 = t + step, t2 = t + 2 * step;
        dB = dec(t1 < n ? t1 : t); if (t1 >= n) { dB.ldw = 0; dB.k0 = 0; dB.scol0 = 0; dB.gain = nullptr; }
        xt_load(B, dB, F.wave, F.lane);
        xt_store(A, dA, b0, F.wave, F.lane);
        dA = dec(t2 < n ? t2 : t); if (t2 >= n) { dA.ldw = 0; dA.k0 = 0; dA.scol0 = 0; dA.gain = nullptr; }
        xt_load(A, dA, F.wave, F.lane);
        if (t1 < n) xt_store(B, dB, b1, F.wave, F.lane);
    }
    XT_BAR();
}
enum { MAP_ID = 0, MAP_EVIN = 1, MAP_ODIN = 2, MAP_SWIGLU = 3 };
struct XtJob { const float* W; int ldw, K, N, Fh; unsigned char* WT; const float* gain; float scale; int map, fp8; };
__device__ __forceinline__ int xt_job_tiles(const XtJob& j) { return (j.K >> 7) * (j.N >> 7); }
__device__ __forceinline__ XtDesc xt_job_dec(const XtJob& j, int t) {
    const int nnb = j.N >> 7, kb = t / nnb, nb = t % nnb; int scol = 128 * nb; float sc = j.scale;
    if (j.map == MAP_EVIN) { if (nb < 4) sc *= C2_64; scol = nb < 12 ? 128 * nb : 1544 + 128 * (nb - 12); }
    else if (j.map == MAP_ODIN) { if (nb >= 4 && nb < 12) { const int u = nb - 4; scol = 512 + (u & 1) * 512 + (u >> 1) * 128; } else if (nb >= 12) { scol = 1536 + 128 * (nb - 12); if (nb < 16) sc *= C2_64; } }
    else if (j.map == MAP_SWIGLU) scol = (nb & 1) * j.Fh + (nb >> 1) * 128;
    return XtDesc{j.W, j.ldw, scol, 128 * kb, j.WT, j.K, 128 * nb, j.gain, sc, j.fp8};
}
constexpr int MOE_T13 = NE * 8 * 56, MOE_T2 = NE * 28 * 8, MOE_TILES = MOE_T13 + MOE_T2, MOE_TQ = MOE_Q / 4, MOE_SLOT_TILES = (64 + 3 * 128) * MOE_TQ;
static_assert(MOE_SLOT_TILES <= MOE_TILES && MOE_Q % 4 == 0, "expert weight conversion slots");
__device__ __forceinline__ XtDesc moe_dec(const float* W13, const float* W2, unsigned char* ws, int t) {
    if (t < MOE_T13) { const int e = t / 448, r = t % 448, kb = r / 56, nb = r % 56;
        return XtDesc{W13 + (size_t)e * D * 2 * FE, 2 * FE, (nb & 1) * FE + (nb >> 1) * 128, 128 * kb, ws + WS_W_M13 + (size_t)e * 2 * FE * D, D, 128 * nb, nullptr, 64.f, 1}; }
    t -= MOE_T13; const int e = t / 224, r = t % 224, kb = r / 8, nb = r % 8;
    return XtDesc{W2 + (size_t)e * FE * D, D, 128 * nb, 128 * kb, ws + WS_W_M2 + (size_t)e * D * FE, FE, 128 * nb, nullptr, 128.f, 1};
}
constexpr int P0_DENSE_TILES = 64 + 192 + 352 + 176 + 64 + 64 + 64 + 128 + 160;
__device__ __forceinline__ XtDesc p0_dec(Frame& F, int g) {
    unsigned char* ws = F.ws;
    const int moe_first = (F.G == 256) ? MOE_SLOT_TILES : 0, moe_n = MOE_TILES - moe_first;
    if (g < moe_n) return moe_dec(F.a->in[24], F.a->in[25], ws, moe_first + g);
    g -= moe_n;
#define P0_JOB(...) { const XtJob j_{__VA_ARGS__}; const int n_ = xt_job_tiles(j_); if (g < n_) return xt_job_dec(j_, g); g -= n_; }
    P0_JOB(F.a->in[22], D, D, D, 0, ws + WS_W_ODOUT, nullptr, 1.f, MAP_ID, 0)
    P0_JOB(F.a->in[15], OD_SRC_N, D, 3072, 0, ws + WS_W_ODIN, F.a->in[14], 1.f, MAP_ODIN, 0)
    P0_JOB(F.a->in[12], 2 * FF, D, 2 * FF, FF, ws + WS_W_F13, F.a->in[30], (FFN_FP8 == 1) ? 64.f : 1.f, MAP_SWIGLU, (FFN_FP8 == 1) ? 1 : 0)
    P0_JOB(F.a->in[13], D, FF, D, 0, ws + WS_W_F2, nullptr, (FFN_FP8 >= 1) ? 128.f : 1.f, MAP_ID, (FFN_FP8 >= 1) ? 1 : 0)
    P0_JOB(F.a->in[29], D, XW, D, 0, ws + WS_W_XO, nullptr, 1.f, MAP_ID, 0)
    P0_JOB(F.a->in[29] + (size_t)XW * D, D, XW, D, 0, ws + WS_W_XO + (size_t)D * XW * 2, nullptr, 1.f, MAP_ID, 0)
    P0_JOB(F.a->in[27], XW, D, XW, 0, ws + WS_W_XQ, F.a->in[26], C2_128, MAP_ID, 0)
    P0_JOB(F.a->in[27] + (size_t)D * XW, XW, D, XW, 0, ws + WS_W_XQ + (size_t)XW * D * 2, F.a->in[26] + D, C2_128, MAP_ID, 0)
    P0_JOB(F.a->in[11], D, D, D, 0, ws + WS_W_EVOUT, nullptr, 1.f, MAP_ID, 0)
    P0_JOB(F.a->in[28], 1024, D, 1024, 0, ws + WS_W_MKV, nullptr, 1.f, MAP_ID, 0)
    P0_JOB(F.a->in[28] + (size_t)D * 1024, 1024, D, 1024, 0, ws + WS_W_MKV + (size_t)1024 * D * 2, nullptr, 1.f, MAP_ID, 0)
    { const XtJob j_{F.a->in[6], EV_SRC_N, D, 2560, 0, ws + WS_W_EVIN, F.a->in[5], 1.f, MAP_EVIN, 0}; return xt_job_dec(j_, g); }
#undef P0_JOB
}
__device__ __forceinline__ void p0_prologue(Frame& F) {
    unsigned char* ws = F.ws;
    __syncthreads();
    const int gw = F.vcu * NWAVES + F.wave, NGW = F.G * NWAVES, lane = F.lane;
    {
        const float* Ws = F.a->in[9]; bf16* WSB = (bf16*)(ws + WS_C2 + 512 * 1024);
        for (int u = (F.vcu * NWAVES + F.wave) * 64 + lane; u < 4 * 128 * 128 / 4; u += F.G * NWAVES * 64) { const int t = (u >> 5) & 127, s0 = (u & 31) * 4; f32x4 w = ((const f32x4*)Ws)[u];
            w.x = (s0 + 0 <= t) ? w.x : 0.f; w.y = (s0 + 1 <= t) ? w.y : 0.f; w.z = (s0 + 2 <= t) ? w.z : 0.f; w.w = (s0 + 3 <= t) ? w.w : 0.f;
            *(unsigned long long*)(WSB + (size_t)u * 4) = (unsigned long long)pk2(w.x, w.y) | ((unsigned long long)pk2(w.z, w.w) << 32); }
    }
    { const int moe_n = MOE_TILES - ((F.G == 256) ? MOE_SLOT_TILES : 0);
      xt_run(F, F.vcu, F.G, moe_n + P0_DENSE_TILES, [&](int g) { return p0_dec(F, g); }); }
    __syncthreads();
    {
        LAS float* wfg = (LAS float*)(F.lds);
        const float* Win = F.a->in[6]; const float* gn = F.a->in[5];
        for (int u = F.tid; u < 8 * 1024; u += NWAVES * 64) { const int k = u >> 3, j = u & 7; wfg[j * 1024 + k] = Win[(size_t)k * EV_SRC_N + 1536 + j] * gn[k]; }
        __syncthreads();
        const float* x = F.a->in[0]; const float* bfp = F.a->in[7];
        bf16* XB = (bf16*)(ws + WS_XB); float* SSQ = (float*)(ws + WS_SSQ); float* FLOG = (float*)(ws + WS_FLOG);
        const float bfv = bfp[lane & 7];
        auto xload = [&](RowF32& b, int m) { const GAS f32x4* xr = (const GAS f32x4*)(x + (size_t)m * D) + lane;
#pragma unroll
            for (int j = 0; j < 4; ++j) b.v[j] = __builtin_nontemporal_load((const f32x4*)xr + 64 * j); };
        auto xproc = [&](const RowF32& b, int m) {
            float s = 0.f;
#pragma unroll
            for (int j = 0; j < 4; ++j) s += (b.v[j].x * b.v[j].x + b.v[j].y * b.v[j].y) + (b.v[j].z * b.v[j].z + b.v[j].w * b.v[j].w);
            const float ssq = wave_sum(s), rs = __builtin_amdgcn_rsqf(ssq * (1.0f / D) + EPS);
            GAS unsigned long long* o8 = (GAS unsigned long long*)(XB + (size_t)m * D) + lane;
#pragma unroll
            for (int j = 0; j < 4; ++j) o8[64 * j] = (unsigned long long)pk2(b.v[j].x, b.v[j].y) | ((unsigned long long)pk2(b.v[j].z, b.v[j].w) << 32);
            float f[8];
#pragma unroll
            for (int c = 0; c < 8; ++c) { float a = 0.f;
#pragma unroll
                for (int j = 0; j < 4; ++j) { const f32x4 w = *(const LAS f32x4*)(wfg + c * 1024 + 4 * lane + 256 * j); a = __builtin_fmaf(b.v[j].x, w.x, a); a = __builtin_fmaf(b.v[j].y, w.y, a); a = __builtin_fmaf(b.v[j].z, w.z, a); a = __builtin_fmaf(b.v[j].w, w.w, a); }
                f[c] = wave_sum(a); }
            float fl = f[0];
#pragma unroll
            for (int c = 1; c < 8; ++c) fl = (lane == c) ? f[c] : fl;
            if (lane < 8) { const float z = fl * rs + bfv; FLOG[(size_t)m * 8 + lane] = fminf(z, 0.f) - log1pf(expf(-fabsf(z))); }
            if (lane < 16) SSQ[(size_t)m * 16 + lane] = (lane == 0) ? ssq : 0.f; };
        ROWPIPE4(RowF32, M, xload, xproc);
        const float* mem = F.a->in[1]; const float* mg = F.a->in[3]; bf16* MEMN = (bf16*)(ws + WS_MEMN);
        for (int m = gw; m < MMEM; m += NGW) {
            const GAS f32x4* xr = (const GAS f32x4*)(mem + (size_t)m * D) + lane; const GAS f32x4* gr = (const GAS f32x4*)mg + lane;
            f32x4 v[4]; float s = 0.f;
#pragma unroll
            for (int j = 0; j < 4; ++j) { v[j] = xr[64 * j]; s += (v[j].x * v[j].x + v[j].y * v[j].y) + (v[j].z * v[j].z + v[j].w * v[j].w); }
            const float rs = __builtin_amdgcn_rsqf(wave_sum(s) * (1.0f / D) + EPS);
            GAS unsigned long long* o8 = (GAS unsigned long long*)(MEMN + (size_t)m * D) + lane;
#pragma unroll
            for (int j = 0; j < 4; ++j) { const f32x4 g = gr[64 * j]; o8[64 * j] = (unsigned long long)pk2(v[j].x * rs * g.x, v[j].y * rs * g.y) | ((unsigned long long)pk2(v[j].z * rs * g.z, v[j].w * rs * g.w) << 32); }
        }
        __syncthreads();
    }
}
__device__ __forceinline__ void m13_slot(Frame& F, int item0, int first_block) {
    const int rank = (int)blockIdx.x - first_block; if (rank < 0 || F.G != 256) return;
    const float* W13 = F.a->in[24]; const float* W2 = F.a->in[25]; unsigned char* ws = F.ws; const int base = item0 / 4 + rank * MOE_TQ;
    xt_run(F, 0, 1, MOE_TQ, [&](int k) { return moe_dec(W13, W2, ws, base + k); });
}
__device__ __forceinline__ void cumsum_seq(Frame& F, int sq) {
    const float* FLOG = (const float*)(F.ws + WS_FLOG); float* C2 = (float*)(F.ws + WS_C2);
    const int b = sq >> 3, h = sq & 7, lane = F.lane;
    const float* src = FLOG + ((size_t)b * SEQ + 32 * lane) * 8 + h;
    float v[32]; float run = 0.f;
#pragma unroll
    for (int i = 0; i < 32; ++i) { run += src[i * 8]; v[i] = run; }
    float tot = run;
#pragma unroll
    for (int o = 1; o < 64; o <<= 1) { const float t = __shfl_up(tot, o); if (lane >= o) tot += t; }
    const float base = tot - run;
    float* dst = C2 + (size_t)sq * SEQ + 32 * lane;
#pragma unroll
    for (int i = 0; i < 32; ++i) dst[i] = (base + v[i]) * LOG2E;
}
__device__ __forceinline__ void sgu_unit(Frame& F, int b, int c, int g) {
    typedef att::bf16x8 bf16x8; typedef att::f32x16 f32x16;
    constexpr int LP = 136;
    constexpr int V_OFF = 40960, ST_OFF = 73728;
    LAS unsigned short* Wl = (LAS unsigned short*)(F.lds); LAS char* Vl = (LAS char*)(F.lds + V_OFF); LAS unsigned short* St = (LAS unsigned short*)(F.lds + ST_OFF);
    const int tid = F.tid, lane = F.lane, wid = F.wave, r32 = lane & 31, hi = lane >> 5;
    const bf16* P = (const bf16*)(F.ws + WS_P); bf16* AG = (bf16*)(F.ws + WS_AG); const bf16* WSB = (const bf16*)(F.ws + WS_C2 + 512 * 1024);
    const size_t row0 = (size_t)b * SEQ + (size_t)c * 128;
    {
        const int t = tid >> 2, s0 = (tid & 3) * 32; const v4u* wp = (const v4u*)(WSB + ((size_t)g * 128 + t) * 128 + s0);
#pragma unroll
        for (int i = 0; i < 4; ++i) *(LAS v4u*)(Wl + t * LP + s0 + 8 * i) = wp[i];
    }
    {
        const int s = tid >> 2, d0 = (tid & 3) * 32; const bf16* vp = P + (row0 + s) * PW + 2048 + g * 128 + d0; const float* gn = F.a->in[8] + g * 128 + d0;
        float v[32]; float ss = 0.f;
#pragma unroll
        for (int i = 0; i < 4; ++i) { const v4u w = ((const v4u*)vp)[i];
            v[8 * i + 0] = bflo(w.x); v[8 * i + 1] = bfhi(w.x); v[8 * i + 2] = bflo(w.y); v[8 * i + 3] = bfhi(w.y); v[8 * i + 4] = bflo(w.z); v[8 * i + 5] = bfhi(w.z); v[8 * i + 6] = bflo(w.w); v[8 * i + 7] = bfhi(w.w); }
#pragma unroll
        for (int i = 0; i < 32; ++i) ss += v[i] * v[i];
        ss += WS_DPP(ss, 0xB1); ss += WS_DPP(ss, 0x4E);
        const float rs = __builtin_amdgcn_rsqf(ss * (1.0f / 128.0f) + EPS);
#pragma unroll
        for (int i = 0; i < 4; ++i) { const f32x4 ga = *(const f32x4*)(gn + 8 * i), gb = *(const f32x4*)(gn + 8 * i + 4);
            const v4u o = {pk2(v[8 * i] * rs * ga.x, v[8 * i + 1] * rs * ga.y), pk2(v[8 * i + 2] * rs * ga.z, v[8 * i + 3] * rs * ga.w), pk2(v[8 * i + 4] * rs * gb.x, v[8 * i + 5] * rs * gb.y), pk2(v[8 * i + 6] * rs * gb.z, v[8 * i + 7] * rs * gb.w)};
            *(LAS v4u*)(Vl + (s >> 6) * 16384 + att::v_st<4>(s & 63, d0 + 8 * i)) = o; }
    }
    __syncthreads();
    const int wt = wid >> 1, wd = wid & 1;
    f32x16 acc0 = f32x16{}, acc1 = f32x16{};
    const int vb = (int)(unsigned)(uintptr_t)Vl + att::v_rd_base(lane);
    for (int sb = 0; sb <= (wt >> 1); ++sb) {
        const LAS unsigned short* wr_ = Wl + (32 * wt + r32) * LP + 64 * sb + 8 * hi;
        const bf16x8 pa0 = *(const LAS bf16x8*)(wr_), pa1 = *(const LAS bf16x8*)(wr_ + 16), pa2 = *(const LAS bf16x8*)(wr_ + 32), pa3 = *(const LAS bf16x8*)(wr_ + 48);
        if (wd == 0) { att::pv_one<4, 0, false>(acc0, vb + sb * 16384, pa0, pa1, pa2, pa3); att::pv_one<4, 1, false>(acc1, vb + sb * 16384, pa0, pa1, pa2, pa3); }
        else         { att::pv_one<4, 2, false>(acc0, vb + sb * 16384, pa0, pa1, pa2, pa3); att::pv_one<4, 3, false>(acc1, vb + sb * 16384, pa0, pa1, pa2, pa3); }
    }
    const float* bsp = F.a->in[10] + g * 128;
#pragma unroll
    for (int r = 0; r < 16; ++r) { const int t = 32 * wt + att::crow(r, hi); const float bs = bsp[t];
        St[t * LP + 64 * wd + r32] = (unsigned short)f2bf(acc0[r] + bs); St[t * LP + 64 * wd + 32 + r32] = (unsigned short)f2bf(acc1[r] + bs); }
    __syncthreads();
#pragma unroll
    for (int i = 0; i < 4; ++i) { const int ch = tid + 512 * i, t = ch >> 4, dc = (ch & 15) * 8;
        const v4u m = *(const LAS v4u*)(St + t * LP + dc); const v4u u = *(const v4u*)(P + (row0 + t) * PW + 1536 + g * 128 + dc);
        const v4u o = {pk2(bflo(u.x) * bflo(m.x), bfhi(u.x) * bfhi(m.x)), pk2(bflo(u.y) * bflo(m.y), bfhi(u.y) * bfhi(m.y)), pk2(bflo(u.z) * bflo(m.z), bfhi(u.z) * bfhi(m.z)), pk2(bflo(u.w) * bflo(m.w), bfhi(u.w) * bfhi(m.w))};
        *(v4u*)(AG + (row0 + t) * D + 512 + g * 128 + dc) = o; }
    __syncthreads();
}
__device__ __forceinline__ void odd_glue_phase(Frame& F) {
    const int gw = F.vcu * NWAVES + F.wave, NGW = F.G * NWAVES, lane = F.lane;
    const bf16* P = (const bf16*)(F.ws + WS_P); const bf16* OD0 = (const bf16*)(F.ws + WS_OD); const bf16* OD1 = OD0 + (size_t)M * 512; bf16* CD = (bf16*)(F.ws + WS_AG);
    const float lam = expf(wave_sum(F.a->in[17][lane] * F.a->in[18][lane])) - expf(wave_sum(F.a->in[19][lane] * F.a->in[20][lane])) + LAM_INIT;
    const float* cw = F.a->in[16]; const float* sub = F.a->in[21];
    float w0[8], w1[8], w2[8], sg[8];
#pragma unroll
    for (int i = 0; i < 8; ++i) { w0[i] = cw[8 * lane + i]; w1[i] = cw[512 + 8 * lane + i]; w2[i] = cw[1024 + 8 * lane + i]; sg[i] = sub[(8 * lane + i) & 127] * (1.0f - LAM_INIT); }
    struct OBuf { v4u bg, x2, x1, x0, o0, o1; };
    auto oload = [&](OBuf& b, int m) { const int t = m & (SEQ - 1); const bf16* pr = P + (size_t)m * PW + 8 * lane;
        b.bg = *(const v4u*)pr; b.x2 = *(const v4u*)(pr + 512);
        b.x1 = *(const v4u*)(pr + 512 - (t >= 1 ? PW : 0)); b.x0 = *(const v4u*)(pr + 512 - (t >= 2 ? 2 * PW : 0));
        b.o0 = *(const v4u*)(OD0 + (size_t)m * 512 + 8 * lane); b.o1 = *(const v4u*)(OD1 + (size_t)m * 512 + 8 * lane); };
    auto oproc = [&](const OBuf& b, int m) {
        const int t = m & (SEQ - 1); const unsigned k1 = t >= 1 ? 0xffffffffu : 0u, k0 = t >= 2 ? 0xffffffffu : 0u;
        const unsigned bgw[4] = {b.bg.x, b.bg.y, b.bg.z, b.bg.w}, a2[4] = {b.x2.x, b.x2.y, b.x2.z, b.x2.w}, a1[4] = {b.x1.x & k1, b.x1.y & k1, b.x1.z & k1, b.x1.w & k1}, a0[4] = {b.x0.x & k0, b.x0.y & k0, b.x0.z & k0, b.x0.w & k0};
        unsigned oc[4];
#pragma unroll
        for (int i = 0; i < 4; ++i) {
            const float lo = bflo(bgw[i]) * (w0[2 * i] * bflo(a0[i]) + w1[2 * i] * bflo(a1[i]) + w2[2 * i] * bflo(a2[i]));
            const float hi = bfhi(bgw[i]) * (w0[2 * i + 1] * bfhi(a0[i]) + w1[2 * i + 1] * bfhi(a1[i]) + w2[2 * i + 1] * bfhi(a2[i]));
            oc[i] = pk2(lo, hi); }
        *(v4u*)(CD + (size_t)m * D + 8 * lane) = (v4u){oc[0], oc[1], oc[2], oc[3]};
        const unsigned p0[4] = {b.o0.x, b.o0.y, b.o0.z, b.o0.w}, p1[4] = {b.o1.x, b.o1.y, b.o1.z, b.o1.w};
        float dv[8]; float ss = 0.f;
#pragma unroll
        for (int i = 0; i < 4; ++i) { dv[2 * i] = bflo(p0[i]) - lam * bflo(p1[i]); dv[2 * i + 1] = bfhi(p0[i]) - lam * bfhi(p1[i]); ss += dv[2 * i] * dv[2 * i] + dv[2 * i + 1] * dv[2 * i + 1]; }
        ss += WS_DPP(ss, 0xB1); ss += WS_DPP(ss, 0x4E); ss += WS_DPP(ss, 0x141); ss += WS_DPP(ss, 0x140);
        const float rs = __builtin_amdgcn_rsqf(ss * (1.0f / 128.0f) + EPS);
        *(v4u*)(CD + (size_t)m * D + 512 + 8 * lane) = (v4u){pk2(dv[0] * rs * sg[0], dv[1] * rs * sg[1]), pk2(dv[2] * rs * sg[2], dv[3] * rs * sg[3]), pk2(dv[4] * rs * sg[4], dv[5] * rs * sg[5]), pk2(dv[6] * rs * sg[6], dv[7] * rs * sg[7])}; };
    ROWPIPE4(OBuf, M, oload, oproc);
}
__device__ __forceinline__ void load_row_bf16(const bf16* row, int lane, f32x4 (&v)[4]) {
    const GAS unsigned long long* p = (const GAS unsigned long long*)row + lane;
#pragma unroll
    for (int j = 0; j < 4; ++j) { const unsigned long long w = p[64 * j]; v[j] = (f32x4){bflo((unsigned)w), bfhi((unsigned)w), bflo((unsigned)(w >> 32)), bfhi((unsigned)(w >> 32))}; }
}
__device__ __forceinline__ void router_phase(Frame& F) {
    const int gw = F.vcu * NWAVES + F.wave, NGW = F.G * NWAVES, lane = F.lane;
    LAS float* wrl = (LAS float*)(F.lds);
    LAS int* rec_e = (LAS int*)(F.lds + 32768);
    LAS int* rec_r = rec_e + 512;
    LAS float* rec_w = (LAS float*)(rec_r + 512);
    LAS int* lcnt = (LAS int*)(rec_w + 1024); LAS int* lbase = lcnt + 8; LAS int* ltile = lbase + 8;
    { const float* Wr = F.a->in[23]; const float* gn = F.a->in[30] + D;
      for (int u = F.tid; u < 8 * 1024; u += NWAVES * 64) { const int k = u >> 3, e = u & 7; wrl[e * 1024 + k] = Wr[u] * gn[k]; }
      if (F.tid < 8) lcnt[F.tid] = 0; }
    __syncthreads();
    const bf16* X = (const bf16*)(F.ws + WS_XB); unsigned* cnt = (unsigned*)(F.ctl + CW_CNT);
    int* TOKP = (int*)(F.ws + WS_TOK + 512 * 1024); unsigned char* HG = F.ws + WS_HG; float* GATE = (float*)(F.ws + WS_GATE);
    const GAS f32x4* gr = (const GAS f32x4*)(F.a->in[30] + D) + lane;
    auto rload = [&](RowBf16& b, int m) { const GAS unsigned long long* p = (const GAS unsigned long long*)(X + (size_t)m * D) + lane;
#pragma unroll
        for (int j = 0; j < 4; ++j) b.w[j] = p[64 * j]; };
    auto rproc = [&](const RowBf16& b, int m) {
        f32x4 v[4]; float s = 0.f;
#pragma unroll
        for (int j = 0; j < 4; ++j) { v[j] = (f32x4){bflo((unsigned)b.w[j]), bfhi((unsigned)b.w[j]), bflo((unsigned)(b.w[j] >> 32)), bfhi((unsigned)(b.w[j] >> 32))};
            s += (v[j].x * v[j].x + v[j].y * v[j].y) + (v[j].z * v[j].z + v[j].w * v[j].w); }
        const float rs = __builtin_amdgcn_rsqf(wave_sum(s) * (1.0f / D) + EPS);
        float lg[8];
#pragma unroll
        for (int e = 0; e < 8; ++e) { float a = 0.f;
#pragma unroll
            for (int j = 0; j < 4; ++j) { const f32x4 w = *(const LAS f32x4*)(wrl + e * 1024 + 4 * lane + 256 * j); a = __builtin_fmaf(v[j].x, w.x, a); a = __builtin_fmaf(v[j].y, w.y, a); a = __builtin_fmaf(v[j].z, w.z, a); a = __builtin_fmaf(v[j].w, w.w, a); }
            lg[e] = wave_sum(a) * rs; }
        int i1 = 0; float v1 = lg[0];
#pragma unroll
        for (int e = 1; e < 8; ++e) if (lg[e] > v1) { v1 = lg[e]; i1 = e; }
        int i2 = -1; float v2 = -INFINITY;
#pragma unroll
        for (int e = 0; e < 8; ++e) if (e != i1 && lg[e] > v2) { v2 = lg[e]; i2 = e; }
        const float w1 = 1.0f / (1.0f + expf(v2 - v1));
        if (lane == 0) { const int k = (m - gw) / NGW, ri = F.wave * 64 + k;
            const int r1 = __hip_atomic_fetch_add(lcnt + i1, 1, __ATOMIC_RELAXED, __HIP_MEMORY_SCOPE_WORKGROUP), r2 = __hip_atomic_fetch_add(lcnt + i2, 1, __ATOMIC_RELAXED, __HIP_MEMORY_SCOPE_WORKGROUP);
            rec_e[ri] = i1 | (i2 << 8); rec_r[ri] = r1 | (r2 << 16); rec_w[2 * ri] = w1; rec_w[2 * ri + 1] = rs; } };
    const bool keep8 = (NGW * 8 == M);
    RowBf16 r8[8];
    if (keep8) {
#pragma unroll
        for (int k = 0; k < 8; ++k) rload(r8[k], gw + k * NGW);
#pragma unroll
        for (int k = 0; k < 8; ++k) rproc(r8[k], gw + k * NGW);
    } else ROWPIPE(RowBf16, M, rload, rproc);
    __syncthreads();
    if (F.tid < 8) { const int e = F.tid, n = lcnt[e]; unsigned bs = 0u;
        if (n > 0) { bs = __hip_atomic_fetch_add(cnt + e, (unsigned)n, RLX_AGENT);
            for (unsigned sl = (bs + 255u) & ~255u; sl < bs + (unsigned)n; sl += 256u) { const unsigned t = __hip_atomic_fetch_add(F.ctl + CW_NT, 1u, RLX_AGENT);
                __hip_atomic_store(F.ctl + CW_TEXP + t, (unsigned)e, RLX_AGENT); __hip_atomic_store(F.ctl + CW_TID + e * 64 + (int)(sl >> 8), t + 1u, RLX_AGENT); } }
        lbase[e] = (int)bs; }
    __syncthreads();
    if (F.tid < 16) { const int e = F.tid >> 1, n = lcnt[e]; int tv = 0;
        if (n > 0) { const unsigned bs = (unsigned)lbase[e], sl = (F.tid & 1) ? bs + (unsigned)n - 1u : bs; gu32* tp = F.ctl + CW_TID + e * 64 + (int)(sl >> 8); unsigned t, k = 0u;
            while ((t = __hip_atomic_load(tp, RLX_AGENT)) == 0u) { __builtin_amdgcn_s_sleep(1); if (++k > (1u << 16)) { t = 1u; break; } }
            tv = (int)(t - 1u); }
        ltile[F.tid] = tv; }
    __syncthreads();
    f32x4 g4[4];
#pragma unroll
    for (int j = 0; j < 4; ++j) g4[j] = gr[64 * j];
    auto wproc = [&](const RowBf16& b, int m) {
        const int k = (m - gw) / NGW, ri = F.wave * 64 + k;
        const int ee = rec_e[ri], rr = rec_r[ri]; const float w1 = rec_w[2 * ri], rs = rec_w[2 * ri + 1];
        const int e1 = ee & 255, e2 = ee >> 8; const unsigned s1 = (unsigned)(lbase[e1] + (rr & 0xffff)), s2 = (unsigned)(lbase[e2] + (rr >> 16));
        const int t1 = ltile[2 * e1 + (((s1 >> 8) != ((unsigned)lbase[e1] >> 8)) ? 1 : 0)], t2 = ltile[2 * e2 + (((s2 >> 8) != ((unsigned)lbase[e2] >> 8)) ? 1 : 0)];
        const int p1 = __builtin_amdgcn_readfirstlane(t1 * 256 + (int)(s1 & 255u)), p2 = __builtin_amdgcn_readfirstlane(t2 * 256 + (int)(s2 & 255u));
        if (lane == 0) { GATE[p1] = w1; GATE[p2] = 1.0f - w1; *(int2*)(TOKP + (size_t)m * 2) = make_int2(p1, p2); }
        GAS unsigned* o1 = (GAS unsigned*)(HG + (size_t)p1 * D) + lane; GAS unsigned* o2 = (GAS unsigned*)(HG + (size_t)p2 * D) + lane;
#pragma unroll
        for (int j = 0; j < 4; ++j) { const f32x4 g = g4[j];
            const unsigned w = pk4_fp8(bflo((unsigned)b.w[j]) * rs * g.x, bfhi((unsigned)b.w[j]) * rs * g.y, bflo((unsigned)(b.w[j] >> 32)) * rs * g.z, bfhi((unsigned)(b.w[j] >> 32)) * rs * g.w);
            o1[64 * j] = w; o2[64 * j] = w; } };
    if (keep8) {
#pragma unroll
        for (int k = 0; k < 8; ++k) wproc(r8[k], gw + k * NGW);
    } else ROWPIPE(RowBf16, M, rload, wproc);
}
__device__ __forceinline__ int moe_base(const unsigned* cnt, int e) {
    int b = 0;
#pragma unroll
    for (int j = 0; j < 8; ++j) b += (j < e) ? (int)((cnt[j] + 255u) >> 8) : 0;
    return b * 256;
}
__device__ __forceinline__ void final_phase(Frame& F) {
    const int gw = F.vcu * NWAVES + F.wave, NGW = F.G * NWAVES, lane = F.lane;
    const bf16* X = (const bf16*)(F.ws + WS_XB); float* OUT = F.out; const int* TOKP = (const int*)(F.ws + WS_TOK + 512 * 1024); const bf16* Y = (const bf16*)(F.ws + WS_Y); const float* gn = F.a->in[4];
    struct FBuf { unsigned long long x[4], a[4], b[4]; };
    const bf16* YP = (const bf16*)(F.ws + WS_OD);
    auto yfast = [&](unsigned long long (&d)[4], int p) { const GAS unsigned long long* y = (const GAS unsigned long long*)(Y + (size_t)(p & 32767) * D) + lane;
#pragma unroll
        for (int j = 0; j < 4; ++j) d[j] = y[64 * j]; };
    auto yslow = [&](unsigned long long (&d)[4], int p) {
        if (p >= 32768) { unsigned long long w[7][4];
#pragma unroll
            for (int sl = 0; sl < 7; ++sl) { const GAS unsigned long long* y = (const GAS unsigned long long*)(YP + ((size_t)sl * 2048 + (p - 32768)) * D) + lane;
#pragma unroll
                for (int j = 0; j < 4; ++j) w[sl][j] = y[64 * j]; }
#pragma unroll
            for (int j = 0; j < 4; ++j) { float a0 = 0.f, a1 = 0.f, a2 = 0.f, a3 = 0.f;
#pragma unroll
                for (int sl = 0; sl < 7; ++sl) { a0 += bflo((unsigned)w[sl][j]); a1 += bfhi((unsigned)w[sl][j]); a2 += bflo((unsigned)(w[sl][j] >> 32)); a3 += bfhi((unsigned)(w[sl][j] >> 32)); }
                d[j] = (unsigned long long)pk2(a0, a1) | ((unsigned long long)pk2(a2, a3) << 32); } } };
    const GAS f32x4* gr = (const GAS f32x4*)gn + lane;
    int2 ppv = make_int2(0, 0);
    { const int mk = gw + lane * NGW; if (mk < M) ppv = *(const int2*)(TOKP + (size_t)mk * 2); }
    auto fload = [&](FBuf& b, int m) { const int k = (m - gw) / NGW; const int p1 = __builtin_amdgcn_readlane(ppv.x, k), p2 = __builtin_amdgcn_readlane(ppv.y, k);
        const GAS unsigned long long* px = (const GAS unsigned long long*)(X + (size_t)m * D) + lane;
#pragma unroll
        for (int j = 0; j < 4; ++j) b.x[j] = px[64 * j];
        yfast(b.a, p1); yfast(b.b, p2); };
    f32x4 g4[4];
#pragma unroll
    for (int j = 0; j < 4; ++j) g4[j] = gr[64 * j];
    auto fproc = [&](FBuf& b, int m) {
        { const int k = (m - gw) / NGW; yslow(b.a, __builtin_amdgcn_readlane(ppv.x, k)); yslow(b.b, __builtin_amdgcn_readlane(ppv.y, k)); }
        GAS f32x4* xr = (GAS f32x4*)(OUT + (size_t)m * D) + lane;
        f32x4 v[4]; float s = 0.f;
#pragma unroll
        for (int j = 0; j < 4; ++j) { const unsigned long long x = b.x[j], a = b.a[j], c = b.b[j];
            v[j].x = bflo((unsigned)x) + bflo((unsigned)a) + bflo((unsigned)c); v[j].y = bfhi((unsigned)x) + bfhi((unsigned)a) + bfhi((unsigned)c);
            v[j].z = bflo((unsigned)(x >> 32)) + bflo((unsigned)(a >> 32)) + bflo((unsigned)(c >> 32)); v[j].w = bfhi((unsigned)(x >> 32)) + bfhi((unsigned)(a >> 32)) + bfhi((unsigned)(c >> 32));
            s += (v[j].x * v[j].x + v[j].y * v[j].y) + (v[j].z * v[j].z + v[j].w * v[j].w); }
        const float rs = __builtin_amdgcn_rsqf(wave_sum(s) * (1.0f / D) + EPS);
#pragma unroll
        for (int j = 0; j < 4; ++j) { const f32x4 g = g4[j]; __builtin_nontemporal_store((f32x4){v[j].x * rs * g.x, v[j].y * rs * g.y, v[j].z * rs * g.z, v[j].w * rs * g.w}, (f32x4*)xr + 64 * j); } };
    ROWPIPE4(FBuf, M, fload, fproc);
}
__device__ __forceinline__ void fox_sgu_phase(Frame& F) {
    using G = att::Geo<64, 64>;
    LAS char* lds = (LAS char*)F.lds;
    const bf16* P = (const bf16*)(F.ws + WS_P); bf16* AG = (bf16*)(F.ws + WS_AG); const float* C2 = (const float*)(F.ws + WS_C2);
    for (int pr = F.vcu; pr < 256; pr += F.G) {
        const int bh = pr >> 2, s = pr & 3, b = bh >> 3, h = bh & 7;
        LAS v4u* tab = (LAS v4u*)(lds + fx::LDS_TAB);
        int tid_o = F.tid; asm volatile("" : "+v"(tid_o));
        for (int u = tid_o; u < SEQ / 4; u += NWAVES * 64) { const f32x4 c = ((const f32x4*)(C2 + (size_t)bh * SEQ))[u]; v4u e;
            { const unsigned h_ = f2bf(-c.x); e.x = h_ | (f2bf(-c.x - bf2f((unsigned short)h_)) << 16); } { const unsigned h_ = f2bf(-c.y); e.y = h_ | (f2bf(-c.y - bf2f((unsigned short)h_)) << 16); }
            { const unsigned h_ = f2bf(-c.z); e.z = h_ | (f2bf(-c.z - bf2f((unsigned short)h_)) << 16); } { const unsigned h_ = f2bf(-c.w); e.w = h_ | (f2bf(-c.w - bf2f((unsigned short)h_)) << 16); }
            tab[u] = e; }
        __syncthreads();
        for (int k = 0; k < 2; ++k) { const int qb = (k == 0) ? 7 - s : s; const size_t row0 = (size_t)b * SEQ + (size_t)qb * 256, kv0 = (size_t)b * SEQ * PW;
            fx::fox_unit<PW, PW, D, FOX_THR>(P + row0 * PW + h * 64, P + kv0 + 512 + h * 64, P + kv0 + 1024 + h * 64, AG + row0 * D + h * 64, qb * 256, lds); }
    }
    Frame F2 = F; asm volatile("" : "+v"(F2.tid), "+v"(F2.lane));
    for (int u = F.vcu; u < 512; u += F.G) sgu_unit(F2, u >> 6, (u >> 2) & 15, u & 3);
}
__device__ __forceinline__ void diff_phase(Frame& F) {
    using G = attd::Geo<64, 128>;
    LAS char* lds = (LAS char*)F.lds;
    const bf16* P = (const bf16*)(F.ws + WS_P); bf16* OD = (bf16*)(F.ws + WS_OD); const float* RB = F.a->in[2];
    for (int pr = F.vcu; pr < 256; pr += F.G) {
        const int bhi = pr >> 2, s = pr & 3, b = bhi >> 3, h = (bhi >> 1) & 3, i = bhi & 1;
        LAS float* tab = (LAS float*)(lds + G::TAB_OFF);
        if (F.tid < 128) { const int d = F.tid; int bk = d;
            if (d >= 16) { bk = 16 + (int)(logf((float)d * (1.0f / 16.0f)) / logf(8.0f) * 16.0f); bk = bk > 31 ? 31 : bk; }
            tab[d] = RB[bk * 4 + h] * LOG2E; }
        __syncthreads();
        for (int u = F.tid; u < 4 * 520; u += NWAVES * 64) { const int c = u / 520, j = u - c * 520, d = j + c - 256;
            ((LAS float*)(lds + G::EXT_OFF))[c * 520 + j] = d < 0 ? -INFINITY : tab[d > 127 ? 127 : d]; }
        __syncthreads();
        for (int k = 0; k < 2; ++k) { const int qb = (k == 0) ? 7 - s : s; const size_t row0 = (size_t)b * SEQ + (size_t)qb * 256, kv0 = (size_t)b * SEQ * PW;
            attd::attn_unit<64, 128, 2, PW, PW, 512>(P + row0 * PW + 1024 + h * 128 + i * 64, P + kv0 + 1536 + h * 128 + i * 64, P + kv0 + 2048 + h * 128, OD + (size_t)i * M * 512 + row0 * 512 + h * 128, 4 * (qb + 1), qb * 256, lds); }
    }
}
__device__ __forceinline__ void xattn_phase(Frame& F, int layer) {
    LAS char* lds = (LAS char*)F.lds;
    const bf16* QX = (const bf16*)(F.ws + WS_QX); const bf16* KVM = (const bf16*)(F.ws + WS_KVM); bf16* OX = (bf16*)(F.ws + WS_OX);
    for (int u = F.vcu; u < 256; u += F.G) { const int b = u >> 5, h = (u >> 3) & 3, qb = u & 7; const size_t row0 = (size_t)b * SEQ + (size_t)qb * 256;
        const bf16* kp = KVM + (size_t)b * MEMLEN * 2048 + layer * 1024 + h * 128;
        attd::attn_unit<128, 128, 0, 512, 2048, 512>(QX + row0 * 512 + h * 128, kp, kp + 512, OX + row0 * 512 + h * 128, 4, 0, lds); }
}

constexpr int N_PHASES = 21;
__global__ void __launch_bounds__(NWAVES * 64, 2) hyb_fwd(Args args) {
    extern __shared__ __attribute__((aligned(16))) unsigned char lds[];
    Frame F;
    F.lds = (LAS unsigned char*)lds;
    F.MISC = (volatile LAS unsigned*)(F.lds + MISC_OFF);
    F.tid = threadIdx.x; F.lane = F.tid & 63; F.wave = __builtin_amdgcn_readfirstlane(F.tid >> 6);
    F.G = gridDim.x; { const int bx = blockIdx.x; F.vcu = (F.G % 8 == 0) ? (bx % 8) * (F.G / 8) + bx / 8 : bx; }
    F.a = &args;
    F.out = args.out; F.ws = args.ws; F.ctl = (gu32*)(args.ws + WS_CTL);
    unsigned char* ws = args.ws;
    for (int u = F.tid; u < (LDS_BYTES - LDSCTL_OFF) / 4; u += NWAVES * 64) ((LAS unsigned*)(F.lds + LDSCTL_OFF))[u] = 0u;
    __syncthreads();
    XcdBarrier bar; bar.bar = (unsigned*)(F.ctl + CW_BAR); bar.x = 0; bar.st = nullptr;
    if (!MK_PER_PHASE) bar = xcd_barrier_post((unsigned*)(F.ctl + CW_BAR), F.MISC + 8);
#define GRID_BAR() do { if (!MK_PER_PHASE) xcd_barrier(bar); } while (0)
    const int lo = args.ph_lo, hi = args.ph_hi;
#ifndef PH_MASK
#define PH_MASK 0x1fffff
#endif
#define IN(k) (((PH_MASK >> (k)) & 1) && lo <= (k) && (k) < hi)
#ifndef DUP_MASK
#define DUP_MASK 0
#endif
#define DUP(k) (((DUP_MASK >> (k)) & 1) ? 2 : 1)
#define SEAM(k) do { if (IN(k) && IN((k) + 1)) GRID_BAR(); } while (0)
    const int bx = (int)blockIdx.x, G = F.G;
    bf16* XB = (bf16*)(ws + WS_XB); float* SSQ = (float*)(ws + WS_SSQ); bf16* P = (bf16*)(ws + WS_P); bf16* AG = (bf16*)(ws + WS_AG);
    bf16* QX = (bf16*)(ws + WS_QX); bf16* OX = (bf16*)(ws + WS_OX); bf16* ACT = (bf16*)(ws + WS_ACT);

    if (IN(0)) p0_prologue(F);
    SEAM(0);
    if (IN(1)) {
        if (F.wave == 0) for (int sq = G - 1 - bx; sq < 64; sq += G) cumsum_seq(F, sq);
        { pg8::Gemm g{XB, (const bf16*)(ws + WS_W_EVIN), M, 2560, D}; pg8::StaticOrder S; S.init(M, 2560, G, bx);
          pg8::EpiIn<0> E{P, SSQ}; pg8::gemm_phase<pg8::EpiIn<0>, pg8::StaticOrder, true, true>(F.lds + RING_OFF, g, S, E); }
        { pg8::Gemm g{(const bf16*)(ws + WS_MEMN), (const bf16*)(ws + WS_W_MKV), MMEM, 2048, D}; pg8::StaticOrder S; S.init(MMEM, 2048, G, (bx + G / 2) % G);
          pg8::EpiPlain<false> E{(bf16*)(ws + WS_KVM), 2048, nullptr}; pg8::gemm_phase<pg8::EpiPlain<false>, pg8::StaticOrder, true, true>(F.lds + RING_OFF, g, S, E); }
    }
    if (IN(1)) m13_slot(F, 0, 192);
    SEAM(1);
    if (IN(2)) fox_sgu_phase(F);
    SEAM(2);
    if (IN(3)) { pg8::Gemm g{AG, (const bf16*)(ws + WS_W_EVOUT), M, D, D}; pg8::StaticOrder S; S.init(M, D, G, bx);
        pg8::EpiResid<false> E{XB, SSQ, nullptr, 1.0f}; pg8::gemm_phase<pg8::EpiResid<false>, pg8::StaticOrder, true, true>(F.lds + RING_OFF, g, S, E); }
    SEAM(3);
    if (IN(4)) { pg8::Gemm g{XB, (const bf16*)(ws + WS_W_XQ), M, XW, D}; pg8::StaticOrder S; S.init(M, XW, G, bx);
        pg8::EpiPlain<true> E{QX, XW, SSQ}; pg8::gemm_phase<pg8::EpiPlain<true>, pg8::StaticOrder, true, true>(F.lds + RING_OFF, g, S, E); }
    if (IN(4)) m13_slot(F, 64 * M13_Q, 128);
    SEAM(4);
    if (IN(5)) xattn_phase(F, 0);
    SEAM(5);
#if FFN_FP8 == 1
    if (IN(6)) { pg8::Gemm g{OX, (const bf16*)(ws + WS_W_XO), M, D, XW}; pg8::StaticOrder S; S.init(M, D, G, bx);
        pg8::EpiResid<true> E{XB, SSQ, ws + WS_XB8, 1.0f}; pg8::gemm_phase<pg8::EpiResid<true>, pg8::StaticOrder, true, true>(F.lds + RING_OFF, g, S, E); }
#else
    if (IN(6)) { pg8::Gemm g{OX, (const bf16*)(ws + WS_W_XO), M, D, XW}; pg8::StaticOrder S; S.init(M, D, G, bx);
        pg8::EpiResid<false> E{XB, SSQ, nullptr, 1.0f}; pg8::gemm_phase<pg8::EpiResid<false>, pg8::StaticOrder, true, true>(F.lds + RING_OFF, g, S, E); }
#endif
    SEAM(6);
#if FFN_FP8 == 2
    if (IN(7)) { pg8::Gemm g{XB, (const bf16*)(ws + WS_W_F13), M, 2 * FF, D}; pg8::StaticOrder S; S.init(M, 2 * FF, G, bx);
        pg8::EpiSwigluF8<22, true> E{ws + WS_ACT, FF, 1.0f, SSQ}; pg8::gemm_phase<pg8::EpiSwigluF8<22, true>, pg8::StaticOrder, true, true>(F.lds + RING_OFF, g, S, E); }
#elif FFN_FP8 == 1
    if (IN(7)) { pg8::Gemm g{(const bf16*)(ws + WS_XB8), (const bf16*)(ws + WS_W_F13), M, 2 * FF, D}; pg8::StaticOrder S; S.init(M, 2 * FF, G, bx);
        pg8::EpiSwigluF8<22, true> E{ws + WS_ACT, FF, 1.0f / 64.0f, SSQ}; pg8::gemm_phase<pg8::EpiSwigluF8<22, true>, pg8::StaticOrder, true, true, true>(F.lds + RING_OFF, g, S, E); }
#else
    if (IN(7)) { pg8::Gemm g{XB, (const bf16*)(ws + WS_W_F13), M, 2 * FF, D}; pg8::StaticOrder S; S.init(M, 2 * FF, G, bx);
        pg8::EpiSwiglu<22> E{ACT, FF, SSQ}; pg8::gemm_phase<pg8::EpiSwiglu<22>, pg8::StaticOrder, true, true>(F.lds + RING_OFF, g, S, E); }
#endif
    if (IN(7)) m13_slot(F, (64 + 128) * M13_Q, 128);
    SEAM(7);
#if FFN_FP8 >= 1
    if (IN(8)) { pg8::Gemm g{(const bf16*)(ws + WS_ACT), (const bf16*)(ws + WS_W_F2), M, D, FF}; pg8::StaticOrder S; S.init(M, D, G, bx);
        pg8::EpiResid<false> E{XB, SSQ, nullptr, 1.0f / 128.0f}; pg8::gemm_phase<pg8::EpiResid<false>, pg8::StaticOrder, true, true, true>(F.lds + RING_OFF, g, S, E); }
#else
    if (IN(8)) { pg8::Gemm g{ACT, (const bf16*)(ws + WS_W_F2), M, D, FF}; pg8::StaticOrder S; S.init(M, D, G, bx);
        pg8::EpiResid<false> E{XB, SSQ, nullptr, 1.0f}; pg8::gemm_phase<pg8::EpiResid<false>, pg8::StaticOrder, true, true>(F.lds + RING_OFF, g, S, E); }
#endif
    SEAM(8);
    if (IN(9)) { pg8::Gemm g{XB, (const bf16*)(ws + WS_W_ODIN), M, 3072, D}; pg8::StaticOrder S; S.init(M, 3072, G, bx);
        pg8::EpiIn<1> E{P, SSQ}; pg8::gemm_phase<pg8::EpiIn<1>, pg8::StaticOrder, true, true>(F.lds + RING_OFF, g, S, E); }
    SEAM(9);
    if (IN(10)) diff_phase(F);
    SEAM(10);
    if (IN(11)) odd_glue_phase(F);
    SEAM(11);
    if (IN(12)) { pg8::Gemm g{AG, (const bf16*)(ws + WS_W_ODOUT), M, D, D}; pg8::StaticOrder S; S.init(M, D, G, bx);
        pg8::EpiResid<false> E{XB, SSQ, nullptr, 1.0f}; pg8::gemm_phase<pg8::EpiResid<false>, pg8::StaticOrder, true, true>(F.lds + RING_OFF, g, S, E); }
    SEAM(12);
    if (IN(13)) { pg8::Gemm g{XB, (const bf16*)(ws + WS_W_XQ) + (size_t)XW * D, M, XW, D}; pg8::StaticOrder S; S.init(M, XW, G, bx);
        pg8::EpiPlain<true> E{QX, XW, SSQ}; pg8::gemm_phase<pg8::EpiPlain<true>, pg8::StaticOrder, true, true>(F.lds + RING_OFF, g, S, E); }
    if (IN(13)) m13_slot(F, (64 + 256) * M13_Q, 128);
    SEAM(13);
    if (IN(14)) xattn_phase(F, 1);
    SEAM(14);
    if (IN(15)) { pg8::Gemm g{OX, (const bf16*)(ws + WS_W_XO) + (size_t)D * XW, M, D, XW}; pg8::StaticOrder S; S.init(M, D, G, bx);
        pg8::EpiResid<false> E{XB, SSQ, nullptr, 1.0f}; pg8::gemm_phase<pg8::EpiResid<false>, pg8::StaticOrder, true, true>(F.lds + RING_OFF, g, S, E); }
    SEAM(15);
    if (IN(16)) router_phase(F);
    SEAM(16);
    if (IN(18)) { const int T = __builtin_amdgcn_readfirstlane((int)F.ctl[CW_NT]); LAS int* texp = (LAS int*)(F.lds + TEXP_LDS);
        if (F.tid < 160) texp[F.tid] = (F.tid < T) ? (int)F.ctl[CW_TEXP + F.tid] : 0;
        __syncthreads();
        pg8::Gemm g{(const bf16*)(ws + WS_HG), (const bf16*)(ws + WS_W_M13), PAIR_ROWS, NE * 2 * FE, D}; pg8::MoeOrder S; S.init(T, texp, 28, G, bx);
        pg8::EpiSwigluF8<28, false> E{ws + WS_ACT, FE, 1.0f / 64.0f, nullptr}; pg8::gemm_phase<pg8::EpiSwigluF8<28, false>, pg8::MoeOrder, true, true, true>(F.lds + RING_OFF, g, S, E); }
    SEAM(18);
    if (IN(19)) { const int T = __builtin_amdgcn_readfirstlane((int)F.ctl[CW_NT]); LAS int* texp = (LAS int*)(F.lds + TEXP_LDS);
        if (F.tid < 160) texp[F.tid] = (F.tid < T) ? (int)F.ctl[CW_TEXP + F.tid] : 0;
        __syncthreads();
        pg8::Gemm g{(const bf16*)(ws + WS_ACT), (const bf16*)(ws + WS_W_M2), PAIR_ROWS, NE * D, FE}; pg8::MoeSplitOrder S; S.init(T, texp, G, bx, FE / 128);
        pg8::EpiY E{(bf16*)(ws + WS_Y), (const float*)(ws + WS_GATE), 1.0f / 128.0f, (bf16*)(ws + WS_OD)}; pg8::gemm_phase<pg8::EpiY, pg8::MoeSplitOrder, true, true, true>(F.lds + RING_OFF, g, S, E); }
    SEAM(19);
    if (IN(20)) final_phase(F);
#undef IN
#undef SEAM
#undef GRID_BAR
}

extern "C" void kernel_launch(void* const* d_in, const int* in_sizes, int n_in, void* d_out, int out_size, void* d_ws, size_t ws_size, hipStream_t stream) {
    static int grid = 0;
    if (grid == 0) {
        if (n_in != 31 || in_sizes[0] != M * D || out_size != M * D || ws_size < WS_END) { fprintf(stderr, "kernel_launch: built for 31 inputs, x/out of %d floats, >= %zu bytes of workspace; got n_in %d, in0 %d, out %d, ws %zu; nothing launched\n", M * D, (size_t)WS_END, n_in, n_in > 0 ? in_sizes[0] : -1, out_size, ws_size); grid = -1; return; }
        int dev = 0, cus = 0, per_cu = 0;
        if (hipGetDevice(&dev) != hipSuccess || hipDeviceGetAttribute(&cus, hipDeviceAttributeMultiprocessorCount, dev) != hipSuccess) { fprintf(stderr, "kernel_launch: hipGetDevice / hipDeviceGetAttribute failed\n"); grid = -1; return; }
        if (hipFuncSetAttribute((const void*)hyb_fwd, hipFuncAttributeMaxDynamicSharedMemorySize, LDS_BYTES) != hipSuccess) { fprintf(stderr, "kernel_launch: hipFuncSetAttribute failed\n"); grid = -1; return; }
        if (hipOccupancyMaxActiveBlocksPerMultiprocessor(&per_cu, (const void*)hyb_fwd, NWAVES * 64, LDS_BYTES) != hipSuccess || per_cu < 1)
            fprintf(stderr, "kernel_launch: note: occupancy query reports %d workgroups per CU\n", per_cu);
        (void)hipGetLastError();
        grid = cus;
    }
    if (grid < 0) return;
    if (hipMemsetAsync((char*)d_ws + WS_CTL, 0, CTL_ZERO_BYTES, stream) != hipSuccess) { fprintf(stderr, "kernel_launch: hipMemsetAsync failed\n"); return; }
    Args a{};
    for (int i = 0; i < 31; ++i) a.in[i] = (const float*)d_in[i];
    a.out = (float*)d_out; a.ws = (unsigned char*)d_ws;
#if MK_PER_PHASE
    for (int p = 0; p < N_PHASES; ++p) { a.ph_lo = p; a.ph_hi = p + 1; hipLaunchKernelGGL(hyb_fwd, dim3(grid), dim3(NWAVES * 64), LDS_BYTES, stream, a); }
#else
    a.ph_lo = 0; a.ph_hi = N_PHASES;
    hipLaunchKernelGGL(hyb_fwd, dim3(grid), dim3(NWAVES * 64), LDS_BYTES, stream, a);
#endif
    const hipError_t le = hipPeekAtLastError();
    if (le != hipSuccess) fprintf(stderr, "kernel_launch: launch failed: %s (grid %d)\n", hipGetErrorName(le), grid);
}
```
